# Optimizing an MI355X kernel written in HIP

```python
import jax, jax.numpy as jnp
from jax import lax
import numpy as np

D_MODEL = 4096
BATCH = 2
SEQ = 8192
DEPTH = 1

CHUNK = 64

RMS_EPS = 1e-6
LRU_WIDTH = D_MODEL
LRU_HEADS = 16
LRU_HEAD_DIM = LRU_WIDTH // LRU_HEADS
CONV_WIDTH = 4
LRU_C = 8.0
POOL_WINDOWS = (2, 4, 8, 16)
POOL_GROUPS = len(POOL_WINDOWS)
POOL_WIDTH = D_MODEL
POOL_GROUP_DIM = POOL_WIDTH // POOL_GROUPS
N_BRANCHES = 2
IN_WIDTH = 2 * LRU_WIDTH + POOL_WIDTH + N_BRANCHES * D_MODEL
D_FF = -(-8 * D_MODEL // (3 * 256)) * 256
N_MOD = 6

kernel_name = "hybrid_rglru_pool_swiglu_block"


def _rmsnorm(x, g):
    x32 = x.astype(jnp.float32)
    y = x32 * lax.rsqrt(jnp.mean(x32 * x32, axis=-1, keepdims=True) + RMS_EPS)
    return y.astype(x.dtype) * g


def _modulate(u, shift, scale):
    return u * (1 + scale[:, None, :]) + shift[:, None, :]


def _causal_depthwise_conv(x, w, b):
    S = x.shape[1]
    xp = jnp.pad(x, ((0, 0), (CONV_WIDTH - 1, 0), (0, 0)))
    y = b
    for k in range(CONV_WIDTH):
        y = y + w[k] * xp[:, k:k + S]
    return y


def _block_diag_linear(x, w, b):
    B, S, _ = x.shape
    xh = x.reshape(B, S, LRU_HEADS, LRU_HEAD_DIM)
    return jnp.einsum('bshi,hij->bshj', xh, w).reshape(B, S, LRU_WIDTH) + b


def _rg_lru(x, w_a, b_a, w_x, b_x, lam):
    B, S, _ = x.shape
    r = jax.nn.sigmoid(_block_diag_linear(x, w_a, b_a).astype(jnp.float32))
    i = jax.nn.sigmoid(_block_diag_linear(x, w_x, b_x).astype(jnp.float32))
    log_a = -LRU_C * r * jax.nn.softplus(-lam.astype(jnp.float32))
    a = jnp.exp(log_a)
    u = jnp.sqrt(-jnp.expm1(2.0 * log_a)) * (i * x.astype(jnp.float32))

    def step(h, inp):
        a_t, u_t = inp
        h = a_t * h + u_t
        return h, h

    h0 = jnp.zeros((B, LRU_WIDTH), jnp.float32)
    _, hs = lax.scan(step, h0, (jnp.swapaxes(a, 0, 1), jnp.swapaxes(u, 0, 1)))
    return jnp.swapaxes(hs, 0, 1).astype(x.dtype)


def _multiscale_pool(p, pool_w, pool_scale):
    B, S, _ = p.shape
    p32 = p.astype(jnp.float32).reshape(B, S, POOL_GROUPS, POOL_GROUP_DIM)
    cs = jnp.cumsum(p32, axis=1)
    t = jnp.arange(S)
    outs = []
    for g, w in enumerate(POOL_WINDOWS):
        csg = cs[:, :, g]
        prev = jnp.pad(csg, ((0, 0), (w, 0), (0, 0)))[:, :S]
        cnt = jnp.minimum(t + 1, w).astype(jnp.float32)[None, :, None]
        outs.append((csg - prev) / cnt)
    pooled = (jnp.stack(outs, axis=2) - p32).astype(p.dtype)
    mixed = jnp.einsum('bsgi,gij->bsgj', pooled, pool_w).reshape(B, S, POOL_WIDTH)
    return mixed * pool_scale


def _normal(k, shape, fan_in):
    return jax.random.normal(k, shape, jnp.float32) * (fan_in ** -0.5)


def setup_inputs(seed: int = 0) -> dict:
    key = jax.random.key(seed)
    ks = jax.random.split(key, 24)
    L = DEPTH
    u = jax.random.uniform(ks[11], (L, LRU_WIDTH), jnp.float32, 0.9, 0.999)
    a0 = u ** (1.0 / LRU_C)
    lru_lambda = jnp.log(a0) - jnp.log1p(-a0)
    return {
        "x": jax.random.normal(ks[0], (BATCH, SEQ, D_MODEL), jnp.float32),
        "c": jax.random.normal(ks[1], (BATCH, D_MODEL), jnp.float32),
        "w_ada": _normal(ks[2], (L, D_MODEL, N_MOD * D_MODEL), D_MODEL),
        "b_ada": 0.02 * jax.random.normal(ks[3], (L, N_MOD * D_MODEL), jnp.float32),
        "g_mix_pre": 1.0 + 0.05 * jax.random.normal(ks[4], (L, D_MODEL), jnp.float32),
        "g_mix_post": 1.0 + 0.05 * jax.random.normal(ks[5], (L, D_MODEL), jnp.float32),
        "w_in": _normal(ks[6], (L, D_MODEL, IN_WIDTH), D_MODEL),
        "conv_w": _normal(ks[7], (L, CONV_WIDTH, LRU_WIDTH), CONV_WIDTH),
        "conv_b": 0.02 * jax.random.normal(ks[8], (L, LRU_WIDTH), jnp.float32),
        "w_rg_a": _normal(ks[9], (L, LRU_HEADS, LRU_HEAD_DIM, LRU_HEAD_DIM), LRU_HEAD_DIM),
        "b_rg_a": 0.02 * jax.random.normal(ks[10], (L, LRU_WIDTH), jnp.float32),
        "w_rg_x": _normal(ks[12], (L, LRU_HEADS, LRU_HEAD_DIM, LRU_HEAD_DIM), LRU_HEAD_DIM),
        "b_rg_x": 0.02 * jax.random.normal(ks[13], (L, LRU_WIDTH), jnp.float32),
        "lru_lambda": lru_lambda,
        "pool_w": _normal(ks[14], (L, POOL_GROUPS, POOL_GROUP_DIM, POOL_GROUP_DIM), POOL_GROUP_DIM),
        "pool_scale": 1.0 + 0.1 * jax.random.normal(ks[15], (L, POOL_WIDTH), jnp.float32),
        "w_branch_lru": _normal(ks[16], (L, LRU_WIDTH, D_MODEL), LRU_WIDTH),
        "w_branch_pool": _normal(ks[17], (L, POOL_WIDTH, D_MODEL), POOL_WIDTH),
        "w_o": _normal(ks[18], (L, D_MODEL, D_MODEL), D_MODEL),
        "g_ffn_pre": 1.0 + 0.05 * jax.random.normal(ks[19], (L, D_MODEL), jnp.float32),
        "g_ffn_post": 1.0 + 0.05 * jax.random.normal(ks[20], (L, D_MODEL), jnp.float32),
        "w_gate_up": _normal(ks[21], (L, D_MODEL, 2 * D_FF), D_MODEL),
        "w_down": _normal(ks[22], (L, D_FF, D_MODEL), D_FF),
    }


def reference(x, c, w_ada, b_ada, g_mix_pre, g_mix_post, w_in, conv_w, conv_b,
              w_rg_a, b_rg_a, w_rg_x, b_rg_x, lru_lambda, pool_w, pool_scale,
              w_branch_lru, w_branch_pool, w_o, g_ffn_pre, g_ffn_post, w_gate_up, w_down):
    splits = [LRU_WIDTH, 2 * LRU_WIDTH, 2 * LRU_WIDTH + POOL_WIDTH,
              2 * LRU_WIDTH + POOL_WIDTH + D_MODEL]
    c_act = jax.nn.silu(c)
    for l in range(DEPTH):
        mod = c_act @ w_ada[l] + b_ada[l]
        sh_m, sc_m, gt_m, sh_f, sc_f, gt_f = jnp.split(mod, N_MOD, axis=-1)

        u = _modulate(_rmsnorm(x, g_mix_pre[l]), sh_m, sc_m)
        proj = u @ w_in[l]
        xr, gr, xp, m_lru, m_pool = jnp.split(proj, splits, axis=-1)
        xr = _causal_depthwise_conv(xr, conv_w[l], conv_b[l])
        y_lru = _rg_lru(xr, w_rg_a[l], b_rg_a[l], w_rg_x[l], b_rg_x[l], lru_lambda[l]) * jax.nn.gelu(gr)
        y_pool = _multiscale_pool(xp, pool_w[l], pool_scale[l])
        merged = (jax.nn.sigmoid(m_lru) * (y_lru @ w_branch_lru[l])
                  + jax.nn.sigmoid(m_pool) * (y_pool @ w_branch_pool[l]))
        y = merged @ w_o[l]
        x = x + gt_m[:, None, :] * _rmsnorm(y, g_mix_post[l])

        u = _modulate(_rmsnorm(x, g_ffn_pre[l]), sh_f, sc_f)
        gate, up = jnp.split(u @ w_gate_up[l], 2, axis=-1)
        y = (jax.nn.silu(gate) * up) @ w_down[l]
        x = x + gt_f[:, None, :] * _rmsnorm(y, g_ffn_post[l])
    return x
```

```cpp
#include <hip/hip_runtime.h>
#include <cstdio>
#include <cstdint>

#ifndef MK_N_LAUNCHES
#define MK_N_LAUNCHES 1
#endif

namespace pg8 {
#define PG8_LAS __attribute__((address_space(3)))
typedef unsigned short bf16_t;
typedef short bf16x8 __attribute__((ext_vector_type(8)));
typedef float f32x4 __attribute__((ext_vector_type(4)));
typedef unsigned u32x4 __attribute__((ext_vector_type(4)));
typedef unsigned u32x2 __attribute__((ext_vector_type(2)));
constexpr int BM = 256, BK = 64, HALF = 128, HTB = HALF * BK * 2  , STAGE_BYTES = 8 * HTB, NXCD = 8, WGM = 8;

__host__ __device__ __forceinline__ int lds_byte(int r, int c) { const int st = (r >> 4) * 2 + (c >> 5), rr = r & 15, cc = c & 31, ob = rr * 64 + cc * 2; return st * 1024 + (ob ^ (((ob >> 9) & 1) << 5)); }
__host__ __device__ __forceinline__ void stage_rc(int b, int& R, int& C) { const int st = b / 1024, sb = b % 1024, swz = sb ^ (((sb >> 9) & 1) << 5); R = (st >> 1) * 16 + swz / 64; C = (st & 1) * 32 + (swz % 64) / 2; }
__host__ __device__ __forceinline__ int perm32(int rho) { const int n = rho >> 4, i = rho & 15; return 8 * (i >> 2) + 4 * n + (i & 3); }

struct Unit { int pm, pn; };
struct Gemm { const bf16_t* A; const bf16_t* Bt; int M, N, K, lda, ldb, agshift; };

struct StaticOrder {
    int nM, nN, nwg, G, c;
    __host__ __device__ void init(int M, int N, int G_, int c_) { nM = M / BM; nN = N / BM; nwg = nM * nN; G = G_; c = c_; }
    __host__ __device__ bool next(int i, Unit& u) const {
        const long L = (long)i * G + c; if (L >= nwg) return false;
        int wgid = (int)L; { const int q = nwg / NXCD, r = nwg % NXCD, xcd = wgid % NXCD, off = wgid / NXCD; wgid = (xcd < r ? xcd * (q + 1) : r * (q + 1) + (xcd - r) * q) + off; }
        const int nig = WGM * nN, gid = wgid / nig, fm = gid * WGM, gsz = (nM - fm) < WGM ? (nM - fm) : WGM;
        u.pm = fm + ((wgid % nig) % gsz); u.pn = (wgid % nig) / gsz; return true;
    }
    __device__ __forceinline__ void a_ready(const Unit&) const {}
    __device__ __forceinline__ void done(const Unit&) const {}
};

__device__ __forceinline__ unsigned cvt_pk_bf16(float lo, float hi) { unsigned r; asm volatile("v_cvt_pk_bf16_f32 %0, %1, %2" : "=v"(r) : "v"(lo), "v"(hi)); return r; }
__device__ __forceinline__ float bf_lo(unsigned w) { return __uint_as_float(w << 16); }
__device__ __forceinline__ float bf_hi(unsigned w) { return __uint_as_float(w & 0xffff0000u); }
__device__ __forceinline__ float fast_rcp(float x) { return __builtin_amdgcn_rcpf(x); }
__device__ __forceinline__ float fast_exp(float x) { return __builtin_amdgcn_exp2f(x * 1.44269504088896f); }
__device__ __forceinline__ float sigmoidf_(float x) { return fast_rcp(1.0f + fast_exp(-x)); }
__device__ __forceinline__ float siluf_(float x) { return x * sigmoidf_(x); }
__device__ __forceinline__ float gelu_tanh_(float x) { const float z = 1.5957691216057308f * (x + 0.044715f * x * x * x); return x * sigmoidf_(z); }

struct EpiPlain {
    static constexpr bool PERM = true;
    bf16_t* O; int ldc;
    __device__ __forceinline__ void operator()(const f32x4 (&acc)[2][2][4][2], const Unit& u, int wr, int wc, int fr, int fq) const {
        const int row0 = u.pm * BM + wr * 64 + fr, col0 = u.pn * BM + wc * 32 + 8 * fq;
#pragma unroll
        for (int ai = 0; ai < 2; ++ai)
#pragma unroll
            for (int m = 0; m < 4; ++m) { bf16_t* rowp = O + (size_t)(row0 + ai * HALF + m * 16) * ldc + col0;
#pragma unroll
                for (int bj = 0; bj < 2; ++bj) { const f32x4 v0 = acc[ai][bj][m][0], v1 = acc[ai][bj][m][1];
                    u32x4 w; w.x = cvt_pk_bf16(v0[0], v0[1]); w.y = cvt_pk_bf16(v0[2], v0[3]); w.z = cvt_pk_bf16(v1[0], v1[1]); w.w = cvt_pk_bf16(v1[2], v1[3]);
                    *(u32x4*)(rowp + bj * HALF) = w; } }
    }
};
struct EpiScale {
    static constexpr bool PERM = true;
    bf16_t* O; int ldc; const float* scale;
    __device__ __forceinline__ void operator()(const f32x4 (&acc)[2][2][4][2], const Unit& u, int wr, int wc, int fr, int fq) const {
        const int row0 = u.pm * BM + wr * 64 + fr, col0 = u.pn * BM + wc * 32 + 8 * fq;
        f32x4 sv[2][2];
#pragma unroll
        for (int bj = 0; bj < 2; ++bj)
#pragma unroll
            for (int n = 0; n < 2; ++n) sv[bj][n] = *(const f32x4*)(scale + col0 + bj * HALF + 4 * n);
#pragma unroll
        for (int ai = 0; ai < 2; ++ai)
#pragma unroll
            for (int m = 0; m < 4; ++m) { bf16_t* rowp = O + (size_t)(row0 + ai * HALF + m * 16) * ldc + col0;
#pragma unroll
                for (int bj = 0; bj < 2; ++bj) { const f32x4 v0 = acc[ai][bj][m][0] * sv[bj][0], v1 = acc[ai][bj][m][1] * sv[bj][1];
                    u32x4 w; w.x = cvt_pk_bf16(v0[0], v0[1]); w.y = cvt_pk_bf16(v0[2], v0[3]); w.z = cvt_pk_bf16(v1[0], v1[1]); w.w = cvt_pk_bf16(v1[2], v1[3]);
                    *(u32x4*)(rowp + bj * HALF) = w; } }
    }
};
template <bool ADD> struct EpiGate {
    static constexpr bool PERM = true;
    bf16_t* O; int ldc; const bf16_t* Gt; int ldg;
    __device__ __forceinline__ void operator()(const f32x4 (&acc)[2][2][4][2], const Unit& u, int wr, int wc, int fr, int fq) const {
        const int row0 = u.pm * BM + wr * 64 + fr, col0 = u.pn * BM + wc * 32 + 8 * fq;
#pragma unroll
        for (int ai = 0; ai < 2; ++ai)
#pragma unroll
            for (int m = 0; m < 4; ++m) { const size_t row = (size_t)(row0 + ai * HALF + m * 16); bf16_t* rowp = O + row * ldc + col0; const bf16_t* gp = Gt + row * ldg + col0;
#pragma unroll
                for (int bj = 0; bj < 2; ++bj) { const u32x4 g = *(const u32x4*)(gp + bj * HALF); const f32x4 v0 = acc[ai][bj][m][0], v1 = acc[ai][bj][m][1];
                    float o[8];
                    o[0] = sigmoidf_(bf_lo(g.x)) * v0[0]; o[1] = sigmoidf_(bf_hi(g.x)) * v0[1]; o[2] = sigmoidf_(bf_lo(g.y)) * v0[2]; o[3] = sigmoidf_(bf_hi(g.y)) * v0[3];
                    o[4] = sigmoidf_(bf_lo(g.z)) * v1[0]; o[5] = sigmoidf_(bf_hi(g.z)) * v1[1]; o[6] = sigmoidf_(bf_lo(g.w)) * v1[2]; o[7] = sigmoidf_(bf_hi(g.w)) * v1[3];
                    if (ADD) { const u32x4 p = *(const u32x4*)(rowp + bj * HALF);
                        o[0] += bf_lo(p.x); o[1] += bf_hi(p.x); o[2] += bf_lo(p.y); o[3] += bf_hi(p.y); o[4] += bf_lo(p.z); o[5] += bf_hi(p.z); o[6] += bf_lo(p.w); o[7] += bf_hi(p.w); }
                    u32x4 w; w.x = cvt_pk_bf16(o[0], o[1]); w.y = cvt_pk_bf16(o[2], o[3]); w.z = cvt_pk_bf16(o[4], o[5]); w.w = cvt_pk_bf16(o[6], o[7]);
                    *(u32x4*)(rowp + bj * HALF) = w; }
                asm volatile("" ::: "memory"); }
    }
};
struct EpiSwiglu {
    static constexpr bool PERM = true;
    bf16_t* O; int ldc;
    __device__ __forceinline__ void operator()(const f32x4 (&acc)[2][2][4][2], const Unit& u, int wr, int wc, int fr, int fq) const {
        const int row0 = u.pm * BM + wr * 64 + fr, col0 = u.pn * HALF + wc * 32 + 8 * fq;
#pragma unroll
        for (int ai = 0; ai < 2; ++ai)
#pragma unroll
            for (int m = 0; m < 4; ++m) { bf16_t* rowp = O + (size_t)(row0 + ai * HALF + m * 16) * ldc + col0;
                const f32x4 g0 = acc[ai][0][m][0], g1 = acc[ai][0][m][1], u0 = acc[ai][1][m][0], u1 = acc[ai][1][m][1];
                u32x4 w; w.x = cvt_pk_bf16(siluf_(g0[0]) * u0[0], siluf_(g0[1]) * u0[1]); w.y = cvt_pk_bf16(siluf_(g0[2]) * u0[2], siluf_(g0[3]) * u0[3]);
                w.z = cvt_pk_bf16(siluf_(g1[0]) * u1[0], siluf_(g1[1]) * u1[1]); w.w = cvt_pk_bf16(siluf_(g1[2]) * u1[2], siluf_(g1[3]) * u1[3]);
                *(u32x4*)rowp = w; }
    }
};
struct EpiRg {
    static constexpr bool PERM = false;
    const bf16_t* XC; unsigned* AU; const float* b_a; const float* b_x; const float* sp8; int ldx;
    __device__ __forceinline__ void operator()(const f32x4 (&acc)[2][2][4][2], const Unit& u, int wr, int wc, int fr, int fq) const {
        const int row0 = u.pm * BM + wr * 64 + fr, chb = u.pn * HALF + wc * 32 + 4 * fq;
#pragma unroll
        for (int n = 0; n < 2; ++n) { const int ch = chb + 16 * n;
            const f32x4 ba = *(const f32x4*)(b_a + ch), bx = *(const f32x4*)(b_x + ch), sp = *(const f32x4*)(sp8 + ch);
#pragma unroll
            for (int ai = 0; ai < 2; ++ai)
#pragma unroll
                for (int m = 0; m < 4; ++m) { const size_t row = (size_t)(row0 + ai * HALF + m * 16);
                    const u32x2 xw = *(const u32x2*)(XC + row * ldx + ch);
                    const float xv[4] = {bf_lo(xw.x), bf_hi(xw.x), bf_lo(xw.y), bf_hi(xw.y)};
                    const f32x4 rp = acc[ai][0][m][n] + ba, ip = acc[ai][1][m][n] + bx;
                    unsigned w[4];
#pragma unroll
                    for (int j = 0; j < 4; ++j) { const float r = sigmoidf_(rp[j]), ig = sigmoidf_(ip[j]); const float la = sp[j] * r, x2 = la + la;
                        const float poly = x2 * (1.0f + x2 * (0.5f + x2 * (0.16666667f + x2 * (0.041666668f + x2 * (0.0083333338f + x2 * 0.0013888889f)))));
                        const float em1 = (x2 > -0.25f) ? poly : (fast_exp(x2) - 1.0f);
                        const float mult = __builtin_sqrtf(fmaxf(-em1, 0.0f));
                        w[j] = cvt_pk_bf16(la, mult * ig * xv[j]); }
                    u32x4 o; o.x = w[0]; o.y = w[1]; o.z = w[2]; o.w = w[3];
                    *(u32x4*)(AU + row * ldx + ch) = o;
                    asm volatile("" ::: "memory"); __builtin_amdgcn_sched_barrier(0); } }
    }
};

template <class Epi, class Sched, bool ALIGN_EPI = false, bool SP2 = false>
__device__ __forceinline__ void gemm_phase(PG8_LAS unsigned char* lds, const Gemm g, const Sched& S, const Epi& E) {
    const int tid = threadIdx.x, wid = __builtin_amdgcn_readfirstlane(tid >> 6), lane = tid & 63, wr = wid >> 2, wc = wid & 3, fr = lane & 15, fq = lane >> 4;
    const int K = g.K, nt = K / BK;
    unsigned voffA[2], voffB[2];
#pragma unroll
    for (int i = 0; i < 2; ++i) { int R, C; stage_rc(tid * 16 + i * 8192, R, C); const int Rb = Epi::PERM ? ((R & ~31) + perm32(R & 31)) : R;
        voffA[i] = (unsigned)(R * g.lda + C) * 2u; voffB[i] = (unsigned)(Rb * g.ldb + C) * 2u; }
    const size_t kstep = (size_t)(BK * 2);
    const size_t hstepA = (size_t)HALF * g.lda * 2, hstepB = (size_t)HALF * g.ldb * 2;
    const size_t tstepA = 2 * hstepA, tstepB = 2 * hstepB;
    const unsigned ldsw = (unsigned)wid * 1024u;
    const int aoff = lds_byte(wr * 64 + fr, fq * 8), boff = lds_byte(wc * 32 + fr, fq * 8);
#define PG8_SA(b, h) (((b) * 2 + (h)) * HTB)
#define PG8_SB(b, h) ((4 + (b) * 2 + (h)) * HTB)
#define PG8_STAGE(bufoff, gbase, voff) do { _Pragma("unroll") for (int _i = 0; _i < 2; ++_i) \
        __builtin_amdgcn_global_load_lds((const unsigned*)((const char*)(gbase) + (voff)[_i]), (PG8_LAS unsigned*)(lds + (bufoff) + ldsw + _i * 8192), 16, 0, 0); } while (0)
#define PG8_LDA(dst, b, h) do { _Pragma("unroll") for (int m = 0; m < 4; ++m) _Pragma("unroll") for (int k = 0; k < 2; ++k) dst[m][k] = *(const PG8_LAS bf16x8*)(lds + PG8_SA(b, h) + aoff + m * 2048 + k * 1024); } while (0)
#define PG8_LDB(dst, b, h) do { _Pragma("unroll") for (int n = 0; n < 2; ++n) _Pragma("unroll") for (int k = 0; k < 2; ++k) dst[n][k] = *(const PG8_LAS bf16x8*)(lds + PG8_SB(b, h) + boff + n * 2048 + k * 1024); } while (0)
#define PG8_MMA(ai, bj, At, Bt) do { __builtin_amdgcn_s_setprio(1); _Pragma("unroll") for (int m = 0; m < 4; ++m) _Pragma("unroll") for (int n = 0; n < 2; ++n) _Pragma("unroll") for (int k = 0; k < 2; ++k) \
        acc[ai][bj][m][n] = __builtin_amdgcn_mfma_f32_16x16x32_bf16(Bt[n][k], At[m][k], acc[ai][bj][m][n], 0, 0, 0); __builtin_amdgcn_s_setprio(0); } while (0)
#define PG8_WAIT_V(n) asm volatile("s_waitcnt vmcnt(" #n ")" ::: "memory")
#define PG8_WAIT_L(n) asm volatile("s_waitcnt lgkmcnt(" #n ")" ::: "memory")
#define PG8_BAR __builtin_amdgcn_s_barrier()
#define PG8_SCHED __builtin_amdgcn_sched_barrier(0)
#define PG8_ABASE(u) ((const char*)g.A + (size_t)(u).pm * tstepA + (size_t)((u).pn >> g.agshift) * (size_t)K * 2)
#define PG8_BBASE(u) ((const char*)g.Bt + (size_t)(u).pn * tstepB)
    Unit cur, nxt; int ui = 0;
    if (!S.next(0, cur)) return;
    f32x4 acc[2][2][4][2];
#pragma unroll
    for (int a = 0; a < 2; ++a)
#pragma unroll
        for (int b = 0; b < 2; ++b)
#pragma unroll
            for (int m = 0; m < 4; ++m)
#pragma unroll
                for (int n = 0; n < 2; ++n) acc[a][b][m][n] = (f32x4){0.f, 0.f, 0.f, 0.f};
    bf16x8 At[4][2], B0[2][2], B1[2][2];
    const char* cA = PG8_ABASE(cur); const char* cB = PG8_BBASE(cur);
    S.a_ready(cur);
    if constexpr (SP2) {
        PG8_STAGE(PG8_SB(0, 0), cB, voffB); PG8_STAGE(PG8_SB(0, 1), cB + hstepB, voffB); PG8_STAGE(PG8_SA(0, 0), cA, voffA); PG8_STAGE(PG8_SA(0, 1), cA + hstepA, voffA);
        if (wr == 1) PG8_BAR;
        PG8_WAIT_V(2); PG8_BAR;
        PG8_STAGE(PG8_SB(1, 0), cB + kstep, voffB); PG8_STAGE(PG8_SA(1, 0), cA + kstep, voffA); PG8_STAGE(PG8_SB(1, 1), cB + hstepB + kstep, voffB);
        PG8_WAIT_V(6); PG8_BAR;
    } else {
        PG8_STAGE(PG8_SB(0, 0), cB, voffB); PG8_STAGE(PG8_SA(0, 0), cA, voffA); PG8_STAGE(PG8_SB(0, 1), cB + hstepB, voffB); PG8_STAGE(PG8_SA(0, 1), cA + hstepA, voffA);
        if (wr == 1) PG8_BAR;
        PG8_WAIT_V(4); PG8_BAR;
        PG8_STAGE(PG8_SB(1, 0), cB + kstep, voffB); PG8_STAGE(PG8_SA(1, 0), cA + kstep, voffA); PG8_STAGE(PG8_SB(1, 1), cB + hstepB + kstep, voffB);
        PG8_WAIT_V(6); PG8_BAR;
    }
    for (;;) {
        const bool has_next = S.next(ui + 1, nxt);
        const char* nA = has_next ? PG8_ABASE(nxt) : cA; const char* nB = has_next ? PG8_BBASE(nxt) : cB;
#pragma unroll 1
        for (int t = 0; t < nt; t += 2) {
            const bool last = (t == nt - 2);
            const char* a1 = cA + (size_t)(t + 1) * kstep;
            const char* a2 = last ? nA : cA + (size_t)(t + 2) * kstep; const char* b2 = last ? nB : cB + (size_t)(t + 2) * kstep;
            const char* a3 = a2 + kstep; const char* b3 = b2 + kstep;
            if (last && has_next) S.a_ready(nxt);
            if constexpr (SP2) {
            PG8_LDB(B0, 0, 0); PG8_LDB(B1, 0, 1); PG8_SCHED; PG8_LDA(At, 0, 0); PG8_STAGE(PG8_SA(1, 1), a1 + hstepA, voffA);
            PG8_WAIT_V(8); PG8_WAIT_L(0); PG8_BAR; PG8_MMA(0, 0, At, B0); PG8_MMA(0, 1, At, B1); PG8_BAR; PG8_SCHED;
            PG8_LDA(At, 0, 1); PG8_STAGE(PG8_SB(0, 0), b2, voffB); PG8_STAGE(PG8_SB(0, 1), b2 + hstepB, voffB); PG8_STAGE(PG8_SA(0, 0), a2, voffA);
            PG8_WAIT_V(8); PG8_WAIT_L(0); PG8_BAR; PG8_MMA(1, 0, At, B0); PG8_MMA(1, 1, At, B1); PG8_BAR; PG8_SCHED;
            PG8_LDB(B0, 1, 0); PG8_LDB(B1, 1, 1); PG8_SCHED; PG8_LDA(At, 1, 0); PG8_STAGE(PG8_SA(0, 1), a2 + hstepA, voffA);
            PG8_WAIT_V(8); PG8_WAIT_L(0); PG8_BAR; PG8_MMA(0, 0, At, B0); PG8_MMA(0, 1, At, B1); PG8_BAR; PG8_SCHED;
            PG8_LDA(At, 1, 1); PG8_STAGE(PG8_SB(1, 0), b3, voffB); PG8_STAGE(PG8_SB(1, 1), b3 + hstepB, voffB); PG8_STAGE(PG8_SA(1, 0), a3, voffA);
            PG8_WAIT_V(8); PG8_WAIT_L(0); PG8_BAR; PG8_MMA(1, 0, At, B0); PG8_MMA(1, 1, At, B1); PG8_BAR; PG8_SCHED;
            } else {
            PG8_LDB(B0, 0, 0); PG8_SCHED; PG8_LDA(At, 0, 0); PG8_STAGE(PG8_SA(1, 1), a1 + hstepA, voffA);
            PG8_WAIT_L(8); PG8_BAR; PG8_WAIT_L(0); PG8_MMA(0, 0, At, B0); PG8_BAR; PG8_SCHED;
            PG8_LDB(B1, 0, 1); PG8_STAGE(PG8_SB(0, 0), b2, voffB);
            PG8_BAR; PG8_WAIT_L(0); PG8_MMA(0, 1, At, B1); PG8_BAR;
            PG8_LDA(At, 0, 1); PG8_STAGE(PG8_SA(0, 0), a2, voffA);
            PG8_BAR; PG8_WAIT_L(0); PG8_MMA(1, 0, At, B0); PG8_BAR; PG8_SCHED;
            PG8_STAGE(PG8_SB(0, 1), b2 + hstepB, voffB);
            PG8_WAIT_V(6); PG8_BAR; PG8_MMA(1, 1, At, B1); PG8_BAR;
            PG8_LDB(B0, 1, 0); PG8_SCHED; PG8_LDA(At, 1, 0); PG8_STAGE(PG8_SA(0, 1), a2 + hstepA, voffA);
            PG8_WAIT_L(8); PG8_BAR; PG8_WAIT_L(0); PG8_MMA(0, 0, At, B0); PG8_BAR; PG8_SCHED;
            PG8_LDB(B1, 1, 1); PG8_STAGE(PG8_SB(1, 0), b3, voffB);
            PG8_BAR; PG8_WAIT_L(0); PG8_MMA(0, 1, At, B1); PG8_BAR;
            PG8_LDA(At, 1, 1); PG8_STAGE(PG8_SA(1, 0), a3, voffA);
            PG8_BAR; PG8_WAIT_L(0); PG8_MMA(1, 0, At, B0); PG8_BAR; PG8_SCHED;
            PG8_STAGE(PG8_SB(1, 1), b3 + hstepB, voffB);
            PG8_WAIT_V(6); PG8_BAR; PG8_MMA(1, 1, At, B1); PG8_BAR;
            }
        }
        if constexpr (ALIGN_EPI) { if (wr == 0) PG8_BAR; }
        E(acc, cur, wr, wc, fr, fq); S.done(cur);
        if (!has_next) break;
#pragma unroll
        for (int a = 0; a < 2; ++a)
#pragma unroll
            for (int b = 0; b < 2; ++b)
#pragma unroll
                for (int m = 0; m < 4; ++m)
#pragma unroll
                    for (int n = 0; n < 2; ++n) acc[a][b][m][n] = (f32x4){0.f, 0.f, 0.f, 0.f};
        cur = nxt; cA = nA; cB = nB; ++ui;
        if constexpr (ALIGN_EPI) { if (wr == 1) PG8_BAR; }
    }
    PG8_WAIT_V(0);
    if constexpr (!ALIGN_EPI) { if (wr == 0) PG8_BAR; }
    PG8_BAR;
#undef PG8_SA
#undef PG8_SB
#undef PG8_STAGE
#undef PG8_LDA
#undef PG8_LDB
#undef PG8_MMA
#undef PG8_WAIT_V
#undef PG8_WAIT_L
#undef PG8_BAR
#undef PG8_SCHED
#undef PG8_ABASE
#undef PG8_BBASE
}
}

constexpr int NWAVES = 8;
constexpr int N_LAUNCHES = MK_N_LAUNCHES;
constexpr int NPH = 13;
constexpr int BATCH = 2, SEQ = 8192, D = 4096, M = BATCH * SEQ;
constexpr int NIN = 5 * D;
constexpr int DFF = 11008, NGU = 2 * DFF;
constexpr int NMOD = 6 * D;
constexpr int HEADS = 16, HD = 256, PGRP = 4, PGD = 1024;
constexpr float RMS_EPS = 1e-6f;
constexpr int SCAN_T = 256, SCAN_NC = SEQ / SCAN_T;

constexpr size_t MiB = 1u << 20;
constexpr size_t WS_CTL = 0, CTL_ZERO_BYTES = 1 * MiB;
constexpr size_t WS_MOD = 1 * MiB;
constexpr size_t WS_SP8 = WS_MOD + 256 * 1024;
constexpr size_t WS_CP = WS_MOD + 512 * 1024;
constexpr size_t WS_WRG = 2 * MiB;
constexpr size_t WS_WPOOL = 6 * MiB;
constexpr size_t WS_WBL = 14 * MiB;
constexpr size_t WS_WBP = 46 * MiB;
constexpr size_t WS_WO = 78 * MiB;
constexpr size_t WS_WIN = 110 * MiB;
constexpr size_t WS_XC = 110 * MiB;
constexpr size_t WS_MERGED = 110 * MiB;
constexpr size_t WS_SCANC = 240 * MiB;
constexpr size_t WS_U = 270 * MiB;
constexpr size_t WS_POOLED = 270 * MiB;
constexpr size_t WS_PROJ = 398 * MiB;
constexpr size_t WS_WGU = 398 * MiB;
constexpr size_t WS_WDN = 570 * MiB;
constexpr size_t WS_H = 656 * MiB;
constexpr size_t WS_AU = 1038 * MiB;
constexpr size_t WS_Y = 1038 * MiB;
constexpr size_t WS_Y2 = 1166 * MiB;
constexpr size_t WS_YL = 1294 * MiB;
constexpr size_t WS_YP = 1422 * MiB;
constexpr size_t WS_END = 1550 * MiB;
static_assert(WS_WIN + (size_t)NIN * D * 2 <= WS_U && WS_SCANC + 2 * MiB <= WS_U && WS_XC + (size_t)M * D * 2 <= WS_SCANC, "ws map 1");
static_assert(WS_U + (size_t)M * D * 2 <= WS_PROJ && WS_PROJ + (size_t)M * NIN * 2 <= WS_AU, "ws map 2");
static_assert(WS_WGU + (size_t)NGU * D * 2 <= WS_WDN && WS_WDN + (size_t)D * DFF * 2 <= WS_H && WS_H + (size_t)M * DFF * 2 <= WS_AU, "ws map 3");
static_assert(WS_AU + (size_t)M * D * 4 <= WS_YL && WS_Y2 + (size_t)M * D * 2 <= WS_YL && WS_YP + (size_t)M * D * 2 <= WS_END, "ws map 4");
constexpr int CW_TMO = 0;
constexpr int CW_BAR = 4096;

constexpr int RING_OFF = 0, RING_BYTES = 131072;
constexpr int LDSCTL_OFF = RING_BYTES, MISC_OFF = LDSCTL_OFF + 320;
constexpr int LDS_BYTES = 147456;
static_assert(MISC_OFF + 128 <= LDS_BYTES, "LDS map");

#define GAS __attribute__((address_space(1)))
#define LAS __attribute__((address_space(3)))
typedef unsigned short bf16;
typedef unsigned v4u __attribute__((ext_vector_type(4)));
typedef unsigned v2u __attribute__((ext_vector_type(2)));
typedef float f32x4 __attribute__((ext_vector_type(4)));
typedef float f32x2 __attribute__((ext_vector_type(2)));
typedef GAS unsigned gu32;
#define RLX_AGENT __ATOMIC_RELAXED, __HIP_MEMORY_SCOPE_AGENT
#define LDS_WAIT() asm volatile("s_waitcnt lgkmcnt(0)" ::: "memory")
#define VM_WAIT() asm volatile("s_waitcnt vmcnt(0)" ::: "memory")
using pg8::cvt_pk_bf16; using pg8::bf_lo; using pg8::bf_hi;

#define XB_TMO      128
#define XB_XCNT(j)  (256  + 64 * (j))
#define XB_XSUB(j)  (1280 + 64 * (j))
#define XB_XGEN(j)  (2304 + 64 * (j))
#define XB_TOP      3328
#define XB_TOPGEN   3392
#define XCD_BAR_WORDS 3456
#define XB_SPIN_CAP (1u << 18)

__device__ __forceinline__ unsigned xb_ld(unsigned* p)              { return __hip_atomic_load(p, __ATOMIC_RELAXED, __HIP_MEMORY_SCOPE_AGENT); }
__device__ __forceinline__ unsigned xb_add(unsigned* p, unsigned v) { return __hip_atomic_fetch_add(p, v, __ATOMIC_RELAXED, __HIP_MEMORY_SCOPE_AGENT); }
__device__ __forceinline__ unsigned xb_xcc_id() { return (unsigned)__builtin_amdgcn_s_getreg((3 << 11) | 20) & 0xFu; }
#define XB_SPIN(cond, bar) do { unsigned _sp = 0; while (cond) { __builtin_amdgcn_s_sleep(1); \
    if ((++_sp & 255u) == 0u) { if (xb_ld(&(bar)[XB_TMO])) break; if (_sp > XB_SPIN_CAP) { atomicAdd(&(bar)[XB_TMO], 1u); break; } } } } while (0)

struct XcdBarrier {
    unsigned* bar; unsigned x;
    volatile LAS unsigned* st;
};
__device__ __forceinline__ XcdBarrier xcd_barrier_post(unsigned* bar, volatile LAS unsigned* st) {
    XcdBarrier b; b.bar = bar; b.x = xb_xcc_id(); b.st = st;
    if (threadIdx.x == 0) (void)xb_add(&bar[XB_XCNT(b.x)], 1u);
    return b;
}
__device__ __forceinline__ void xcd_barrier_complete(unsigned* bar, unsigned x, unsigned& nloc, unsigned& nx) {
    const unsigned G = gridDim.x * gridDim.y * gridDim.z;
    unsigned sum, cnt, mine, sp = 0u;
    for (;;) {
        sum = 0u; cnt = 0u; mine = 0u;
#pragma unroll
        for (unsigned j = 0; j < 16; ++j) { const unsigned c = xb_ld(&bar[XB_XCNT(j)]); sum += c; cnt += (c > 0u) ? 1u : 0u; mine = (j == x) ? c : mine; }
        if (sum == G) break;
        __builtin_amdgcn_s_sleep(1);
        if ((++sp & 255u) == 0u) { if (xb_ld(&bar[XB_TMO])) break; if (sp > XB_SPIN_CAP) { atomicAdd(&bar[XB_TMO], 1u); break; } }
    }
    nloc = mine > 0u ? mine : 1u; nx = cnt > 0u ? cnt : 1u;
}
__device__ __forceinline__ void xcd_barrier(const XcdBarrier& b) {
    asm volatile("s_waitcnt vmcnt(0)" ::: "memory");
    __syncthreads();
    if (threadIdx.x == 0) {
        unsigned* bar = b.bar;
        __builtin_amdgcn_s_waitcnt(0);
        unsigned nloc = b.st[0], nx = b.st[1];
        if (nloc == 0u) { xcd_barrier_complete(bar, b.x, nloc, nx); b.st[0] = nloc; b.st[1] = nx; }
        const unsigned old = xb_add(&bar[XB_XSUB(b.x)], 1u);
        const unsigned gen = old / nloc;
        if (old + 1u == (gen + 1u) * nloc) {
            __builtin_amdgcn_fence(__ATOMIC_RELEASE, "agent");
            asm volatile("s_waitcnt vmcnt(0)" ::: "memory");
            const unsigned og = xb_add(&bar[XB_TOP], 1u);
            const unsigned tg = og / nx;
            if (og + 1u == (tg + 1u) * nx) xb_add(&bar[XB_TOPGEN], 1u);
            else XB_SPIN(xb_ld(&bar[XB_TOPGEN]) == tg, bar);
            __builtin_amdgcn_fence(__ATOMIC_ACQUIRE, "agent");
            xb_add(&bar[XB_XGEN(b.x)], 1u);
            asm volatile("s_waitcnt vmcnt(0)" ::: "memory");
        } else {
            XB_SPIN(xb_ld(&bar[XB_XGEN(b.x)]) == gen, bar);
            __builtin_amdgcn_fence(__ATOMIC_ACQUIRE, "agent");
            asm volatile("s_waitcnt vmcnt(0)" ::: "memory");
        }
    }
    __syncthreads();
}

__device__ __forceinline__ float wave_sum(float v) {
#pragma unroll
    for (int o = 1; o < 64; o <<= 1) v += __shfl_xor(v, o);
    return v;
}
__device__ __forceinline__ float dot4(f32x4 a) { return (a.x * a.x + a.y * a.y) + (a.z * a.z + a.w * a.w); }

__device__ __forceinline__ void transpose_item(const float* W, int N, bf16* WT, int ldk, int k0, int n0, int drow0, LAS float* scr, int lane) {
#pragma unroll 8
    for (int i = 0; i < 32; ++i) { const int kk = 2 * i + (lane >> 5); scr[kk * 33 + (lane & 31)] = W[(size_t)(k0 + kk) * N + n0 + (lane & 31)]; }
    LDS_WAIT(); asm volatile("" ::: "memory");
    const int c = lane & 7;
#pragma unroll
    for (int j = 0; j < 4; ++j) { const int n = (lane >> 3) + 8 * j; const LAS float* s = scr + (8 * c) * 33 + n;
        v4u o; o.x = cvt_pk_bf16(s[0 * 33], s[1 * 33]); o.y = cvt_pk_bf16(s[2 * 33], s[3 * 33]); o.z = cvt_pk_bf16(s[4 * 33], s[5 * 33]); o.w = cvt_pk_bf16(s[6 * 33], s[7 * 33]);
        *(v4u*)(WT + (size_t)(drow0 + n) * ldk + k0 + 8 * c) = o; }
    LDS_WAIT(); asm volatile("" ::: "memory");
}
template <int DMAP>
__device__ __forceinline__ void transpose_matrix(const float* W, int K, int N, bf16* WT, int ldk, int drow_off, LAS float* scr, int lane, int gw, int NGW, int& itbase) {
    const int nblk = N / 32, nitems = (K / 64) * nblk;
    int it = gw - (itbase % NGW); if (it < 0) it += NGW;
    for (; it < nitems; it += NGW) {
        const int kb = it / nblk, nb = it % nblk, n0 = 32 * nb;
        int drow;
        if (DMAP == 1) { const int isup = n0 >= DFF ? 1 : 0, j = n0 - isup * DFF; drow = (j >> 7) * 256 + isup * 128 + (j & 127); }
        else drow = n0;
        transpose_item(W, N, WT, ldk, 64 * kb, n0, drow_off + drow, scr, lane);
    }
    itbase += nitems;
}

struct Args { const float* in[23]; float* out; unsigned char* ws; int ph_lo, ph_hi, li, pad; };

__global__ void __launch_bounds__(NWAVES * 64, 2) fwd_kernel(Args args) {
    extern __shared__ __attribute__((aligned(16))) unsigned char lds_raw[];
    LAS unsigned char* lds = (LAS unsigned char*)lds_raw;
    volatile LAS unsigned* MISC = (volatile LAS unsigned*)(lds + MISC_OFF);
    const int tid = threadIdx.x, lane = tid & 63, wave = __builtin_amdgcn_readfirstlane(tid >> 6);
    const int G = gridDim.x; const int bx = blockIdx.x; const int vcu = (G % 8 == 0) ? (bx % 8) * (G / 8) + bx / 8 : bx;
    unsigned char* ws = args.ws;
    gu32* ctl = (gu32*)(ws + WS_CTL);
    const float* x = args.in[0]; const float* cvec = args.in[1]; const float* w_ada = args.in[2]; const float* b_ada = args.in[3];
    const float* g_mix_pre = args.in[4]; const float* g_mix_post = args.in[5]; const float* w_in = args.in[6]; const float* conv_w = args.in[7]; const float* conv_b = args.in[8];
    const float* w_rg_a = args.in[9]; const float* b_rg_a = args.in[10]; const float* w_rg_x = args.in[11]; const float* b_rg_x = args.in[12]; const float* lam = args.in[13];
    const float* pool_w = args.in[14]; const float* pool_scale = args.in[15]; const float* w_bl = args.in[16]; const float* w_bp = args.in[17]; const float* w_o = args.in[18];
    const float* g_ffn_pre = args.in[19]; const float* g_ffn_post = args.in[20]; const float* w_gu = args.in[21]; const float* w_dn = args.in[22];
    float* out = args.out;
    float* mod = (float*)(ws + WS_MOD); float* sp8 = (float*)(ws + WS_SP8);
    bf16* Wrg_t = (bf16*)(ws + WS_WRG); bf16* Wpool_t = (bf16*)(ws + WS_WPOOL); bf16* Wbl_t = (bf16*)(ws + WS_WBL); bf16* Wbp_t = (bf16*)(ws + WS_WBP); bf16* Wo_t = (bf16*)(ws + WS_WO);
    bf16* Win_t = (bf16*)(ws + WS_WIN); bf16* Wgu_t = (bf16*)(ws + WS_WGU); bf16* Wdn_t = (bf16*)(ws + WS_WDN);
    bf16* U = (bf16*)(ws + WS_U); bf16* PROJ = (bf16*)(ws + WS_PROJ); bf16* XC = (bf16*)(ws + WS_XC); bf16* POOLED = (bf16*)(ws + WS_POOLED);
    unsigned* AU = (unsigned*)(ws + WS_AU); float* SCP = (float*)(ws + WS_SCANC); float* SCH = SCP + BATCH * SCAN_NC * D;
    bf16* YL = (bf16*)(ws + WS_YL); bf16* YP = (bf16*)(ws + WS_YP); bf16* MERGED = (bf16*)(ws + WS_MERGED); bf16* Y = (bf16*)(ws + WS_Y); bf16* Y2 = (bf16*)(ws + WS_Y2); bf16* H = (bf16*)(ws + WS_H);

    for (int u = tid; u < (LDS_BYTES - LDSCTL_OFF) / 4; u += NWAVES * 64) ((LAS unsigned*)(lds + LDSCTL_OFF))[u] = 0u;
    __syncthreads();
    XcdBarrier bar; bar.bar = (unsigned*)(ctl + CW_BAR) + args.li * XCD_BAR_WORDS; bar.x = 0; bar.st = nullptr;
    if (N_LAUNCHES != NPH) bar = xcd_barrier_post((unsigned*)(ctl + CW_BAR) + args.li * XCD_BAR_WORDS, MISC + 8);
#define GRID_BAR() do { if (N_LAUNCHES != NPH) xcd_barrier(bar); } while (0)
    const int lo = args.ph_lo, hi = args.ph_hi;
#ifndef PH_MASK
#define PH_MASK 0x1fff
#endif
#define IN(k) (((PH_MASK >> (k)) & 1) && lo <= (k) && (k) < hi)
#define BOTH(k) (IN(k) && IN((k) + 1))
    const int gw = vcu * NWAVES + wave, NGW = G * NWAVES;

    if (IN(0)) {
        {
            LAS float* cact = (LAS float*)lds; LAS float* red = (LAS float*)(lds + 32768);
            for (int i = tid; i < BATCH * D; i += NWAVES * 64) { const float v = cvec[i]; cact[i] = pg8::siluf_(v); }
            __syncthreads();
            const int cg = tid % 24, kg = tid / 24;
            for (int g = vcu; g < NMOD / 96; g += G) {
                if (kg < 21) {
                    f32x4 a0 = {0.f, 0.f, 0.f, 0.f}, a1 = {0.f, 0.f, 0.f, 0.f};
                    const float* wp = w_ada + (size_t)g * 96 + cg * 4;
#pragma unroll 8
                    for (int k = kg; k < D; k += 21) { const f32x4 w = *(const f32x4*)(wp + (size_t)k * NMOD); const float c0 = cact[k], c1 = cact[D + k]; a0 += w * c0; a1 += w * c1; }
                    LAS float* rp = red + (kg * 24 + cg) * 8;
                    rp[0] = a0.x; rp[1] = a0.y; rp[2] = a0.z; rp[3] = a0.w; rp[4] = a1.x; rp[5] = a1.y; rp[6] = a1.z; rp[7] = a1.w;
                }
                __syncthreads();
                if (tid < 192) { const int cgo = tid >> 3, r = tid & 7, b = r >> 2, j = r & 3; float s = 0.f;
#pragma unroll
                    for (int q = 0; q < 21; ++q) s += red[(q * 24 + cgo) * 8 + r];
                    const int n = g * 96 + cgo * 4 + j; mod[b * NMOD + n] = s + b_ada[n]; }
                __syncthreads();
            }
        }
        for (int i = bx * NWAVES * 64 + tid; i < D; i += G * NWAVES * 64) { const float l = lam[i]; sp8[i] = -8.0f * log1pf(expf(-l)); }
        {
            LAS float* scr = (LAS float*)(lds + wave * 16384);
            int itbase = 0;
            transpose_matrix<0>(w_in, D, NIN, Win_t, D, 0, scr, lane, gw, NGW, itbase);
            for (int h = 0; h < HEADS; ++h) {
                const int nblk = HD / 32, nitems = (HD / 64) * nblk * 2;
                int it = gw - (itbase % NGW); if (it < 0) it += NGW;
                for (; it < nitems; it += NGW) { const int which = it / ((HD / 64) * nblk), r = it % ((HD / 64) * nblk), kb = r / nblk, nb = r % nblk, n0 = 32 * nb;
                    const float* W = (which ? w_rg_x : w_rg_a) + (size_t)h * HD * HD;
                    transpose_item(W, HD, Wrg_t, HD, 64 * kb, n0, h * 512 + (n0 >> 7) * 256 + which * 128 + (n0 & 127), scr, lane); }
                itbase += nitems;
            }
            for (int gi = 0; gi < PGRP; ++gi) transpose_matrix<0>(pool_w + (size_t)gi * PGD * PGD, PGD, PGD, Wpool_t, PGD, gi * PGD, scr, lane, gw, NGW, itbase);
            transpose_matrix<0>(w_bl, D, D, Wbl_t, D, 0, scr, lane, gw, NGW, itbase);
            transpose_matrix<0>(w_bp, D, D, Wbp_t, D, 0, scr, lane, gw, NGW, itbase);
            transpose_matrix<0>(w_o, D, D, Wo_t, D, 0, scr, lane, gw, NGW, itbase);
        }
        if (BOTH(0)) GRID_BAR();
    }

    if (IN(1)) {
        LAS float* cA = (LAS float*)lds; LAS float* cB = cA + D;
        int cur_b = -1;
        for (int chunk = vcu; chunk < M / 64; chunk += G) {
            const int b = chunk / (SEQ / 64);
            if (b != cur_b) { __syncthreads();
                for (int i = tid; i < D; i += NWAVES * 64) { cA[i] = g_mix_pre[i] * (1.0f + mod[b * NMOD + 1 * D + i]); cB[i] = mod[b * NMOD + 0 * D + i]; }
                __syncthreads(); cur_b = b; }
            for (int r = wave; r < 64; r += NWAVES) { const size_t row = (size_t)chunk * 64 + r;
                const f32x4* xr = (const f32x4*)(x + row * D) + lane;
                f32x4 v[16]; float s = 0.f;
#pragma unroll
                for (int j = 0; j < 16; ++j) { v[j] = xr[64 * j]; s += dot4(v[j]); }
                const float rstd = 1.0f / sqrtf(wave_sum(s) * (1.0f / D) + RMS_EPS);
                v2u* o8 = (v2u*)(U + row * D) + lane;
#pragma unroll
                for (int j = 0; j < 16; ++j) { const f32x4 a = ((const LAS f32x4*)cA)[lane + 64 * j], bb = ((const LAS f32x4*)cB)[lane + 64 * j]; const f32x4 o = v[j] * rstd * a + bb;
                    v2u w; w.x = cvt_pk_bf16(o.x, o.y); w.y = cvt_pk_bf16(o.z, o.w); o8[64 * j] = w; }
            }
        }
        if (BOTH(1)) GRID_BAR();
    }

    if (IN(2)) {
        pg8::Gemm g{U, Win_t, M, NIN, D, D, D, 30}; pg8::StaticOrder S; S.init(M, NIN, G, bx);
        pg8::EpiPlain E{PROJ, NIN};
        pg8::gemm_phase<pg8::EpiPlain, pg8::StaticOrder, true, true>(lds + RING_OFF, g, S, E);
        if (BOTH(2)) GRID_BAR();
    }

    if (IN(3)) {
        const int ch0 = tid * 8;
        float cw[4][8], cb[8];
#pragma unroll
        for (int k = 0; k < 4; ++k) { const f32x4 a = *(const f32x4*)(conv_w + k * D + ch0), b = *(const f32x4*)(conv_w + k * D + ch0 + 4);
            cw[k][0] = a.x; cw[k][1] = a.y; cw[k][2] = a.z; cw[k][3] = a.w; cw[k][4] = b.x; cw[k][5] = b.y; cw[k][6] = b.z; cw[k][7] = b.w; }
        { const f32x4 a = *(const f32x4*)(conv_b + ch0), b = *(const f32x4*)(conv_b + ch0 + 4); cb[0] = a.x; cb[1] = a.y; cb[2] = a.z; cb[3] = a.w; cb[4] = b.x; cb[5] = b.y; cb[6] = b.z; cb[7] = b.w; }
        const int pw = 2 << (tid >> 7);
        for (int chunk = vcu; chunk < M / 64; chunk += G) {
#pragma unroll 2
            for (int r = 0; r < 64; ++r) { const size_t m = (size_t)chunk * 64 + r; const int t = (int)(m % SEQ);
                const bf16* pr = PROJ + m * NIN + ch0;
                float a[8];
#pragma unroll
                for (int j = 0; j < 8; ++j) a[j] = cb[j];
#pragma unroll
                for (int k = 0; k < 4; ++k) { if (t - 3 + k >= 0) { const v4u q = *(const v4u*)(pr - (ptrdiff_t)(3 - k) * NIN);
                    a[0] += cw[k][0] * bf_lo(q.x); a[1] += cw[k][1] * bf_hi(q.x); a[2] += cw[k][2] * bf_lo(q.y); a[3] += cw[k][3] * bf_hi(q.y);
                    a[4] += cw[k][4] * bf_lo(q.z); a[5] += cw[k][5] * bf_hi(q.z); a[6] += cw[k][6] * bf_lo(q.w); a[7] += cw[k][7] * bf_hi(q.w); } }
                { v4u o; o.x = cvt_pk_bf16(a[0], a[1]); o.y = cvt_pk_bf16(a[2], a[3]); o.z = cvt_pk_bf16(a[4], a[5]); o.w = cvt_pk_bf16(a[6], a[7]); *(v4u*)(XC + m * D + ch0) = o; }
                const bf16* pp = pr + 2 * D;
                const int cnt = (t + 1 < pw) ? (t + 1) : pw;
                float s[8], p0[8];
#pragma unroll
                for (int j = 0; j < 8; ++j) s[j] = 0.f;
#pragma unroll
                for (int q = 0; q < 16; ++q) { if (q < cnt) { const v4u w = *(const v4u*)(pp - (ptrdiff_t)q * NIN);
                    const float f[8] = {bf_lo(w.x), bf_hi(w.x), bf_lo(w.y), bf_hi(w.y), bf_lo(w.z), bf_hi(w.z), bf_lo(w.w), bf_hi(w.w)};
#pragma unroll
                    for (int j = 0; j < 8; ++j) { s[j] += f[j]; if (q == 0) p0[j] = f[j]; } } }
                const float inv = 1.0f / (float)cnt;
                { v4u o; o.x = cvt_pk_bf16(s[0] * inv - p0[0], s[1] * inv - p0[1]); o.y = cvt_pk_bf16(s[2] * inv - p0[2], s[3] * inv - p0[3]);
                  o.z = cvt_pk_bf16(s[4] * inv - p0[4], s[5] * inv - p0[5]); o.w = cvt_pk_bf16(s[6] * inv - p0[6], s[7] * inv - p0[7]); *(v4u*)(POOLED + m * D + ch0) = o; }
            }
        }
        if (BOTH(3)) GRID_BAR();
    }

    if (IN(4)) {
#ifndef P4_NO_RG
        { pg8::Gemm g{XC, Wrg_t, M, HEADS * 512, HD, D, HD, 1}; pg8::StaticOrder S; S.init(M, HEADS * 512, G, bx);
          pg8::EpiRg E{XC, AU, b_rg_a, b_rg_x, sp8, D};
          pg8::gemm_phase<pg8::EpiRg, pg8::StaticOrder, true, true>(lds + RING_OFF, g, S, E); }
#endif
#ifndef P4_NO_POOL
        { pg8::Gemm g{POOLED, Wpool_t, M, D, PGD, D, PGD, 2}; pg8::StaticOrder S; S.init(M, D, G, bx);
          pg8::EpiScale E{YP, D, pool_scale};
          pg8::gemm_phase<pg8::EpiScale, pg8::StaticOrder, true, true>(lds + RING_OFF, g, S, E); }
#endif
        if (BOTH(4)) GRID_BAR();
    }

    if (IN(5)) {
        for (int id = gw; id < BATCH * SCAN_NC * 32; id += NGW) { const int cgp = id & 31, chunk = (id >> 5) % SCAN_NC, b = id / (32 * SCAN_NC);
            const int ch = cgp * 128 + lane * 2; const size_t row0 = (size_t)b * SEQ + (size_t)chunk * SCAN_T;
            const v2u* p = (const v2u*)(AU + row0 * D + ch);
            float S0 = 0.f, S1 = 0.f, h0 = 0.f, h1 = 0.f;
#pragma unroll 16
            for (int r = 0; r < SCAN_T; ++r) { const v2u w = p[(size_t)r * (D / 2)];
                const float l0 = bf_lo(w.x), u0 = bf_hi(w.x), l1 = bf_lo(w.y), u1 = bf_hi(w.y);
                h0 = pg8::fast_exp(l0) * h0 + u0; h1 = pg8::fast_exp(l1) * h1 + u1; S0 += l0; S1 += l1; }
            const size_t o = ((size_t)(b * SCAN_NC + chunk)) * D + ch;
            *(f32x2*)(SCP + o) = (f32x2){pg8::fast_exp(S0), pg8::fast_exp(S1)}; *(f32x2*)(SCH + o) = (f32x2){h0, h1};
        }
        if (BOTH(5)) GRID_BAR();
    }

    if (IN(6)) {
        for (int id = gw; id < BATCH * SCAN_NC * 32; id += NGW) { const int cgp = id & 31, chunk = (id >> 5) % SCAN_NC, b = id / (32 * SCAN_NC);
            const int ch = cgp * 128 + lane * 2; const size_t row0 = (size_t)b * SEQ + (size_t)chunk * SCAN_T;
            float h0 = 0.f, h1 = 0.f;
            for (int c = 0; c < chunk; ++c) { const size_t o = ((size_t)(b * SCAN_NC + c)) * D + ch; const f32x2 P = *(const f32x2*)(SCP + o), Hh = *(const f32x2*)(SCH + o);
                h0 = P.x * h0 + Hh.x; h1 = P.y * h1 + Hh.y; }
            const v2u* p = (const v2u*)(AU + row0 * D + ch); const unsigned* gp = (const unsigned*)(PROJ + row0 * NIN + D + ch); unsigned* yo = (unsigned*)(YL + row0 * D + ch);
#pragma unroll 16
            for (int r = 0; r < SCAN_T; ++r) { const v2u w = p[(size_t)r * (D / 2)]; const unsigned gq = gp[(size_t)r * (NIN / 2)];
                const float l0 = bf_lo(w.x), u0 = bf_hi(w.x), l1 = bf_lo(w.y), u1 = bf_hi(w.y);
                h0 = pg8::fast_exp(l0) * h0 + u0; h1 = pg8::fast_exp(l1) * h1 + u1;
                yo[(size_t)r * (D / 2)] = cvt_pk_bf16(h0 * pg8::gelu_tanh_(bf_lo(gq)), h1 * pg8::gelu_tanh_(bf_hi(gq))); }
        }
        if (BOTH(6)) GRID_BAR();
    }

    if (IN(7)) {
        { pg8::Gemm g{YL, Wbl_t, M, D, D, D, D, 30}; pg8::StaticOrder S; S.init(M, D, G, bx);
          pg8::EpiGate<false> E{MERGED, D, PROJ + 3 * D, NIN};
          pg8::gemm_phase<pg8::EpiGate<false>, pg8::StaticOrder, true, true>(lds + RING_OFF, g, S, E); }
        { pg8::Gemm g{YP, Wbp_t, M, D, D, D, D, 30}; pg8::StaticOrder S; S.init(M, D, G, bx);
          pg8::EpiGate<true> E{MERGED, D, PROJ + 4 * D, NIN};
          pg8::gemm_phase<pg8::EpiGate<true>, pg8::StaticOrder, true, true>(lds + RING_OFF, g, S, E); }
        if (BOTH(7)) GRID_BAR();
    }

    if (IN(8)) {
        pg8::Gemm g{MERGED, Wo_t, M, D, D, D, D, 30}; pg8::StaticOrder S; S.init(M, D, G, bx);
        pg8::EpiPlain E{Y, D};
        pg8::gemm_phase<pg8::EpiPlain, pg8::StaticOrder, true, true>(lds + RING_OFF, g, S, E);
        if (BOTH(8)) GRID_BAR();
    }

    if (IN(9)) {
        {
            LAS float* cG = (LAS float*)lds; LAS float* cA = cG + D; LAS float* cB = cA + D;
            int cur_b = -1;
            for (int chunk = vcu; chunk < M / 64; chunk += G) {
                const int b = chunk / (SEQ / 64);
                if (b != cur_b) { __syncthreads();
                    for (int i = tid; i < D; i += NWAVES * 64) { cG[i] = mod[b * NMOD + 2 * D + i] * g_mix_post[i]; cA[i] = g_ffn_pre[i] * (1.0f + mod[b * NMOD + 4 * D + i]); cB[i] = mod[b * NMOD + 3 * D + i]; }
                    __syncthreads(); cur_b = b; }
                for (int r = wave; r < 64; r += NWAVES) { const size_t row = (size_t)chunk * 64 + r;
                    const f32x4* xr = (const f32x4*)(x + row * D) + lane; const v2u* yr = (const v2u*)(Y + row * D) + lane;
                    f32x4 v[16]; v2u yv[16]; float sy = 0.f;
#pragma unroll
                    for (int j = 0; j < 16; ++j) { v[j] = xr[64 * j]; yv[j] = yr[64 * j]; }
#pragma unroll
                    for (int j = 0; j < 16; ++j) { const f32x4 y = {bf_lo(yv[j].x), bf_hi(yv[j].x), bf_lo(yv[j].y), bf_hi(yv[j].y)}; sy += dot4(y); }
                    const float rstdy = 1.0f / sqrtf(wave_sum(sy) * (1.0f / D) + RMS_EPS);
                    float s1 = 0.f; f32x4* orow = (f32x4*)(out + row * D) + lane;
#pragma unroll
                    for (int j = 0; j < 16; ++j) { const f32x4 y = {bf_lo(yv[j].x), bf_hi(yv[j].x), bf_lo(yv[j].y), bf_hi(yv[j].y)}; const f32x4 gq = ((const LAS f32x4*)cG)[lane + 64 * j];
                        v[j] = v[j] + gq * (y * rstdy); s1 += dot4(v[j]); orow[64 * j] = v[j]; }
                    const float rstd1 = 1.0f / sqrtf(wave_sum(s1) * (1.0f / D) + RMS_EPS);
                    v2u* o8 = (v2u*)(U + row * D) + lane;
#pragma unroll
                    for (int j = 0; j < 16; ++j) { const f32x4 a = ((const LAS f32x4*)cA)[lane + 64 * j], bb = ((const LAS f32x4*)cB)[lane + 64 * j]; const f32x4 o = v[j] * rstd1 * a + bb;
                        v2u w; w.x = cvt_pk_bf16(o.x, o.y); w.y = cvt_pk_bf16(o.z, o.w); o8[64 * j] = w; }
                }
            }
        }
        __syncthreads();
        {
            LAS float* scr = (LAS float*)(lds + wave * 16384);
            int itbase = 0;
            transpose_matrix<1>(w_gu, D, NGU, Wgu_t, D, 0, scr, lane, gw, NGW, itbase);
            transpose_matrix<0>(w_dn, DFF, D, Wdn_t, DFF, 0, scr, lane, gw, NGW, itbase);
        }
        if (BOTH(9)) GRID_BAR();
    }

    if (IN(10)) {
        pg8::Gemm g{U, Wgu_t, M, NGU, D, D, D, 30}; pg8::StaticOrder S; S.init(M, NGU, G, bx);
        pg8::EpiSwiglu E{H, DFF};
        pg8::gemm_phase<pg8::EpiSwiglu, pg8::StaticOrder, true, true>(lds + RING_OFF, g, S, E);
        if (BOTH(10)) GRID_BAR();
    }

    if (IN(11)) {
        pg8::Gemm g{H, Wdn_t, M, D, DFF, DFF, DFF, 30}; pg8::StaticOrder S; S.init(M, D, G, bx);
        pg8::EpiPlain E{Y2, D};
        pg8::gemm_phase<pg8::EpiPlain, pg8::StaticOrder, true, true>(lds + RING_OFF, g, S, E);
        if (BOTH(11)) GRID_BAR();
    }

    if (IN(12)) {
        LAS float* cG = (LAS float*)lds;
        int cur_b = -1;
        for (int chunk = vcu; chunk < M / 64; chunk += G) {
            const int b = chunk / (SEQ / 64);
            if (b != cur_b) { __syncthreads();
                for (int i = tid; i < D; i += NWAVES * 64) cG[i] = mod[b * NMOD + 5 * D + i] * g_ffn_post[i];
                __syncthreads(); cur_b = b; }
            for (int r = wave; r < 64; r += NWAVES) { const size_t row = (size_t)chunk * 64 + r;
                f32x4* xr = (f32x4*)(out + row * D) + lane; const v2u* yr = (const v2u*)(Y2 + row * D) + lane;
                f32x4 v[16]; v2u yv[16]; float sy = 0.f;
#pragma unroll
                for (int j = 0; j < 16; ++j) { v[j] = xr[64 * j]; yv[j] = yr[64 * j]; }
#pragma unroll
                for (int j = 0; j < 16; ++j) { const f32x4 y = {bf_lo(yv[j].x), bf_hi(yv[j].x), bf_lo(yv[j].y), bf_hi(yv[j].y)}; sy += dot4(y); }
                const float rstdy = 1.0f / sqrtf(wave_sum(sy) * (1.0f / D) + RMS_EPS);
#pragma unroll
                for (int j = 0; j < 16; ++j) { const f32x4 y = {bf_lo(yv[j].x), bf_hi(yv[j].x), bf_lo(yv[j].y), bf_hi(yv[j].y)}; const f32x4 gq = ((const LAS f32x4*)cG)[lane + 64 * j];
                    xr[64 * j] = v[j] + gq * (y * rstdy); }
            }
        }
    }
#undef IN
#undef BOTH
#undef GRID_BAR
}

extern "C" void kernel_launch(void* const* d_in, const int* in_sizes, int n_in, void* d_out, int out_size, void* d_ws, size_t ws_size, hipStream_t stream) {
    static int grid = 0;
    if (grid == 0) {
        if (n_in != 23 || in_sizes[0] != M * D || out_size != M * D || ws_size < WS_END) {
            fprintf(stderr, "kernel_launch: built for 23 inputs, x/out of %d floats, >= %zu bytes of workspace; got n_in %d, in0 %d, out %d, ws %zu; nothing launched\n", M * D, (size_t)WS_END, n_in, n_in > 0 ? in_sizes[0] : -1, out_size, ws_size);
            grid = -1; return; }
        int dev = 0, cus = 0, per_cu = 0;
        if (hipGetDevice(&dev) != hipSuccess || hipDeviceGetAttribute(&cus, hipDeviceAttributeMultiprocessorCount, dev) != hipSuccess) { fprintf(stderr, "kernel_launch: device query failed\n"); grid = -1; return; }
        if (hipFuncSetAttribute((const void*)fwd_kernel, hipFuncAttributeMaxDynamicSharedMemorySize, LDS_BYTES) != hipSuccess) { fprintf(stderr, "kernel_launch: hipFuncSetAttribute failed\n"); grid = -1; return; }
        if (hipOccupancyMaxActiveBlocksPerMultiprocessor(&per_cu, (const void*)fwd_kernel, NWAVES * 64, LDS_BYTES) != hipSuccess || per_cu < 1)
            fprintf(stderr, "kernel_launch: note: occupancy query reports %d workgroups per CU\n", per_cu);
        (void)hipGetLastError();
        grid = cus;
    }
    if (grid < 0) return;
    if (hipMemsetAsync((char*)d_ws + WS_CTL, 0, CTL_ZERO_BYTES, stream) != hipSuccess) { fprintf(stderr, "kernel_launch: memset failed\n"); return; }
    Args a{};
    for (int i = 0; i < 23; ++i) a.in[i] = (const float*)d_in[i];
    a.out = (float*)d_out; a.ws = (unsigned char*)d_ws; a.pad = 0;
    for (int li = 0; li < N_LAUNCHES; ++li) {
        a.ph_lo = (N_LAUNCHES == NPH) ? li : (li * NPH) / N_LAUNCHES; a.ph_hi = (N_LAUNCHES == NPH) ? li + 1 : ((li + 1) * NPH) / N_LAUNCHES; a.li = li;
        hipLaunchKernelGGL(fwd_kernel, dim3(grid), dim3(NWAVES * 64), LDS_BYTES, stream, a);
        const hipError_t le = hipPeekAtLastError();
        if (le != hipSuccess) { fprintf(stderr, "kernel_launch: launch %d failed: %s\n", li, hipGetErrorName(le)); break; }
    }
}
```

```cpp
#include <hip/hip_runtime.h>
#include <cstdio>
#include <cstdint>

#ifndef MK_N_LAUNCHES
#define MK_N_LAUNCHES 1
#endif

namespace pg8 {
#define PG8_LAS __attribute__((address_space(3)))
typedef unsigned short bf16_t;
typedef short bf16x8 __attribute__((ext_vector_type(8)));
typedef float f32x4 __attribute__((ext_vector_type(4)));
typedef unsigned u32x4 __attribute__((ext_vector_type(4)));
typedef unsigned u32x2 __attribute__((ext_vector_type(2)));
constexpr int BM = 256, BK = 64, HALF = 128, HTB = HALF * BK * 2  , STAGE_BYTES = 8 * HTB, NXCD = 8, WGM = 8;

__host__ __device__ __forceinline__ int lds_byte(int r, int c) { const int st = (r >> 4) * 2 + (c >> 5), rr = r & 15, cc = c & 31, ob = rr * 64 + cc * 2; return st * 1024 + (ob ^ (((ob >> 9) & 1) << 5)); }
__host__ __device__ __forceinline__ void stage_rc(int b, int& R, int& C) { const int st = b / 1024, sb = b % 1024, swz = sb ^ (((sb >> 9) & 1) << 5); R = (st >> 1) * 16 + swz / 64; C = (st & 1) * 32 + (swz % 64) / 2; }
__host__ __device__ __forceinline__ int perm32(int rho) { const int n = rho >> 4, i = rho & 15; return 8 * (i >> 2) + 4 * n + (i & 3); }

struct Unit { int pm, pn; };
struct Gemm { const bf16_t* A; const bf16_t* Bt; int M, N, K, lda, ldb, agshift; };

struct StaticOrder {
    int nM, nN, nwg, G, c;
    __host__ __device__ void init(int M, int N, int G_, int c_) { nM = M / BM; nN = N / BM; nwg = nM * nN; G = G_; c = c_; }
    __host__ __device__ bool next(int i, Unit& u) const {
        const long L = (long)i * G + c; if (L >= nwg) return false;
        int wgid = (int)L; { const int q = nwg / NXCD, r = nwg % NXCD, xcd = wgid % NXCD, off = wgid / NXCD; wgid = (xcd < r ? xcd * (q + 1) : r * (q + 1) + (xcd - r) * q) + off; }
        const int nig = WGM * nN, gid = wgid / nig, fm = gid * WGM, gsz = (nM - fm) < WGM ? (nM - fm) : WGM;
        u.pm = fm + ((wgid % nig) % gsz); u.pn = (wgid % nig) / gsz; return true;
    }
    __device__ __forceinline__ void a_ready(const Unit&) const {}
    __device__ __forceinline__ void done(const Unit&) const {}
};

struct FixedOrder : StaticOrder {
    __host__ __device__ bool next(int i, Unit& u) const { const bool ok = StaticOrder::next(i, u); u.pm = 0; u.pn = 0; return ok; }
};
__device__ __forceinline__ unsigned cvt_pk_bf16(float lo, float hi) { unsigned r; asm volatile("v_cvt_pk_bf16_f32 %0, %1, %2" : "=v"(r) : "v"(lo), "v"(hi)); return r; }
__device__ __forceinline__ float bf_lo(unsigned w) { return __uint_as_float(w << 16); }
__device__ __forceinline__ float bf_hi(unsigned w) { return __uint_as_float(w & 0xffff0000u); }
__device__ __forceinline__ float fast_rcp(float x) { return __builtin_amdgcn_rcpf(x); }
__device__ __forceinline__ float fast_exp(float x) { return __builtin_amdgcn_exp2f(x * 1.44269504088896f); }
__device__ __forceinline__ float sigmoidf_(float x) { return fast_rcp(1.0f + fast_exp(-x)); }
__device__ __forceinline__ float siluf_(float x) { return x * sigmoidf_(x); }
__device__ __forceinline__ float gelu_tanh_(float x) { const float z = 1.5957691216057308f * (x + 0.044715f * x * x * x); return x * sigmoidf_(z); }

struct EpiPlain {
    static constexpr bool PERM = true;
    bf16_t* O; int ldc;
    __device__ __forceinline__ void operator()(const f32x4 (&acc)[2][2][4][2], const Unit& u, int wr, int wc, int fr, int fq) const {
        const int row0 = u.pm * BM + wr * 64 + fr, col0 = u.pn * BM + wc * 32 + 8 * fq;
#pragma unroll
        for (int ai = 0; ai < 2; ++ai)
#pragma unroll
            for (int m = 0; m < 4; ++m) { bf16_t* rowp = O + (size_t)(row0 + ai * HALF + m * 16) * ldc + col0;
#pragma unroll
                for (int bj = 0; bj < 2; ++bj) { const f32x4 v0 = acc[ai][bj][m][0], v1 = acc[ai][bj][m][1];
                    u32x4 w; w.x = cvt_pk_bf16(v0[0], v0[1]); w.y = cvt_pk_bf16(v0[2], v0[3]); w.z = cvt_pk_bf16(v1[0], v1[1]); w.w = cvt_pk_bf16(v1[2], v1[3]);
                    *(u32x4*)(rowp + bj * HALF) = w; } }
    }
};
struct EpiScale {
    static constexpr bool PERM = true;
    bf16_t* O; int ldc; const float* scale;
    __device__ __forceinline__ void operator()(const f32x4 (&acc)[2][2][4][2], const Unit& u, int wr, int wc, int fr, int fq) const {
        const int row0 = u.pm * BM + wr * 64 + fr, col0 = u.pn * BM + wc * 32 + 8 * fq;
        f32x4 sv[2][2];
#pragma unroll
        for (int bj = 0; bj < 2; ++bj)
#pragma unroll
            for (int n = 0; n < 2; ++n) sv[bj][n] = *(const f32x4*)(scale + col0 + bj * HALF + 4 * n);
#pragma unroll
        for (int ai = 0; ai < 2; ++ai)
#pragma unroll
            for (int m = 0; m < 4; ++m) { bf16_t* rowp = O + (size_t)(row0 + ai * HALF + m * 16) * ldc + col0;
#pragma unroll
                for (int bj = 0; bj < 2; ++bj) { const f32x4 v0 = acc[ai][bj][m][0] * sv[bj][0], v1 = acc[ai][bj][m][1] * sv[bj][1];
                    u32x4 w; w.x = cvt_pk_bf16(v0[0], v0[1]); w.y = cvt_pk_bf16(v0[2], v0[3]); w.z = cvt_pk_bf16(v1[0], v1[1]); w.w = cvt_pk_bf16(v1[2], v1[3]);
                    *(u32x4*)(rowp + bj * HALF) = w; } }
    }
};
template <bool ADD> struct EpiGate {
    static constexpr bool PERM = true;
    bf16_t* O; int ldc; const bf16_t* Gt; int ldg;
    __device__ __forceinline__ void operator()(const f32x4 (&acc)[2][2][4][2], const Unit& u, int wr, int wc, int fr, int fq) const {
        const int row0 = u.pm * BM + wr * 64 + fr, col0 = u.pn * BM + wc * 32 + 8 * fq;
#pragma unroll
        for (int ai = 0; ai < 2; ++ai)
#pragma unroll
            for (int m = 0; m < 4; ++m) { const size_t row = (size_t)(row0 + ai * HALF + m * 16); bf16_t* rowp = O + row * ldc + col0; const bf16_t* gp = Gt + row * ldg + col0;
#pragma unroll
                for (int bj = 0; bj < 2; ++bj) { const u32x4 g = *(const u32x4*)(gp + bj * HALF); const f32x4 v0 = acc[ai][bj][m][0], v1 = acc[ai][bj][m][1];
                    float o[8];
                    o[0] = sigmoidf_(bf_lo(g.x)) * v0[0]; o[1] = sigmoidf_(bf_hi(g.x)) * v0[1]; o[2] = sigmoidf_(bf_lo(g.y)) * v0[2]; o[3] = sigmoidf_(bf_hi(g.y)) * v0[3];
                    o[4] = sigmoidf_(bf_lo(g.z)) * v1[0]; o[5] = sigmoidf_(bf_hi(g.z)) * v1[1]; o[6] = sigmoidf_(bf_lo(g.w)) * v1[2]; o[7] = sigmoidf_(bf_hi(g.w)) * v1[3];
                    if (ADD) { const u32x4 p = *(const u32x4*)(rowp + bj * HALF);
                        o[0] += bf_lo(p.x); o[1] += bf_hi(p.x); o[2] += bf_lo(p.y); o[3] += bf_hi(p.y); o[4] += bf_lo(p.z); o[5] += bf_hi(p.z); o[6] += bf_lo(p.w); o[7] += bf_hi(p.w); }
                    u32x4 w; w.x = cvt_pk_bf16(o[0], o[1]); w.y = cvt_pk_bf16(o[2], o[3]); w.z = cvt_pk_bf16(o[4], o[5]); w.w = cvt_pk_bf16(o[6], o[7]);
                    *(u32x4*)(rowp + bj * HALF) = w; }
                asm volatile("" ::: "memory"); }
    }
};
struct EpiSwiglu {
    static constexpr bool PERM = true;
    bf16_t* O; int ldc;
    __device__ __forceinline__ void operator()(const f32x4 (&acc)[2][2][4][2], const Unit& u, int wr, int wc, int fr, int fq) const {
        const int row0 = u.pm * BM + wr * 64 + fr, col0 = u.pn * HALF + wc * 32 + 8 * fq;
#pragma unroll
        for (int ai = 0; ai < 2; ++ai)
#pragma unroll
            for (int m = 0; m < 4; ++m) { bf16_t* rowp = O + (size_t)(row0 + ai * HALF + m * 16) * ldc + col0;
                const f32x4 g0 = acc[ai][0][m][0], g1 = acc[ai][0][m][1], u0 = acc[ai][1][m][0], u1 = acc[ai][1][m][1];
                u32x4 w; w.x = cvt_pk_bf16(siluf_(g0[0]) * u0[0], siluf_(g0[1]) * u0[1]); w.y = cvt_pk_bf16(siluf_(g0[2]) * u0[2], siluf_(g0[3]) * u0[3]);
                w.z = cvt_pk_bf16(siluf_(g1[0]) * u1[0], siluf_(g1[1]) * u1[1]); w.w = cvt_pk_bf16(siluf_(g1[2]) * u1[2], siluf_(g1[3]) * u1[3]);
                *(u32x4*)rowp = w; }
    }
};
struct EpiRg {
    static constexpr bool PERM = false;
    const bf16_t* XC; unsigned* AU; const float* b_a; const float* b_x; const float* sp8; int ldx;
    __device__ __forceinline__ void operator()(const f32x4 (&acc)[2][2][4][2], const Unit& u, int wr, int wc, int fr, int fq) const {
        const int row0 = u.pm * BM + wr * 64 + fr, chb = u.pn * HALF + wc * 32 + 4 * fq;
#pragma unroll
        for (int n = 0; n < 2; ++n) { const int ch = chb + 16 * n;
            const f32x4 ba = *(const f32x4*)(b_a + ch), bx = *(const f32x4*)(b_x + ch), sp = *(const f32x4*)(sp8 + ch);
#pragma unroll
            for (int ai = 0; ai < 2; ++ai)
#pragma unroll
                for (int m = 0; m < 4; ++m) { const size_t row = (size_t)(row0 + ai * HALF + m * 16);
                    const u32x2 xw = *(const u32x2*)(XC + row * ldx + ch);
                    const float xv[4] = {bf_lo(xw.x), bf_hi(xw.x), bf_lo(xw.y), bf_hi(xw.y)};
                    const f32x4 rp = acc[ai][0][m][n] + ba, ip = acc[ai][1][m][n] + bx;
                    unsigned w[4];
#pragma unroll
                    for (int j = 0; j < 4; ++j) { const float r = sigmoidf_(rp[j]), ig = sigmoidf_(ip[j]); const float la = sp[j] * r, x2 = la + la;
                        const float poly = x2 * (1.0f + x2 * (0.5f + x2 * (0.16666667f + x2 * (0.041666668f + x2 * (0.0083333338f + x2 * 0.0013888889f)))));
                        const float em1 = (x2 > -0.25f) ? poly : (fast_exp(x2) - 1.0f);
                        const float mult = __builtin_sqrtf(fmaxf(-em1, 0.0f));
                        w[j] = cvt_pk_bf16(la, mult * ig * xv[j]); }
                    u32x4 o; o.x = w[0]; o.y = w[1]; o.z = w[2]; o.w = w[3];
                    *(u32x4*)(AU + row * ldx + ch) = o;
                    asm volatile("" ::: "memory"); __builtin_amdgcn_sched_barrier(0); } }
    }
};

template <class Epi, class Sched, bool ALIGN_EPI = false, bool SP2 = false>
__device__ __forceinline__ void gemm_phase(PG8_LAS unsigned char* lds, const Gemm g, const Sched& S, const Epi& E) {
    const int tid = threadIdx.x, wid = __builtin_amdgcn_readfirstlane(tid >> 6), lane = tid & 63, wr = wid >> 2, wc = wid & 3, fr = lane & 15, fq = lane >> 4;
    const int K = g.K, nt = K / BK;
    unsigned voffA[2], voffB[2];
#pragma unroll
    for (int i = 0; i < 2; ++i) { int R, C; stage_rc(tid * 16 + i * 8192, R, C); const int Rb = Epi::PERM ? ((R & ~31) + perm32(R & 31)) : R;
        voffA[i] = (unsigned)(R * g.lda + C) * 2u; voffB[i] = (unsigned)(Rb * g.ldb + C) * 2u; }
    const size_t kstep = (size_t)(BK * 2);
    const size_t hstepA = (size_t)HALF * g.lda * 2, hstepB = (size_t)HALF * g.ldb * 2;
    const size_t tstepA = 2 * hstepA, tstepB = 2 * hstepB;
    const unsigned ldsw = (unsigned)wid * 1024u;
    const int aoff = lds_byte(wr * 64 + fr, fq * 8), boff = lds_byte(wc * 32 + fr, fq * 8);
#define PG8_SA(b, h) (((b) * 2 + (h)) * HTB)
#define PG8_SB(b, h) ((4 + (b) * 2 + (h)) * HTB)
#define PG8_STAGE(bufoff, gbase, voff) do { _Pragma("unroll") for (int _i = 0; _i < 2; ++_i) \
        __builtin_amdgcn_global_load_lds((const unsigned*)((const char*)(gbase) + (voff)[_i]), (PG8_LAS unsigned*)(lds + (bufoff) + ldsw + _i * 8192), 16, 0, 0); } while (0)
#define PG8_LDA(dst, b, h) do { _Pragma("unroll") for (int m = 0; m < 4; ++m) _Pragma("unroll") for (int k = 0; k < 2; ++k) dst[m][k] = *(const PG8_LAS bf16x8*)(lds + PG8_SA(b, h) + aoff + m * 2048 + k * 1024); } while (0)
#define PG8_LDB(dst, b, h) do { _Pragma("unroll") for (int n = 0; n < 2; ++n) _Pragma("unroll") for (int k = 0; k < 2; ++k) dst[n][k] = *(const PG8_LAS bf16x8*)(lds + PG8_SB(b, h) + boff + n * 2048 + k * 1024); } while (0)
#define PG8_MMA(ai, bj, At, Bt) do { __builtin_amdgcn_s_setprio(1); _Pragma("unroll") for (int m = 0; m < 4; ++m) _Pragma("unroll") for (int n = 0; n < 2; ++n) _Pragma("unroll") for (int k = 0; k < 2; ++k) \
        acc[ai][bj][m][n] = __builtin_amdgcn_mfma_f32_16x16x32_bf16(Bt[n][k], At[m][k], acc[ai][bj][m][n], 0, 0, 0); __builtin_amdgcn_s_setprio(0); } while (0)
#define PG8_WAIT_V(n) asm volatile("s_waitcnt vmcnt(" #n ")" ::: "memory")
#define PG8_WAIT_L(n) asm volatile("s_waitcnt lgkmcnt(" #n ")" ::: "memory")
#define PG8_BAR __builtin_amdgcn_s_barrier()
#define PG8_SCHED __builtin_amdgcn_sched_barrier(0)
#define PG8_ABASE(u) ((const char*)g.A + (size_t)(u).pm * tstepA + (size_t)((u).pn >> g.agshift) * (size_t)K * 2)
#define PG8_BBASE(u) ((const char*)g.Bt + (size_t)(u).pn * tstepB)
    Unit cur, nxt; int ui = 0;
    if (!S.next(0, cur)) return;
    f32x4 acc[2][2][4][2];
#pragma unroll
    for (int a = 0; a < 2; ++a)
#pragma unroll
        for (int b = 0; b < 2; ++b)
#pragma unroll
            for (int m = 0; m < 4; ++m)
#pragma unroll
                for (int n = 0; n < 2; ++n) acc[a][b][m][n] = (f32x4){0.f, 0.f, 0.f, 0.f};
    bf16x8 At[4][2], B0[2][2], B1[2][2];
    const char* cA = PG8_ABASE(cur); const char* cB = PG8_BBASE(cur);
    S.a_ready(cur);
    if constexpr (SP2) {
        PG8_STAGE(PG8_SB(0, 0), cB, voffB); PG8_STAGE(PG8_SB(0, 1), cB + hstepB, voffB); PG8_STAGE(PG8_SA(0, 0), cA, voffA); PG8_STAGE(PG8_SA(0, 1), cA + hstepA, voffA);
        if (wr == 1) PG8_BAR;
        PG8_WAIT_V(2); PG8_BAR;
        PG8_STAGE(PG8_SB(1, 0), cB + kstep, voffB); PG8_STAGE(PG8_SA(1, 0), cA + kstep, voffA); PG8_STAGE(PG8_SB(1, 1), cB + hstepB + kstep, voffB);
        PG8_WAIT_V(6); PG8_BAR;
    } else {
        PG8_STAGE(PG8_SB(0, 0), cB, voffB); PG8_STAGE(PG8_SA(0, 0), cA, voffA); PG8_STAGE(PG8_SB(0, 1), cB + hstepB, voffB); PG8_STAGE(PG8_SA(0, 1), cA + hstepA, voffA);
        if (wr == 1) PG8_BAR;
        PG8_WAIT_V(4); PG8_BAR;
        PG8_STAGE(PG8_SB(1, 0), cB + kstep, voffB); PG8_STAGE(PG8_SA(1, 0), cA + kstep, voffA); PG8_STAGE(PG8_SB(1, 1), cB + hstepB + kstep, voffB);
        PG8_WAIT_V(6); PG8_BAR;
    }
    for (;;) {
        const bool has_next = S.next(ui + 1, nxt);
        const char* nA = has_next ? PG8_ABASE(nxt) : cA; const char* nB = has_next ? PG8_BBASE(nxt) : cB;
#pragma unroll 1
        for (int t = 0; t < nt; t += 2) {
            const bool last = (t == nt - 2);
            const char* a1 = cA + (size_t)(t + 1) * kstep;
            const char* a2 = last ? nA : cA + (size_t)(t + 2) * kstep; const char* b2 = last ? nB : cB + (size_t)(t + 2) * kstep;
            const char* a3 = a2 + kstep; const char* b3 = b2 + kstep;
            if (last && has_next) S.a_ready(nxt);
            if constexpr (SP2) {
            PG8_LDB(B0, 0, 0); PG8_LDB(B1, 0, 1); PG8_SCHED; PG8_LDA(At, 0, 0); PG8_STAGE(PG8_SA(1, 1), a1 + hstepA, voffA);
            PG8_WAIT_V(8); PG8_WAIT_L(0); PG8_BAR; PG8_MMA(0, 0, At, B0); PG8_MMA(0, 1, At, B1); PG8_BAR; PG8_SCHED;
            PG8_LDA(At, 0, 1); PG8_STAGE(PG8_SB(0, 0), b2, voffB); PG8_STAGE(PG8_SB(0, 1), b2 + hstepB, voffB); PG8_STAGE(PG8_SA(0, 0), a2, voffA);
            PG8_WAIT_V(8); PG8_WAIT_L(0); PG8_BAR; PG8_MMA(1, 0, At, B0); PG8_MMA(1, 1, At, B1); PG8_BAR; PG8_SCHED;
            PG8_LDB(B0, 1, 0); PG8_LDB(B1, 1, 1); PG8_SCHED; PG8_LDA(At, 1, 0); PG8_STAGE(PG8_SA(0, 1), a2 + hstepA, voffA);
            PG8_WAIT_V(8); PG8_WAIT_L(0); PG8_BAR; PG8_MMA(0, 0, At, B0); PG8_MMA(0, 1, At, B1); PG8_BAR; PG8_SCHED;
            PG8_LDA(At, 1, 1); PG8_STAGE(PG8_SB(1, 0), b3, voffB); PG8_STAGE(PG8_SB(1, 1), b3 + hstepB, voffB); PG8_STAGE(PG8_SA(1, 0), a3, voffA);
            PG8_WAIT_V(8); PG8_WAIT_L(0); PG8_BAR; PG8_MMA(1, 0, At, B0); PG8_MMA(1, 1, At, B1); PG8_BAR; PG8_SCHED;
            } else {
            PG8_LDB(B0, 0, 0); PG8_SCHED; PG8_LDA(At, 0, 0); PG8_STAGE(PG8_SA(1, 1), a1 + hstepA, voffA);
            PG8_WAIT_L(8); PG8_BAR; PG8_WAIT_L(0); PG8_MMA(0, 0, At, B0); PG8_BAR; PG8_SCHED;
            PG8_LDB(B1, 0, 1); PG8_STAGE(PG8_SB(0, 0), b2, voffB);
            PG8_BAR; PG8_WAIT_L(0); PG8_MMA(0, 1, At, B1); PG8_BAR;
            PG8_LDA(At, 0, 1); PG8_STAGE(PG8_SA(0, 0), a2, voffA);
            PG8_BAR; PG8_WAIT_L(0); PG8_MMA(1, 0, At, B0); PG8_BAR; PG8_SCHED;
            PG8_STAGE(PG8_SB(0, 1), b2 + hstepB, voffB);
            PG8_WAIT_V(6); PG8_BAR; PG8_MMA(1, 1, At, B1); PG8_BAR;
            PG8_LDB(B0, 1, 0); PG8_SCHED; PG8_LDA(At, 1, 0); PG8_STAGE(PG8_SA(0, 1), a2 + hstepA, voffA);
            PG8_WAIT_L(8); PG8_BAR; PG8_WAIT_L(0); PG8_MMA(0, 0, At, B0); PG8_BAR; PG8_SCHED;
            PG8_LDB(B1, 1, 1); PG8_STAGE(PG8_SB(1, 0), b3, voffB);
            PG8_BAR; PG8_WAIT_L(0); PG8_MMA(0, 1, At, B1); PG8_BAR;
            PG8_LDA(At, 1, 1); PG8_STAGE(PG8_SA(1, 0), a3, voffA);
            PG8_BAR; PG8_WAIT_L(0); PG8_MMA(1, 0, At, B0); PG8_BAR; PG8_SCHED;
            PG8_STAGE(PG8_SB(1, 1), b3 + hstepB, voffB);
            PG8_WAIT_V(6); PG8_BAR; PG8_MMA(1, 1, At, B1); PG8_BAR;
            }
        }
        if constexpr (ALIGN_EPI) { if (wr == 0) PG8_BAR; }
        E(acc, cur, wr, wc, fr, fq); S.done(cur);
        if (!has_next) break;
#pragma unroll
        for (int a = 0; a < 2; ++a)
#pragma unroll
            for (int b = 0; b < 2; ++b)
#pragma unroll
                for (int m = 0; m < 4; ++m)
#pragma unroll
                    for (int n = 0; n < 2; ++n) acc[a][b][m][n] = (f32x4){0.f, 0.f, 0.f, 0.f};
        cur = nxt; cA = nA; cB = nB; ++ui;
        if constexpr (ALIGN_EPI) { if (wr == 1) PG8_BAR; }
    }
    PG8_WAIT_V(0);
    if constexpr (!ALIGN_EPI) { if (wr == 0) PG8_BAR; }
    PG8_BAR;
#undef PG8_SA
#undef PG8_SB
#undef PG8_STAGE
#undef PG8_LDA
#undef PG8_LDB
#undef PG8_MMA
#undef PG8_WAIT_V
#undef PG8_WAIT_L
#undef PG8_BAR
#undef PG8_SCHED
#undef PG8_ABASE
#undef PG8_BBASE
}
}

constexpr int NWAVES = 8;
constexpr int N_LAUNCHES = MK_N_LAUNCHES;
constexpr int NPH = 13;
constexpr int BATCH = 2, SEQ = 8192, D = 4096, M = BATCH * SEQ;
constexpr int NIN = 5 * D;
constexpr int DFF = 11008, NGU = 2 * DFF;
constexpr int NMOD = 6 * D;
constexpr int HEADS = 16, HD = 256, PGRP = 4, PGD = 1024;
constexpr float RMS_EPS = 1e-6f;
constexpr int SCAN_T = 128, SCAN_NC = SEQ / SCAN_T;

constexpr size_t MiB = 1u << 20;
constexpr size_t WS_CTL = 0, CTL_ZERO_BYTES = 1 * MiB;
constexpr size_t WS_MOD = 1 * MiB;
constexpr size_t WS_SP8 = WS_MOD + 256 * 1024;
constexpr size_t WS_CP = WS_MOD + 512 * 1024;
constexpr size_t WS_WRG = 2 * MiB;
constexpr size_t WS_WPOOL = 6 * MiB;
constexpr size_t WS_WBL = 14 * MiB;
constexpr size_t WS_WBP = 46 * MiB;
constexpr size_t WS_WO = 78 * MiB;
constexpr size_t WS_WIN = 110 * MiB;
constexpr size_t WS_XC = 110 * MiB;
constexpr size_t WS_MERGED = 110 * MiB;
constexpr size_t WS_SCANC = 240 * MiB;
constexpr size_t WS_U = 270 * MiB;
constexpr size_t WS_POOLED = 270 * MiB;
constexpr size_t WS_PROJ = 398 * MiB;
constexpr size_t WS_WGU = 398 * MiB;
constexpr size_t WS_WDN = 570 * MiB;
constexpr size_t WS_H = 656 * MiB;
constexpr size_t WS_AU = 1038 * MiB;
constexpr size_t WS_Y = 1038 * MiB;
constexpr size_t WS_Y2 = 1166 * MiB;
constexpr size_t WS_YL = 1294 * MiB;
constexpr size_t WS_X1B = 1294 * MiB;
constexpr size_t WS_YP = 1422 * MiB;
constexpr size_t WS_END = 1550 * MiB;
static_assert(WS_WIN + (size_t)NIN * D * 2 <= WS_U && WS_SCANC + 4 * MiB <= WS_U && WS_XC + (size_t)M * D * 2 <= WS_SCANC, "ws map 1");
static_assert(WS_U + (size_t)M * D * 2 <= WS_PROJ && WS_PROJ + (size_t)M * NIN * 2 <= WS_AU, "ws map 2");
static_assert(WS_WGU + (size_t)NGU * D * 2 <= WS_WDN && WS_WDN + (size_t)D * DFF * 2 <= WS_H && WS_H + (size_t)M * DFF * 2 <= WS_AU, "ws map 3");
static_assert(WS_AU + (size_t)M * D * 4 <= WS_YL && WS_Y2 + (size_t)M * D * 2 <= WS_YL && WS_YP + (size_t)M * D * 2 <= WS_END, "ws map 4");
constexpr int CW_TMO = 0;
constexpr int CW_BAR = 4096;

constexpr int RING_OFF = 0, RING_BYTES = 131072;
constexpr int LDSCTL_OFF = RING_BYTES, MISC_OFF = LDSCTL_OFF + 320;
constexpr int LDS_BYTES = 147456;
static_assert(MISC_OFF + 128 <= LDS_BYTES, "LDS map");

#define GAS __attribute__((address_space(1)))
#define LAS __attribute__((address_space(3)))
typedef unsigned short bf16;
typedef unsigned v4u __attribute__((ext_vector_type(4)));
typedef unsigned v2u __attribute__((ext_vector_type(2)));
typedef float f32x4 __attribute__((ext_vector_type(4)));
typedef float f32x2 __attribute__((ext_vector_type(2)));
typedef GAS unsigned gu32;
#define RLX_AGENT __ATOMIC_RELAXED, __HIP_MEMORY_SCOPE_AGENT
#define LDS_WAIT() asm volatile("s_waitcnt lgkmcnt(0)" ::: "memory")
#define VM_WAIT() asm volatile("s_waitcnt vmcnt(0)" ::: "memory")
using pg8::cvt_pk_bf16; using pg8::bf_lo; using pg8::bf_hi;

#define XB_TMO      128
#define XB_XCNT(j)  (256  + 64 * (j))
#define XB_XSUB(j)  (1280 + 64 * (j))
#define XB_XGEN(j)  (2304 + 64 * (j))
#define XB_TOP      3328
#define XB_TOPGEN   3392
#define XCD_BAR_WORDS 3456
#define XB_SPIN_CAP (1u << 18)

__device__ __forceinline__ unsigned xb_ld(unsigned* p)              { return __hip_atomic_load(p, __ATOMIC_RELAXED, __HIP_MEMORY_SCOPE_AGENT); }
__device__ __forceinline__ unsigned xb_add(unsigned* p, unsigned v) { return __hip_atomic_fetch_add(p, v, __ATOMIC_RELAXED, __HIP_MEMORY_SCOPE_AGENT); }
__device__ __forceinline__ unsigned xb_xcc_id() { return (unsigned)__builtin_amdgcn_s_getreg((3 << 11) | 20) & 0xFu; }
#define XB_SPIN(cond, bar) do { unsigned _sp = 0; while (cond) { __builtin_amdgcn_s_sleep(1); \
    if ((++_sp & 255u) == 0u) { if (xb_ld(&(bar)[XB_TMO])) break; if (_sp > XB_SPIN_CAP) { atomicAdd(&(bar)[XB_TMO], 1u); break; } } } } while (0)

struct XcdBarrier {
    unsigned* bar; unsigned x;
    volatile LAS unsigned* st;
};
__device__ __forceinline__ XcdBarrier xcd_barrier_post(unsigned* bar, volatile LAS unsigned* st) {
    XcdBarrier b; b.bar = bar; b.x = xb_xcc_id(); b.st = st;
    if (threadIdx.x == 0) (void)xb_add(&bar[XB_XCNT(b.x)], 1u);
    return b;
}
__device__ __forceinline__ void xcd_barrier_complete(unsigned* bar, unsigned x, unsigned& nloc, unsigned& nx) {
    const unsigned G = gridDim.x * gridDim.y * gridDim.z;
    unsigned sum, cnt, mine, sp = 0u;
    for (;;) {
        sum = 0u; cnt = 0u; mine = 0u;
#pragma unroll
        for (unsigned j = 0; j < 16; ++j) { const unsigned c = xb_ld(&bar[XB_XCNT(j)]); sum += c; cnt += (c > 0u) ? 1u : 0u; mine = (j == x) ? c : mine; }
        if (sum == G) break;
        __builtin_amdgcn_s_sleep(1);
        if ((++sp & 255u) == 0u) { if (xb_ld(&bar[XB_TMO])) break; if (sp > XB_SPIN_CAP) { atomicAdd(&bar[XB_TMO], 1u); break; } }
    }
    nloc = mine > 0u ? mine : 1u; nx = cnt > 0u ? cnt : 1u;
}
__device__ __forceinline__ void xcd_barrier(const XcdBarrier& b) {
    asm volatile("s_waitcnt vmcnt(0)" ::: "memory");
    __syncthreads();
    if (threadIdx.x == 0) {
        unsigned* bar = b.bar;
        __builtin_amdgcn_s_waitcnt(0);
        unsigned nloc = b.st[0], nx = b.st[1];
        if (nloc == 0u) { xcd_barrier_complete(bar, b.x, nloc, nx); b.st[0] = nloc; b.st[1] = nx; }
        const unsigned old = xb_add(&bar[XB_XSUB(b.x)], 1u);
        const unsigned gen = old / nloc;
        if (old + 1u == (gen + 1u) * nloc) {
            __builtin_amdgcn_fence(__ATOMIC_RELEASE, "agent");
            asm volatile("s_waitcnt vmcnt(0)" ::: "memory");
            const unsigned og = xb_add(&bar[XB_TOP], 1u);
            const unsigned tg = og / nx;
            if (og + 1u == (tg + 1u) * nx) xb_add(&bar[XB_TOPGEN], 1u);
            else XB_SPIN(xb_ld(&bar[XB_TOPGEN]) == tg, bar);
            __builtin_amdgcn_fence(__ATOMIC_ACQUIRE, "agent");
            xb_add(&bar[XB_XGEN(b.x)], 1u);
            asm volatile("s_waitcnt vmcnt(0)" ::: "memory");
        } else {
            XB_SPIN(xb_ld(&bar[XB_XGEN(b.x)]) == gen, bar);
            __builtin_amdgcn_fence(__ATOMIC_ACQUIRE, "agent");
            asm volatile("s_waitcnt vmcnt(0)" ::: "memory");
        }
    }
    __syncthreads();
}

__device__ __forceinline__ float wave_sum(float v) {
#pragma unroll
    for (int o = 1; o < 64; o <<= 1) v += __shfl_xor(v, o);
    return v;
}
__device__ __forceinline__ float dot4(f32x4 a) { return (a.x * a.x + a.y * a.y) + (a.z * a.z + a.w * a.w); }

#ifndef FAKEQ
#define FAKEQ 0
#endif
__device__ __forceinline__ float fq8(float v, float inv, float sc) { float q = __builtin_rintf(v * inv); q = fminf(fmaxf(q, -127.f), 127.f); return q * sc; }
__device__ __forceinline__ void transpose_item(const float* W, int N, bf16* WT, int ldk, int k0, int n0, int drow0, LAS float* scr, int lane, const unsigned* cmax = nullptr) {
#pragma unroll 8
    for (int i = 0; i < 32; ++i) { const int kk = 2 * i + (lane >> 5); scr[kk * 33 + (lane & 31)] = W[(size_t)(k0 + kk) * N + n0 + (lane & 31)]; }
    LDS_WAIT(); asm volatile("" ::: "memory");
    const int c = lane & 7;
#pragma unroll
    for (int j = 0; j < 4; ++j) { const int n = (lane >> 3) + 8 * j; const LAS float* s = scr + (8 * c) * 33 + n;
        v4u o;
        if (cmax) { const float am = fmaxf(__uint_as_float(cmax[n0 + n]), 1e-30f), sc = am * (1.0f / 127.0f), inv = 127.0f / am;
            o.x = cvt_pk_bf16(fq8(s[0 * 33], inv, sc), fq8(s[1 * 33], inv, sc)); o.y = cvt_pk_bf16(fq8(s[2 * 33], inv, sc), fq8(s[3 * 33], inv, sc));
            o.z = cvt_pk_bf16(fq8(s[4 * 33], inv, sc), fq8(s[5 * 33], inv, sc)); o.w = cvt_pk_bf16(fq8(s[6 * 33], inv, sc), fq8(s[7 * 33], inv, sc)); }
        else { o.x = cvt_pk_bf16(s[0 * 33], s[1 * 33]); o.y = cvt_pk_bf16(s[2 * 33], s[3 * 33]); o.z = cvt_pk_bf16(s[4 * 33], s[5 * 33]); o.w = cvt_pk_bf16(s[6 * 33], s[7 * 33]); }
        *(v4u*)(WT + (size_t)(drow0 + n) * ldk + k0 + 8 * c) = o; }
    LDS_WAIT(); asm volatile("" ::: "memory");
}
template <int DMAP>
__device__ __forceinline__ void transpose_matrix(const float* W, int K, int N, bf16* WT, int ldk, int drow_off, LAS float* scr, int lane, int gw, int NGW, int& itbase, const unsigned* cmax = nullptr) {
    const int nblk = N / 32, nitems = (K / 64) * nblk;
    int it = gw - (itbase % NGW); if (it < 0) it += NGW;
    for (; it < nitems; it += NGW) {
        const int kb = it / nblk, nb = it % nblk, n0 = 32 * nb;
        int drow;
        if (DMAP == 1) { const int isup = n0 >= DFF ? 1 : 0, j = n0 - isup * DFF; drow = (j >> 7) * 256 + isup * 128 + (j & 127); }
        else drow = n0;
        transpose_item(W, N, WT, ldk, 64 * kb, n0, drow_off + drow, scr, lane, cmax);
    }
    itbase += nitems;
}

__device__ __forceinline__ void col_amax(const float* W, int K, int N, unsigned* cmax, int gtid, int gthreads) {
    const int ng = N / 4, nks = K / 256;
    for (int it = gtid; it < ng * nks; it += gthreads) { const int cgp = it % ng, ks = it / ng;
        const float* p = W + (size_t)ks * 256 * N + cgp * 4; f32x4 m = {0.f, 0.f, 0.f, 0.f};
#pragma unroll 8
        for (int k = 0; k < 256; ++k) { const f32x4 w = *(const f32x4*)(p + (size_t)k * N); m.x = fmaxf(m.x, fabsf(w.x)); m.y = fmaxf(m.y, fabsf(w.y)); m.z = fmaxf(m.z, fabsf(w.z)); m.w = fmaxf(m.w, fabsf(w.w)); }
        atomicMax(cmax + cgp * 4 + 0, __float_as_uint(m.x)); atomicMax(cmax + cgp * 4 + 1, __float_as_uint(m.y)); atomicMax(cmax + cgp * 4 + 2, __float_as_uint(m.z)); atomicMax(cmax + cgp * 4 + 3, __float_as_uint(m.w)); }
}
__device__ __forceinline__ void unpack4(const v2u q, float (&f)[4]) { f[0] = bf_lo(q.x); f[1] = bf_hi(q.x); f[2] = bf_lo(q.y); f[3] = bf_hi(q.y); }
template <int W>
__device__ __forceinline__ void conv_pool_chunk(const bf16* PROJ, bf16* XC, bf16* POOLED, const float* conv_w, const float* conv_b, int chunk, int ch0) {
    float cw[4][4], cb[4];
#pragma unroll
    for (int k = 0; k < 4; ++k) { const f32x4 a = *(const f32x4*)(conv_w + k * D + ch0); cw[k][0] = a.x; cw[k][1] = a.y; cw[k][2] = a.z; cw[k][3] = a.w; }
    { const f32x4 a = *(const f32x4*)(conv_b + ch0); cb[0] = a.x; cb[1] = a.y; cb[2] = a.z; cb[3] = a.w; }
    const size_t row0 = (size_t)chunk * 64; const int t0 = (int)(row0 % SEQ);
    const bf16* pr = PROJ + row0 * NIN + ch0;
    float cx[4][4];
    v2u ph[W];
    float s[4];
#pragma unroll
    for (int j = 0; j < 4; ++j) s[j] = 0.f;
#pragma unroll
    for (int q = 0; q < 4; ++q)
#pragma unroll
        for (int j = 0; j < 4; ++j) cx[q][j] = 0.f;
#pragma unroll
    for (int q = 0; q < W; ++q) ph[q] = (v2u){0u, 0u};
    if (t0 > 0) {
#pragma unroll
        for (int q = 1; q <= 3; ++q) { const v2u x = *(const v2u*)(pr - (ptrdiff_t)q * NIN); unpack4(x, cx[(64 - q) & 3]); }
#pragma unroll
        for (int q = 1; q < W; ++q) { const v2u x = *(const v2u*)(pr + 2 * D - (ptrdiff_t)q * NIN); ph[(64 - q) & (W - 1)] = x; float f[4]; unpack4(x, f);
#pragma unroll
            for (int j = 0; j < 4; ++j) s[j] += f[j]; }
    }
    const bf16* p = pr; bf16* xo = XC + row0 * D + ch0; bf16* po = POOLED + row0 * D + ch0;
#pragma unroll 1
    for (int rb = 0; rb < 4; ++rb) {
#pragma unroll
        for (int rr = 0; rr < 16; ++rr) { const int r = rb * 16 + rr;
            const v2u xn = *(const v2u*)p; const v2u pn = *(const v2u*)(p + 2 * D);
            float xf[4]; unpack4(xn, xf);
            float a[4];
#pragma unroll
            for (int j = 0; j < 4; ++j) a[j] = cb[j] + cw[0][j] * cx[(rr + 1) & 3][j] + cw[1][j] * cx[(rr + 2) & 3][j] + cw[2][j] * cx[(rr + 3) & 3][j] + cw[3][j] * xf[j];
#pragma unroll
            for (int j = 0; j < 4; ++j) cx[rr & 3][j] = xf[j];
            { v2u o; o.x = cvt_pk_bf16(a[0], a[1]); o.y = cvt_pk_bf16(a[2], a[3]); *(v2u*)xo = o; }
            float pf[4], of[4]; unpack4(pn, pf); unpack4(ph[rr & (W - 1)], of);
            ph[rr & (W - 1)] = pn;
            const int t = t0 + r; const int cnt = (t + 1 < W) ? (t + 1) : W; const float inv = 1.0f / (float)cnt;
#pragma unroll
            for (int j = 0; j < 4; ++j) { s[j] += pf[j] - of[j]; a[j] = s[j] * inv - pf[j]; }
            { v2u o; o.x = cvt_pk_bf16(a[0], a[1]); o.y = cvt_pk_bf16(a[2], a[3]); *(v2u*)po = o; }
            p += NIN; xo += D; po += D;
            if ((rr & 7) == 7) asm volatile("" ::: "memory");
        }
    }
}

struct Args { const float* in[23]; float* out; unsigned char* ws; int ph_lo, ph_hi, li, pad; };

__global__ void __launch_bounds__(NWAVES * 64, 2) fwd_kernel(Args args) {
    extern __shared__ __attribute__((aligned(16))) unsigned char lds_raw[];
    LAS unsigned char* lds = (LAS unsigned char*)lds_raw;
    volatile LAS unsigned* MISC = (volatile LAS unsigned*)(lds + MISC_OFF);
    const int tid = threadIdx.x, lane = tid & 63, wave = __builtin_amdgcn_readfirstlane(tid >> 6);
    const int G = gridDim.x; const int bx = blockIdx.x; const int vcu = (G % 8 == 0) ? (bx % 8) * (G / 8) + bx / 8 : bx;
    unsigned char* ws = args.ws;
    gu32* ctl = (gu32*)(ws + WS_CTL);
    const float* x = args.in[0]; const float* cvec = args.in[1]; const float* w_ada = args.in[2]; const float* b_ada = args.in[3];
    const float* g_mix_pre = args.in[4]; const float* g_mix_post = args.in[5]; const float* w_in = args.in[6]; const float* conv_w = args.in[7]; const float* conv_b = args.in[8];
    const float* w_rg_a = args.in[9]; const float* b_rg_a = args.in[10]; const float* w_rg_x = args.in[11]; const float* b_rg_x = args.in[12]; const float* lam = args.in[13];
    const float* pool_w = args.in[14]; const float* pool_scale = args.in[15]; const float* w_bl = args.in[16]; const float* w_bp = args.in[17]; const float* w_o = args.in[18];
    const float* g_ffn_pre = args.in[19]; const float* g_ffn_post = args.in[20]; const float* w_gu = args.in[21]; const float* w_dn = args.in[22];
    float* out = args.out;
    float* mod = (float*)(ws + WS_MOD); float* sp8 = (float*)(ws + WS_SP8);
    bf16* Wrg_t = (bf16*)(ws + WS_WRG); bf16* Wpool_t = (bf16*)(ws + WS_WPOOL); bf16* Wbl_t = (bf16*)(ws + WS_WBL); bf16* Wbp_t = (bf16*)(ws + WS_WBP); bf16* Wo_t = (bf16*)(ws + WS_WO);
    bf16* Win_t = (bf16*)(ws + WS_WIN); bf16* Wgu_t = (bf16*)(ws + WS_WGU); bf16* Wdn_t = (bf16*)(ws + WS_WDN);
    bf16* U = (bf16*)(ws + WS_U); bf16* PROJ = (bf16*)(ws + WS_PROJ); bf16* XC = (bf16*)(ws + WS_XC); bf16* POOLED = (bf16*)(ws + WS_POOLED);
    unsigned* AU = (unsigned*)(ws + WS_AU); float* SCP = (float*)(ws + WS_SCANC); float* SCH = SCP + BATCH * SCAN_NC * D;
    bf16* YL = (bf16*)(ws + WS_YL); bf16* YP = (bf16*)(ws + WS_YP); bf16* MERGED = (bf16*)(ws + WS_MERGED); bf16* Y = (bf16*)(ws + WS_Y); bf16* Y2 = (bf16*)(ws + WS_Y2); bf16* H = (bf16*)(ws + WS_H); bf16* X1B = (bf16*)(ws + WS_X1B);

    for (int u = tid; u < (LDS_BYTES - LDSCTL_OFF) / 4; u += NWAVES * 64) ((LAS unsigned*)(lds + LDSCTL_OFF))[u] = 0u;
    __syncthreads();
    XcdBarrier bar; bar.bar = (unsigned*)(ctl + CW_BAR) + args.li * XCD_BAR_WORDS; bar.x = 0; bar.st = nullptr;
    if (N_LAUNCHES != NPH) bar = xcd_barrier_post((unsigned*)(ctl + CW_BAR) + args.li * XCD_BAR_WORDS, MISC + 8);
#define GRID_BAR() do { if (N_LAUNCHES != NPH) xcd_barrier(bar); } while (0)
    const int lo = args.ph_lo, hi = args.ph_hi;
#ifndef PH_MASK
#define PH_MASK 0x1fff
#endif
#define IN(k) (((PH_MASK >> (k)) & 1) && lo <= (k) && (k) < hi)
#ifndef DUP_MASK
#define DUP_MASK 0

#endif
#define DUP(k) ((DUP_MASK >> (k)) & 1)
#define REP(k) _Pragma("unroll 1") for (int rep_ = 0; rep_ < DUP(k) + 1; ++rep_)
#define BOTH(k) (IN(k) && IN((k) + 1))
    const int gw = vcu * NWAVES + wave, NGW = G * NWAVES;
    unsigned* cmax_in = (unsigned*)(ws + 512 * 1024); unsigned* cmax_gu = (unsigned*)(ws + 640 * 1024);

    if (IN(0)) REP(0) {
#if FAKEQ
        col_amax(w_in, D, NIN, cmax_in, bx * NWAVES * 64 + tid, G * NWAVES * 64); col_amax(w_gu, D, NGU, cmax_gu, bx * NWAVES * 64 + tid, G * NWAVES * 64);
#endif
        {
            LAS float* cact = (LAS float*)lds; LAS float* red = (LAS float*)(lds + 32768);
            for (int i = tid; i < BATCH * D; i += NWAVES * 64) { const float v = cvec[i]; cact[i] = pg8::siluf_(v); }
            __syncthreads();
            const int cg = tid % 24, kg = tid / 24;
            for (int g = vcu; g < NMOD / 96; g += G) {
                if (kg < 21) {
                    f32x4 a0 = {0.f, 0.f, 0.f, 0.f}, a1 = {0.f, 0.f, 0.f, 0.f};
                    const float* wp = w_ada + (size_t)g * 96 + cg * 4;
#pragma unroll 8
                    for (int k = kg; k < D; k += 21) { const f32x4 w = *(const f32x4*)(wp + (size_t)k * NMOD); const float c0 = cact[k], c1 = cact[D + k]; a0 += w * c0; a1 += w * c1; }
                    LAS float* rp = red + (kg * 24 + cg) * 8;
                    rp[0] = a0.x; rp[1] = a0.y; rp[2] = a0.z; rp[3] = a0.w; rp[4] = a1.x; rp[5] = a1.y; rp[6] = a1.z; rp[7] = a1.w;
                }
                __syncthreads();
                if (tid < 192) { const int cgo = tid >> 3, r = tid & 7, b = r >> 2, j = r & 3; float s = 0.f;
#pragma unroll
                    for (int q = 0; q < 21; ++q) s += red[(q * 24 + cgo) * 8 + r];
                    const int n = g * 96 + cgo * 4 + j; mod[b * NMOD + n] = s + b_ada[n]; }
                __syncthreads();
            }
        }
        for (int i = bx * NWAVES * 64 + tid; i < D; i += G * NWAVES * 64) { const float l = lam[i]; sp8[i] = -8.0f * log1pf(expf(-l)); }
        {
            LAS float* scr = (LAS float*)(lds + wave * 16384);
            int itbase = 0;
#if !FAKEQ
            transpose_matrix<0>(w_in, D, NIN, Win_t, D, 0, scr, lane, gw, NGW, itbase);
#endif
            for (int h = 0; h < HEADS; ++h) {
                const int nblk = HD / 32, nitems = (HD / 64) * nblk * 2;
                int it = gw - (itbase % NGW); if (it < 0) it += NGW;
                for (; it < nitems; it += NGW) { const int which = it / ((HD / 64) * nblk), r = it % ((HD / 64) * nblk), kb = r / nblk, nb = r % nblk, n0 = 32 * nb;
                    const float* W = (which ? w_rg_x : w_rg_a) + (size_t)h * HD * HD;
                    transpose_item(W, HD, Wrg_t, HD, 64 * kb, n0, h * 512 + (n0 >> 7) * 256 + which * 128 + (n0 & 127), scr, lane); }
                itbase += nitems;
            }
            for (int gi = 0; gi < PGRP; ++gi) transpose_matrix<0>(pool_w + (size_t)gi * PGD * PGD, PGD, PGD, Wpool_t, PGD, gi * PGD, scr, lane, gw, NGW, itbase);
            transpose_matrix<0>(w_bl, D, D, Wbl_t, D, 0, scr, lane, gw, NGW, itbase);
            transpose_matrix<0>(w_bp, D, D, Wbp_t, D, 0, scr, lane, gw, NGW, itbase);
            transpose_matrix<0>(w_o, D, D, Wo_t, D, 0, scr, lane, gw, NGW, itbase);
        }
        if (BOTH(0)) GRID_BAR();
    }

    if (IN(1)) REP(1) {
#if FAKEQ
        { LAS float* scr = (LAS float*)(lds + wave * 16384); int itbase = 0; transpose_matrix<0>(w_in, D, NIN, Win_t, D, 0, scr, lane, gw, NGW, itbase, cmax_in); }
        __syncthreads();
#endif
        LAS float* cA = (LAS float*)lds; LAS float* cB = cA + D;
        int cur_b = -1;
        for (int chunk = vcu; chunk < M / 64; chunk += G) {
            const int b = chunk / (SEQ / 64);
            if (b != cur_b) { __syncthreads();
                for (int i = tid; i < D; i += NWAVES * 64) { cA[i] = g_mix_pre[i] * (1.0f + mod[b * NMOD + 1 * D + i]); cB[i] = mod[b * NMOD + 0 * D + i]; }
                __syncthreads(); cur_b = b; }
            for (int r = wave; r < 64; r += NWAVES) { const size_t row = (size_t)chunk * 64 + r;
                const f32x4* xr = (const f32x4*)(x + row * D) + lane;
                f32x4 v[16]; float s = 0.f;
#pragma unroll
                for (int j = 0; j < 16; ++j) { v[j] = xr[64 * j]; s += dot4(v[j]); }
                const float rstd = 1.0f / sqrtf(wave_sum(s) * (1.0f / D) + RMS_EPS);
                v2u* o8 = (v2u*)(U + row * D) + lane;
#if FAKEQ
                float am = 0.f;
#pragma unroll
                for (int j = 0; j < 16; ++j) { const f32x4 a = ((const LAS f32x4*)cA)[lane + 64 * j], bb = ((const LAS f32x4*)cB)[lane + 64 * j]; v[j] = v[j] * rstd * a + bb;
                    am = fmaxf(fmaxf(am, fmaxf(fabsf(v[j].x), fabsf(v[j].y))), fmaxf(fabsf(v[j].z), fabsf(v[j].w))); }
#pragma unroll
                for (int o = 1; o < 64; o <<= 1) am = fmaxf(am, __shfl_xor(am, o));
                am = fmaxf(am, 1e-30f); const float qs = am * (1.0f / 127.0f), qi = 127.0f / am;
#pragma unroll
                for (int j = 0; j < 16; ++j) { v2u w; w.x = cvt_pk_bf16(fq8(v[j].x, qi, qs), fq8(v[j].y, qi, qs)); w.y = cvt_pk_bf16(fq8(v[j].z, qi, qs), fq8(v[j].w, qi, qs)); o8[64 * j] = w; }
#else
#pragma unroll
                for (int j = 0; j < 16; ++j) { const f32x4 a = ((const LAS f32x4*)cA)[lane + 64 * j], bb = ((const LAS f32x4*)cB)[lane + 64 * j]; const f32x4 o = v[j] * rstd * a + bb;
                    v2u w; w.x = cvt_pk_bf16(o.x, o.y); w.y = cvt_pk_bf16(o.z, o.w); o8[64 * j] = w; }
#endif
            }
        }
        if (BOTH(1)) GRID_BAR();
    }

    if (IN(2)) {
#define P2_BODY do { pg8::Gemm g{U, Win_t, M, NIN, D, D, D, 30}; pg8::StaticOrder S; S.init(M, NIN, G, bx); \
        pg8::EpiPlain E{PROJ, NIN}; \
        pg8::gemm_phase<pg8::EpiPlain, pg8::StaticOrder, true, true>(lds + RING_OFF, g, S, E); } while (0)
        P2_BODY; if (DUP(2)) { P2_BODY; }
#ifdef PROBE_FIXED
        { pg8::Gemm g{U, Win_t, M, NIN, D, D, D, 30}; pg8::FixedOrder S; S.init(M, NIN, G, bx);
          pg8::EpiPlain E{(bf16*)(ws + WS_AU), NIN};
          pg8::gemm_phase<pg8::EpiPlain, pg8::FixedOrder, true, true>(lds + RING_OFF, g, S, E); }
#endif
        if (BOTH(2)) GRID_BAR();
    }

    if (IN(3)) REP(3) {
        for (int id = gw; id < (M / 64) * 16; id += NGW) { const int chunk = id >> 4, cgp = id & 15, ch0 = cgp * 256 + lane * 4;
            switch (cgp >> 2) {
                case 0: conv_pool_chunk<2>(PROJ, XC, POOLED, conv_w, conv_b, chunk, ch0); break;
                case 1: conv_pool_chunk<4>(PROJ, XC, POOLED, conv_w, conv_b, chunk, ch0); break;
                case 2: conv_pool_chunk<8>(PROJ, XC, POOLED, conv_w, conv_b, chunk, ch0); break;
                default: conv_pool_chunk<16>(PROJ, XC, POOLED, conv_w, conv_b, chunk, ch0); break;
            }
        }
        if (BOTH(3)) GRID_BAR();
    }

    if (IN(4)) {
#define P4_BODY do { \
        { pg8::Gemm g{XC, Wrg_t, M, HEADS * 512, HD, D, HD, 1}; pg8::StaticOrder S; S.init(M, HEADS * 512, G, bx); \
          pg8::EpiRg E{XC, AU, b_rg_a, b_rg_x, sp8, D}; \
          pg8::gemm_phase<pg8::EpiRg, pg8::StaticOrder, true, true>(lds + RING_OFF, g, S, E); } \
        { pg8::Gemm g{POOLED, Wpool_t, M, D, PGD, D, PGD, 2}; pg8::StaticOrder S; S.init(M, D, G, bx); \
          pg8::EpiScale E{YP, D, pool_scale}; \
          pg8::gemm_phase<pg8::EpiScale, pg8::StaticOrder, true, true>(lds + RING_OFF, g, S, E); } } while (0)
        P4_BODY; if (DUP(4)) { P4_BODY; }
        if (BOTH(4)) GRID_BAR();
    }

    if (IN(5)) REP(5) {
        for (int id = gw; id < BATCH * SCAN_NC * 16; id += NGW) { const int cgp = id & 15, chunk = (id >> 4) % SCAN_NC, b = id / (16 * SCAN_NC);
            const int ch = cgp * 256 + lane * 4; const size_t row0 = (size_t)b * SEQ + (size_t)chunk * SCAN_T;
            const v4u* p = (const v4u*)(AU + row0 * D + ch);
            float S[4] = {0.f, 0.f, 0.f, 0.f}, h[4] = {0.f, 0.f, 0.f, 0.f};
#pragma unroll 8
            for (int r = 0; r < SCAN_T; ++r) { const v4u w = p[(size_t)r * (D / 4)]; const unsigned ww[4] = {w.x, w.y, w.z, w.w};
#pragma unroll
                for (int j = 0; j < 4; ++j) { const float l = bf_lo(ww[j]), u = bf_hi(ww[j]); h[j] = pg8::fast_exp(l) * h[j] + u; S[j] += l; } }
            const size_t o = ((size_t)(b * SCAN_NC + chunk)) * D + ch;
            *(f32x4*)(SCP + o) = (f32x4){pg8::fast_exp(S[0]), pg8::fast_exp(S[1]), pg8::fast_exp(S[2]), pg8::fast_exp(S[3])}; *(f32x4*)(SCH + o) = (f32x4){h[0], h[1], h[2], h[3]};
        }
        if (BOTH(5)) GRID_BAR();
    }

    if (IN(6)) REP(6) {
        for (int id = gw; id < BATCH * SCAN_NC * 16; id += NGW) { const int cgp = id & 15, chunk = (id >> 4) % SCAN_NC, b = id / (16 * SCAN_NC);
            const int ch = cgp * 256 + lane * 4; const size_t row0 = (size_t)b * SEQ + (size_t)chunk * SCAN_T;
            f32x4 hc = {0.f, 0.f, 0.f, 0.f};
#pragma unroll 8
            for (int c = 0; c < chunk; ++c) { const size_t o = ((size_t)(b * SCAN_NC + c)) * D + ch; const f32x4 P = *(const f32x4*)(SCP + o), Hh = *(const f32x4*)(SCH + o); hc = P * hc + Hh; }
            float h[4] = {hc.x, hc.y, hc.z, hc.w};
            const v4u* p = (const v4u*)(AU + row0 * D + ch); const v2u* gp = (const v2u*)(PROJ + row0 * NIN + D + ch); v2u* yo = (v2u*)(YL + row0 * D + ch);
#pragma unroll 8
            for (int r = 0; r < SCAN_T; ++r) { const v4u w = p[(size_t)r * (D / 4)]; const v2u gq = gp[(size_t)r * (NIN / 4)]; const unsigned ww[4] = {w.x, w.y, w.z, w.w};
                const float gg[4] = {bf_lo(gq.x), bf_hi(gq.x), bf_lo(gq.y), bf_hi(gq.y)}; float y[4];
#pragma unroll
                for (int j = 0; j < 4; ++j) { const float l = bf_lo(ww[j]), u = bf_hi(ww[j]); h[j] = pg8::fast_exp(l) * h[j] + u; y[j] = h[j] * pg8::gelu_tanh_(gg[j]); }
                v2u o; o.x = cvt_pk_bf16(y[0], y[1]); o.y = cvt_pk_bf16(y[2], y[3]); yo[(size_t)r * (D / 4)] = o; }
        }
        if (BOTH(6)) GRID_BAR();
    }

    if (IN(7)) {
#define P7_BODY do { \
        { pg8::Gemm g{YL, Wbl_t, M, D, D, D, D, 30}; pg8::StaticOrder S; S.init(M, D, G, bx); \
          pg8::EpiGate<false> E{MERGED, D, PROJ + 3 * D, NIN}; \
          pg8::gemm_phase<pg8::EpiGate<false>, pg8::StaticOrder, true, true>(lds + RING_OFF, g, S, E); } \
        { pg8::Gemm g{YP, Wbp_t, M, D, D, D, D, 30}; pg8::StaticOrder S; S.init(M, D, G, bx); \
          pg8::EpiGate<true> E{MERGED, D, PROJ + 4 * D, NIN}; \
          pg8::gemm_phase<pg8::EpiGate<true>, pg8::StaticOrder, true, true>(lds + RING_OFF, g, S, E); } } while (0)
        P7_BODY; if (DUP(7)) { P7_BODY; }
        if (BOTH(7)) GRID_BAR();
    }

    if (IN(8)) {
#define P8_BODY do { pg8::Gemm g{MERGED, Wo_t, M, D, D, D, D, 30}; pg8::StaticOrder S; S.init(M, D, G, bx); \
        pg8::EpiPlain E{Y, D}; \
        pg8::gemm_phase<pg8::EpiPlain, pg8::StaticOrder, true, true>(lds + RING_OFF, g, S, E); } while (0)
        P8_BODY; if (DUP(8)) { P8_BODY; }
        if (BOTH(8)) GRID_BAR();
    }

    if (IN(9)) REP(9) {
        {
            LAS float* cG = (LAS float*)lds; LAS float* cA = cG + D; LAS float* cB = cA + D;
            int cur_b = -1;
            for (int chunk = vcu; chunk < M / 64; chunk += G) {
                const int b = chunk / (SEQ / 64);
                if (b != cur_b) { __syncthreads();
                    for (int i = tid; i < D; i += NWAVES * 64) { cG[i] = mod[b * NMOD + 2 * D + i] * g_mix_post[i]; cA[i] = g_ffn_pre[i] * (1.0f + mod[b * NMOD + 4 * D + i]); cB[i] = mod[b * NMOD + 3 * D + i]; }
                    __syncthreads(); cur_b = b; }
                for (int r = wave; r < 64; r += NWAVES) { const size_t row = (size_t)chunk * 64 + r;
                    const f32x4* xr = (const f32x4*)(x + row * D) + lane; const v2u* yr = (const v2u*)(Y + row * D) + lane;
                    f32x4 v[16]; v2u yv[16]; float sy = 0.f;
#pragma unroll
                    for (int j = 0; j < 16; ++j) { v[j] = xr[64 * j]; yv[j] = yr[64 * j]; }
#pragma unroll
                    for (int j = 0; j < 16; ++j) { const f32x4 y = {bf_lo(yv[j].x), bf_hi(yv[j].x), bf_lo(yv[j].y), bf_hi(yv[j].y)}; sy += dot4(y); }
                    const float rstdy = 1.0f / sqrtf(wave_sum(sy) * (1.0f / D) + RMS_EPS);
                    float s1 = 0.f; v2u* orow = (v2u*)(X1B + row * D) + lane;
#pragma unroll
                    for (int j = 0; j < 16; ++j) { const f32x4 y = {bf_lo(yv[j].x), bf_hi(yv[j].x), bf_lo(yv[j].y), bf_hi(yv[j].y)}; const f32x4 gq = ((const LAS f32x4*)cG)[lane + 64 * j];
                        v[j] = v[j] + gq * (y * rstdy); s1 += dot4(v[j]); v2u w; w.x = cvt_pk_bf16(v[j].x, v[j].y); w.y = cvt_pk_bf16(v[j].z, v[j].w); orow[64 * j] = w; }
                    const float rstd1 = 1.0f / sqrtf(wave_sum(s1) * (1.0f / D) + RMS_EPS);
                    v2u* o8 = (v2u*)(U + row * D) + lane;
#if FAKEQ
                    float am = 0.f;
#pragma unroll
                    for (int j = 0; j < 16; ++j) { const f32x4 a = ((const LAS f32x4*)cA)[lane + 64 * j], bb = ((const LAS f32x4*)cB)[lane + 64 * j]; v[j] = v[j] * rstd1 * a + bb;
                        am = fmaxf(fmaxf(am, fmaxf(fabsf(v[j].x), fabsf(v[j].y))), fmaxf(fabsf(v[j].z), fabsf(v[j].w))); }
#pragma unroll
                    for (int o = 1; o < 64; o <<= 1) am = fmaxf(am, __shfl_xor(am, o));
                    am = fmaxf(am, 1e-30f); const float qs = am * (1.0f / 127.0f), qi = 127.0f / am;
#pragma unroll
                    for (int j = 0; j < 16; ++j) { v2u w; w.x = cvt_pk_bf16(fq8(v[j].x, qi, qs), fq8(v[j].y, qi, qs)); w.y = cvt_pk_bf16(fq8(v[j].z, qi, qs), fq8(v[j].w, qi, qs)); o8[64 * j] = w; }
#else
#pragma unroll
                    for (int j = 0; j < 16; ++j) { const f32x4 a = ((const LAS f32x4*)cA)[lane + 64 * j], bb = ((const LAS f32x4*)cB)[lane + 64 * j]; const f32x4 o = v[j] * rstd1 * a + bb;
                        v2u w; w.x = cvt_pk_bf16(o.x, o.y); w.y = cvt_pk_bf16(o.z, o.w); o8[64 * j] = w; }
#endif
                }
            }
        }
        __syncthreads();
        {
            LAS float* scr = (LAS float*)(lds + wave * 16384);
            int itbase = 0;
#if FAKEQ
            transpose_matrix<1>(w_gu, D, NGU, Wgu_t, D, 0, scr, lane, gw, NGW, itbase, cmax_gu);
#else
            transpose_matrix<1>(w_gu, D, NGU, Wgu_t, D, 0, scr, lane, gw, NGW, itbase);
#endif
            transpose_matrix<0>(w_dn, DFF, D, Wdn_t, DFF, 0, scr, lane, gw, NGW, itbase);
        }
        if (BOTH(9)) GRID_BAR();
    }

    if (IN(10)) {
#define P10_BODY do { pg8::Gemm g{U, Wgu_t, M, NGU, D, D, D, 30}; pg8::StaticOrder S; S.init(M, NGU, G, bx); \
        pg8::EpiSwiglu E{H, DFF}; \
        pg8::gemm_phase<pg8::EpiSwiglu, pg8::StaticOrder, true, true>(lds + RING_OFF, g, S, E); } while (0)
        P10_BODY; if (DUP(10)) { P10_BODY; }
        if (BOTH(10)) GRID_BAR();
    }

    if (IN(11)) {
#define P11_BODY do { pg8::Gemm g{H, Wdn_t, M, D, DFF, DFF, DFF, 30}; pg8::StaticOrder S; S.init(M, D, G, bx); \
        pg8::EpiPlain E{Y2, D}; \
        pg8::gemm_phase<pg8::EpiPlain, pg8::StaticOrder, true, true>(lds + RING_OFF, g, S, E); } while (0)
        P11_BODY; if (DUP(11)) { P11_BODY; }
        if (BOTH(11)) GRID_BAR();
    }

    if (IN(12)) {
        LAS float* cG = (LAS float*)lds;
        int cur_b = -1;
        for (int chunk = vcu; chunk < M / 64; chunk += G) {
            const int b = chunk / (SEQ / 64);
            if (b != cur_b) { __syncthreads();
                for (int i = tid; i < D; i += NWAVES * 64) cG[i] = mod[b * NMOD + 5 * D + i] * g_ffn_post[i];
                __syncthreads(); cur_b = b; }
            for (int r = wave; r < 64; r += NWAVES) { const size_t row = (size_t)chunk * 64 + r;
                f32x4* xr = (f32x4*)(out + row * D) + lane; const v2u* yr = (const v2u*)(Y2 + row * D) + lane; const v2u* x1r = (const v2u*)(X1B + row * D) + lane;
                f32x4 v[16]; v2u yv[16]; float sy = 0.f;
#pragma unroll
                for (int j = 0; j < 16; ++j) { const v2u q = x1r[64 * j]; v[j] = (f32x4){bf_lo(q.x), bf_hi(q.x), bf_lo(q.y), bf_hi(q.y)}; yv[j] = yr[64 * j]; }
#pragma unroll
                for (int j = 0; j < 16; ++j) { const f32x4 y = {bf_lo(yv[j].x), bf_hi(yv[j].x), bf_lo(yv[j].y), bf_hi(yv[j].y)}; sy += dot4(y); }
                const float rstdy = 1.0f / sqrtf(wave_sum(sy) * (1.0f / D) + RMS_EPS);
#pragma unroll
                for (int j = 0; j < 16; ++j) { const f32x4 y = {bf_lo(yv[j].x), bf_hi(yv[j].x), bf_lo(yv[j].y), bf_hi(yv[j].y)}; const f32x4 gq = ((const LAS f32x4*)cG)[lane + 64 * j];
                    xr[64 * j] = v[j] + gq * (y * rstdy); }
            }
        }
    }
#undef IN
#undef BOTH
#undef GRID_BAR
}

extern "C" void kernel_launch(void* const* d_in, const int* in_sizes, int n_in, void* d_out, int out_size, void* d_ws, size_t ws_size, hipStream_t stream) {
    static int grid = 0;
    if (grid == 0) {
        if (n_in != 23 || in_sizes[0] != M * D || out_size != M * D || ws_size < WS_END) {
            fprintf(stderr, "kernel_launch: built for 23 inputs, x/out of %d floats, >= %zu bytes of workspace; got n_in %d, in0 %d, out %d, ws %zu; nothing launched\n", M * D, (size_t)WS_END, n_in, n_in > 0 ? in_sizes[0] : -1, out_size, ws_size);
            grid = -1; return; }
        int dev = 0, cus = 0, per_cu = 0;
        if (hipGetDevice(&dev) != hipSuccess || hipDeviceGetAttribute(&cus, hipDeviceAttributeMultiprocessorCount, dev) != hipSuccess) { fprintf(stderr, "kernel_launch: device query failed\n"); grid = -1; return; }
        if (hipFuncSetAttribute((const void*)fwd_kernel, hipFuncAttributeMaxDynamicSharedMemorySize, LDS_BYTES) != hipSuccess) { fprintf(stderr, "kernel_launch: hipFuncSetAttribute failed\n"); grid = -1; return; }
        if (hipOccupancyMaxActiveBlocksPerMultiprocessor(&per_cu, (const void*)fwd_kernel, NWAVES * 64, LDS_BYTES) != hipSuccess || per_cu < 1)
            fprintf(stderr, "kernel_launch: note: occupancy query reports %d workgroups per CU\n", per_cu);
        (void)hipGetLastError();
        grid = cus;
    }
    if (grid < 0) return;
    if (hipMemsetAsync((char*)d_ws + WS_CTL, 0, CTL_ZERO_BYTES, stream) != hipSuccess) { fprintf(stderr, "kernel_launch: memset failed\n"); return; }
    Args a{};
    for (int i = 0; i < 23; ++i) a.in[i] = (const float*)d_in[i];
    a.out = (float*)d_out; a.ws = (unsigned char*)d_ws; a.pad = 0;
    for (int li = 0; li < N_LAUNCHES; ++li) {
        a.ph_lo = (N_LAUNCHES == NPH) ? li : (li * NPH) / N_LAUNCHES; a.ph_hi = (N_LAUNCHES == NPH) ? li + 1 : ((li + 1) * NPH) / N_LAUNCHES; a.li = li;
        hipLaunchKernelGGL(fwd_kernel, dim3(grid), dim3(NWAVES * 64), LDS_BYTES, stream, a);
        const hipError_t le = hipPeekAtLastError();
        if (le != hipSuccess) { fprintf(stderr, "kernel_launch: launch %d failed: %s\n", li, hipGetErrorName(le)); break; }
    }
}
```

```cpp
#include <hip/hip_runtime.h>
#include <cstdio>
#include <cstdint>

#ifndef MK_N_LAUNCHES
#define MK_N_LAUNCHES 1
#endif

namespace pg8 {
#define PG8_LAS __attribute__((address_space(3)))
typedef unsigned short bf16_t;
typedef short bf16x8 __attribute__((ext_vector_type(8)));
typedef float f32x4 __attribute__((ext_vector_type(4)));
typedef unsigned u32x4 __attribute__((ext_vector_type(4)));
typedef unsigned u32x2 __attribute__((ext_vector_type(2)));
constexpr int BM = 256, BK = 64, HALF = 128, HTB = HALF * BK * 2  , STAGE_BYTES = 8 * HTB, NXCD = 8, WGM = 8;

__host__ __device__ __forceinline__ int lds_byte(int r, int c) { const int st = (r >> 4) * 2 + (c >> 5), rr = r & 15, cc = c & 31, ob = rr * 64 + cc * 2; return st * 1024 + (ob ^ (((ob >> 9) & 1) << 5)); }
__host__ __device__ __forceinline__ void stage_rc(int b, int& R, int& C) { const int st = b / 1024, sb = b % 1024, swz = sb ^ (((sb >> 9) & 1) << 5); R = (st >> 1) * 16 + swz / 64; C = (st & 1) * 32 + (swz % 64) / 2; }
__host__ __device__ __forceinline__ int perm32(int rho) { const int n = rho >> 4, i = rho & 15; return 8 * (i >> 2) + 4 * n + (i & 3); }

struct Unit { int pm, pn; };
struct Gemm { const bf16_t* A; const bf16_t* Bt; int M, N, K, lda, ldb, agshift; };

struct StaticOrder {
    int nM, nN, nwg, G, c;
    __host__ __device__ void init(int M, int N, int G_, int c_) { nM = M / BM; nN = N / BM; nwg = nM * nN; G = G_; c = c_; }
    __host__ __device__ bool next(int i, Unit& u) const {
        const long L = (long)i * G + c; if (L >= nwg) return false;
        int wgid = (int)L; { const int q = nwg / NXCD, r = nwg % NXCD, xcd = wgid % NXCD, off = wgid / NXCD; wgid = (xcd < r ? xcd * (q + 1) : r * (q + 1) + (xcd - r) * q) + off; }
        const int nig = WGM * nN, gid = wgid / nig, fm = gid * WGM, gsz = (nM - fm) < WGM ? (nM - fm) : WGM;
        u.pm = fm + ((wgid % nig) % gsz); u.pn = (wgid % nig) / gsz; return true;
    }
    __device__ __forceinline__ void a_ready(const Unit&) const {}
    __device__ __forceinline__ void done(const Unit&) const {}
};

__device__ __forceinline__ unsigned cvt_pk_bf16(float lo, float hi) { unsigned r; asm volatile("v_cvt_pk_bf16_f32 %0, %1, %2" : "=v"(r) : "v"(lo), "v"(hi)); return r; }
__device__ __forceinline__ float bf_lo(unsigned w) { return __uint_as_float(w << 16); }
__device__ __forceinline__ float bf_hi(unsigned w) { return __uint_as_float(w & 0xffff0000u); }
__device__ __forceinline__ float fast_rcp(float x) { return __builtin_amdgcn_rcpf(x); }
__device__ __forceinline__ float fast_exp(float x) { return __builtin_amdgcn_exp2f(x * 1.44269504088896f); }
__device__ __forceinline__ float sigmoidf_(float x) { return fast_rcp(1.0f + fast_exp(-x)); }
__device__ __forceinline__ float siluf_(float x) { return x * sigmoidf_(x); }
__device__ __forceinline__ float gelu_tanh_(float x) { const float z = 1.5957691216057308f * (x + 0.044715f * x * x * x); return x * sigmoidf_(z); }

struct EpiPlain {
    static constexpr bool PERM = true;
    bf16_t* O; int ldc;
    __device__ __forceinline__ void operator()(const f32x4 (&acc)[2][2][4][2], const Unit& u, int wr, int wc, int fr, int fq) const {
        const int row0 = u.pm * BM + wr * 64 + fr, col0 = u.pn * BM + wc * 32 + 8 * fq;
#pragma unroll
        for (int ai = 0; ai < 2; ++ai)
#pragma unroll
            for (int m = 0; m < 4; ++m) { bf16_t* rowp = O + (size_t)(row0 + ai * HALF + m * 16) * ldc + col0;
#pragma unroll
                for (int bj = 0; bj < 2; ++bj) { const f32x4 v0 = acc[ai][bj][m][0], v1 = acc[ai][bj][m][1];
                    u32x4 w; w.x = cvt_pk_bf16(v0[0], v0[1]); w.y = cvt_pk_bf16(v0[2], v0[3]); w.z = cvt_pk_bf16(v1[0], v1[1]); w.w = cvt_pk_bf16(v1[2], v1[3]);
                    *(u32x4*)(rowp + bj * HALF) = w; } }
    }
};
struct EpiScale {
    static constexpr bool PERM = true;
    bf16_t* O; int ldc; const float* scale;
    __device__ __forceinline__ void operator()(const f32x4 (&acc)[2][2][4][2], const Unit& u, int wr, int wc, int fr, int fq) const {
        const int row0 = u.pm * BM + wr * 64 + fr, col0 = u.pn * BM + wc * 32 + 8 * fq;
        f32x4 sv[2][2];
#pragma unroll
        for (int bj = 0; bj < 2; ++bj)
#pragma unroll
            for (int n = 0; n < 2; ++n) sv[bj][n] = *(const f32x4*)(scale + col0 + bj * HALF + 4 * n);
#pragma unroll
        for (int ai = 0; ai < 2; ++ai)
#pragma unroll
            for (int m = 0; m < 4; ++m) { bf16_t* rowp = O + (size_t)(row0 + ai * HALF + m * 16) * ldc + col0;
#pragma unroll
                for (int bj = 0; bj < 2; ++bj) { const f32x4 v0 = acc[ai][bj][m][0] * sv[bj][0], v1 = acc[ai][bj][m][1] * sv[bj][1];
                    u32x4 w; w.x = cvt_pk_bf16(v0[0], v0[1]); w.y = cvt_pk_bf16(v0[2], v0[3]); w.z = cvt_pk_bf16(v1[0], v1[1]); w.w = cvt_pk_bf16(v1[2], v1[3]);
                    *(u32x4*)(rowp + bj * HALF) = w; } }
    }
};
template <bool ADD> struct EpiGate {
    static constexpr bool PERM = true;
    bf16_t* O; int ldc; const bf16_t* Gt; int ldg;
    __device__ __forceinline__ void operator()(const f32x4 (&acc)[2][2][4][2], const Unit& u, int wr, int wc, int fr, int fq) const {
        const int row0 = u.pm * BM + wr * 64 + fr, col0 = u.pn * BM + wc * 32 + 8 * fq;
#pragma unroll
        for (int ai = 0; ai < 2; ++ai) {
            u32x4 g[4][2], p[4][2];
#pragma unroll
            for (int m = 0; m < 4; ++m) { const size_t row = (size_t)(row0 + ai * HALF + m * 16);
#pragma unroll
                for (int bj = 0; bj < 2; ++bj) { g[m][bj] = *(const u32x4*)(Gt + row * ldg + col0 + bj * HALF); if (ADD) p[m][bj] = *(const u32x4*)(O + row * ldc + col0 + bj * HALF); } }
            asm volatile("" ::: "memory");
#pragma unroll
            for (int m = 0; m < 4; ++m) { const size_t row = (size_t)(row0 + ai * HALF + m * 16); bf16_t* rowp = O + row * ldc + col0;
#pragma unroll
                for (int bj = 0; bj < 2; ++bj) { const u32x4 gg = g[m][bj]; const f32x4 v0 = acc[ai][bj][m][0], v1 = acc[ai][bj][m][1];
                    float o[8];
                    o[0] = sigmoidf_(bf_lo(gg.x)) * v0[0]; o[1] = sigmoidf_(bf_hi(gg.x)) * v0[1]; o[2] = sigmoidf_(bf_lo(gg.y)) * v0[2]; o[3] = sigmoidf_(bf_hi(gg.y)) * v0[3];
                    o[4] = sigmoidf_(bf_lo(gg.z)) * v1[0]; o[5] = sigmoidf_(bf_hi(gg.z)) * v1[1]; o[6] = sigmoidf_(bf_lo(gg.w)) * v1[2]; o[7] = sigmoidf_(bf_hi(gg.w)) * v1[3];
                    if (ADD) { const u32x4 pp = p[m][bj];
                        o[0] += bf_lo(pp.x); o[1] += bf_hi(pp.x); o[2] += bf_lo(pp.y); o[3] += bf_hi(pp.y); o[4] += bf_lo(pp.z); o[5] += bf_hi(pp.z); o[6] += bf_lo(pp.w); o[7] += bf_hi(pp.w); }
                    u32x4 w; w.x = cvt_pk_bf16(o[0], o[1]); w.y = cvt_pk_bf16(o[2], o[3]); w.z = cvt_pk_bf16(o[4], o[5]); w.w = cvt_pk_bf16(o[6], o[7]);
                    *(u32x4*)(rowp + bj * HALF) = w; } }
            asm volatile("" ::: "memory");
        }
    }
};
struct EpiSwiglu {
    static constexpr bool PERM = true;
    bf16_t* O; int ldc;
    __device__ __forceinline__ void operator()(const f32x4 (&acc)[2][2][4][2], const Unit& u, int wr, int wc, int fr, int fq) const {
        const int row0 = u.pm * BM + wr * 64 + fr, col0 = u.pn * HALF + wc * 32 + 8 * fq;
#pragma unroll
        for (int ai = 0; ai < 2; ++ai)
#pragma unroll
            for (int m = 0; m < 4; ++m) { bf16_t* rowp = O + (size_t)(row0 + ai * HALF + m * 16) * ldc + col0;
                const f32x4 g0 = acc[ai][0][m][0], g1 = acc[ai][0][m][1], u0 = acc[ai][1][m][0], u1 = acc[ai][1][m][1];
                u32x4 w; w.x = cvt_pk_bf16(siluf_(g0[0]) * u0[0], siluf_(g0[1]) * u0[1]); w.y = cvt_pk_bf16(siluf_(g0[2]) * u0[2], siluf_(g0[3]) * u0[3]);
                w.z = cvt_pk_bf16(siluf_(g1[0]) * u1[0], siluf_(g1[1]) * u1[1]); w.w = cvt_pk_bf16(siluf_(g1[2]) * u1[2], siluf_(g1[3]) * u1[3]);
                *(u32x4*)rowp = w; }
    }
};
struct EpiRg {
    static constexpr bool PERM = false;
    const bf16_t* XC; unsigned* AU; const float* b_a; const float* b_x; const float* sp8; int ldx;
    __device__ __forceinline__ void operator()(const f32x4 (&acc)[2][2][4][2], const Unit& u, int wr, int wc, int fr, int fq) const {
        const int row0 = u.pm * BM + wr * 64 + fr, chb = u.pn * HALF + wc * 32 + 4 * fq;
        u32x2 xw[2][4][2];
#pragma unroll
        for (int ai = 0; ai < 2; ++ai)
#pragma unroll
            for (int m = 0; m < 4; ++m)
#pragma unroll
                for (int n = 0; n < 2; ++n) xw[ai][m][n] = *(const u32x2*)(XC + (size_t)(row0 + ai * HALF + m * 16) * ldx + chb + 16 * n);
        asm volatile("" ::: "memory");
#pragma unroll
        for (int n = 0; n < 2; ++n) { const int ch = chb + 16 * n;
            const f32x4 ba = *(const f32x4*)(b_a + ch), bx = *(const f32x4*)(b_x + ch), sp = *(const f32x4*)(sp8 + ch);
#pragma unroll
            for (int ai = 0; ai < 2; ++ai)
#pragma unroll
                for (int m = 0; m < 4; ++m) { const size_t row = (size_t)(row0 + ai * HALF + m * 16);
                    const u32x2 xq = xw[ai][m][n];
                    const float xv[4] = {bf_lo(xq.x), bf_hi(xq.x), bf_lo(xq.y), bf_hi(xq.y)};
                    const f32x4 rp = acc[ai][0][m][n] + ba, ip = acc[ai][1][m][n] + bx;
                    unsigned w[4];
#pragma unroll
                    for (int j = 0; j < 4; ++j) { const float r = sigmoidf_(rp[j]), ig = sigmoidf_(ip[j]); const float la = sp[j] * r, x2 = la + la;
                        const float poly = x2 * (1.0f + x2 * (0.5f + x2 * (0.16666667f + x2 * (0.041666668f + x2 * (0.0083333338f + x2 * 0.0013888889f)))));
                        const float em1 = (x2 > -0.25f) ? poly : (fast_exp(x2) - 1.0f);
                        const float mult = __builtin_sqrtf(fmaxf(-em1, 0.0f));
                        w[j] = cvt_pk_bf16(la, mult * ig * xv[j]); }
                    u32x4 o; o.x = w[0]; o.y = w[1]; o.z = w[2]; o.w = w[3];
                    *(u32x4*)(AU + row * ldx + ch) = o;
                    __builtin_amdgcn_sched_barrier(0); } }
    }
};

template <class Epi, class Sched, bool ALIGN_EPI = false, bool SP2 = false>
__device__ __forceinline__ void gemm_phase(PG8_LAS unsigned char* lds, const Gemm g, const Sched& S, const Epi& E) {
    const int tid = threadIdx.x, wid = __builtin_amdgcn_readfirstlane(tid >> 6), lane = tid & 63, wr = wid >> 2, wc = wid & 3, fr = lane & 15, fq = lane >> 4;
    const int K = g.K, nt = K / BK;
    unsigned voffA[2], voffB[2];
#pragma unroll
    for (int i = 0; i < 2; ++i) { int R, C; stage_rc(tid * 16 + i * 8192, R, C); const int Rb = Epi::PERM ? ((R & ~31) + perm32(R & 31)) : R;
        voffA[i] = (unsigned)(R * g.lda + C) * 2u; voffB[i] = (unsigned)(Rb * g.ldb + C) * 2u; }
    const size_t kstep = (size_t)(BK * 2);
    const size_t hstepA = (size_t)HALF * g.lda * 2, hstepB = (size_t)HALF * g.ldb * 2;
    const size_t tstepA = 2 * hstepA, tstepB = 2 * hstepB;
    const unsigned ldsw = (unsigned)wid * 1024u;
    const int aoff = lds_byte(wr * 64 + fr, fq * 8), boff = lds_byte(wc * 32 + fr, fq * 8);
#define PG8_SA(b, h) (((b) * 2 + (h)) * HTB)
#define PG8_SB(b, h) ((4 + (b) * 2 + (h)) * HTB)
#define PG8_STAGE(bufoff, gbase, voff) do { _Pragma("unroll") for (int _i = 0; _i < 2; ++_i) \
        __builtin_amdgcn_global_load_lds((const unsigned*)((const char*)(gbase) + (voff)[_i]), (PG8_LAS unsigned*)(lds + (bufoff) + ldsw + _i * 8192), 16, 0, 0); } while (0)
#define PG8_LDA(dst, b, h) do { _Pragma("unroll") for (int m = 0; m < 4; ++m) _Pragma("unroll") for (int k = 0; k < 2; ++k) dst[m][k] = *(const PG8_LAS bf16x8*)(lds + PG8_SA(b, h) + aoff + m * 2048 + k * 1024); } while (0)
#define PG8_LDB(dst, b, h) do { _Pragma("unroll") for (int n = 0; n < 2; ++n) _Pragma("unroll") for (int k = 0; k < 2; ++k) dst[n][k] = *(const PG8_LAS bf16x8*)(lds + PG8_SB(b, h) + boff + n * 2048 + k * 1024); } while (0)
#define PG8_MMA(ai, bj, At, Bt) do { __builtin_amdgcn_s_setprio(1); _Pragma("unroll") for (int m = 0; m < 4; ++m) _Pragma("unroll") for (int n = 0; n < 2; ++n) _Pragma("unroll") for (int k = 0; k < 2; ++k) \
        acc[ai][bj][m][n] = __builtin_amdgcn_mfma_f32_16x16x32_bf16(Bt[n][k], At[m][k], acc[ai][bj][m][n], 0, 0, 0); __builtin_amdgcn_s_setprio(0); } while (0)
#define PG8_WAIT_V(n) asm volatile("s_waitcnt vmcnt(" #n ")" ::: "memory")
#define PG8_WAIT_L(n) asm volatile("s_waitcnt lgkmcnt(" #n ")" ::: "memory")
#define PG8_BAR __builtin_amdgcn_s_barrier()
#define PG8_SCHED __builtin_amdgcn_sched_barrier(0)
#define PG8_ABASE(u) ((const char*)g.A + (size_t)(u).pm * tstepA + (size_t)((u).pn >> g.agshift) * (size_t)K * 2)
#define PG8_BBASE(u) ((const char*)g.Bt + (size_t)(u).pn * tstepB)
    Unit cur, nxt; int ui = 0;
    if (!S.next(0, cur)) return;
    f32x4 acc[2][2][4][2];
#pragma unroll
    for (int a = 0; a < 2; ++a)
#pragma unroll
        for (int b = 0; b < 2; ++b)
#pragma unroll
            for (int m = 0; m < 4; ++m)
#pragma unroll
                for (int n = 0; n < 2; ++n) acc[a][b][m][n] = (f32x4){0.f, 0.f, 0.f, 0.f};
    bf16x8 At[4][2], B0[2][2], B1[2][2];
    const char* cA = PG8_ABASE(cur); const char* cB = PG8_BBASE(cur);
    S.a_ready(cur);
    if constexpr (SP2) {
        PG8_STAGE(PG8_SB(0, 0), cB, voffB); PG8_STAGE(PG8_SB(0, 1), cB + hstepB, voffB); PG8_STAGE(PG8_SA(0, 0), cA, voffA); PG8_STAGE(PG8_SA(0, 1), cA + hstepA, voffA);
        if (wr == 1) PG8_BAR;
        PG8_WAIT_V(2); PG8_BAR;
        PG8_STAGE(PG8_SB(1, 0), cB + kstep, voffB); PG8_STAGE(PG8_SA(1, 0), cA + kstep, voffA); PG8_STAGE(PG8_SB(1, 1), cB + hstepB + kstep, voffB);
        PG8_WAIT_V(6); PG8_BAR;
    } else {
        PG8_STAGE(PG8_SB(0, 0), cB, voffB); PG8_STAGE(PG8_SA(0, 0), cA, voffA); PG8_STAGE(PG8_SB(0, 1), cB + hstepB, voffB); PG8_STAGE(PG8_SA(0, 1), cA + hstepA, voffA);
        if (wr == 1) PG8_BAR;
        PG8_WAIT_V(4); PG8_BAR;
        PG8_STAGE(PG8_SB(1, 0), cB + kstep, voffB); PG8_STAGE(PG8_SA(1, 0), cA + kstep, voffA); PG8_STAGE(PG8_SB(1, 1), cB + hstepB + kstep, voffB);
        PG8_WAIT_V(6); PG8_BAR;
    }
    for (;;) {
        const bool has_next = S.next(ui + 1, nxt);
        const char* nA = has_next ? PG8_ABASE(nxt) : cA; const char* nB = has_next ? PG8_BBASE(nxt) : cB;
#pragma unroll 1
        for (int t = 0; t < nt; t += 2) {
            const bool last = (t == nt - 2);
            const char* a1 = cA + (size_t)(t + 1) * kstep;
            const char* a2 = last ? nA : cA + (size_t)(t + 2) * kstep; const char* b2 = last ? nB : cB + (size_t)(t + 2) * kstep;
            const char* a3 = a2 + kstep; const char* b3 = b2 + kstep;
            if (last && has_next) S.a_ready(nxt);
            if constexpr (SP2) {
            PG8_LDB(B0, 0, 0); PG8_LDB(B1, 0, 1); PG8_SCHED; PG8_LDA(At, 0, 0); PG8_STAGE(PG8_SA(1, 1), a1 + hstepA, voffA);
            PG8_WAIT_V(8); PG8_WAIT_L(0); PG8_BAR; PG8_MMA(0, 0, At, B0); PG8_MMA(0, 1, At, B1); PG8_BAR; PG8_SCHED;
            PG8_LDA(At, 0, 1); PG8_STAGE(PG8_SB(0, 0), b2, voffB); PG8_STAGE(PG8_SB(0, 1), b2 + hstepB, voffB); PG8_STAGE(PG8_SA(0, 0), a2, voffA);
            PG8_WAIT_V(8); PG8_WAIT_L(0); PG8_BAR; PG8_MMA(1, 0, At, B0); PG8_MMA(1, 1, At, B1); PG8_BAR; PG8_SCHED;
            PG8_LDB(B0, 1, 0); PG8_LDB(B1, 1, 1); PG8_SCHED; PG8_LDA(At, 1, 0); PG8_STAGE(PG8_SA(0, 1), a2 + hstepA, voffA);
            PG8_WAIT_V(8); PG8_WAIT_L(0); PG8_BAR; PG8_MMA(0, 0, At, B0); PG8_MMA(0, 1, At, B1); PG8_BAR; PG8_SCHED;
            PG8_LDA(At, 1, 1); PG8_STAGE(PG8_SB(1, 0), b3, voffB); PG8_STAGE(PG8_SB(1, 1), b3 + hstepB, voffB); PG8_STAGE(PG8_SA(1, 0), a3, voffA);
            PG8_WAIT_V(8); PG8_WAIT_L(0); PG8_BAR; PG8_MMA(1, 0, At, B0); PG8_MMA(1, 1, At, B1); PG8_BAR; PG8_SCHED;
            } else {
            PG8_LDB(B0, 0, 0); PG8_SCHED; PG8_LDA(At, 0, 0); PG8_STAGE(PG8_SA(1, 1), a1 + hstepA, voffA);
            PG8_WAIT_L(8); PG8_BAR; PG8_WAIT_L(0); PG8_MMA(0, 0, At, B0); PG8_BAR; PG8_SCHED;
            PG8_LDB(B1, 0, 1); PG8_STAGE(PG8_SB(0, 0), b2, voffB);
            PG8_BAR; PG8_WAIT_L(0); PG8_MMA(0, 1, At, B1); PG8_BAR;
            PG8_LDA(At, 0, 1); PG8_STAGE(PG8_SA(0, 0), a2, voffA);
            PG8_BAR; PG8_WAIT_L(0); PG8_MMA(1, 0, At, B0); PG8_BAR; PG8_SCHED;
            PG8_STAGE(PG8_SB(0, 1), b2 + hstepB, voffB);
            PG8_WAIT_V(6); PG8_BAR; PG8_MMA(1, 1, At, B1); PG8_BAR;
            PG8_LDB(B0, 1, 0); PG8_SCHED; PG8_LDA(At, 1, 0); PG8_STAGE(PG8_SA(0, 1), a2 + hstepA, voffA);
            PG8_WAIT_L(8); PG8_BAR; PG8_WAIT_L(0); PG8_MMA(0, 0, At, B0); PG8_BAR; PG8_SCHED;
            PG8_LDB(B1, 1, 1); PG8_STAGE(PG8_SB(1, 0), b3, voffB);
            PG8_BAR; PG8_WAIT_L(0); PG8_MMA(0, 1, At, B1); PG8_BAR;
            PG8_LDA(At, 1, 1); PG8_STAGE(PG8_SA(1, 0), a3, voffA);
            PG8_BAR; PG8_WAIT_L(0); PG8_MMA(1, 0, At, B0); PG8_BAR; PG8_SCHED;
            PG8_STAGE(PG8_SB(1, 1), b3 + hstepB, voffB);
            PG8_WAIT_V(6); PG8_BAR; PG8_MMA(1, 1, At, B1); PG8_BAR;
            }
        }
        if constexpr (ALIGN_EPI) { if (wr == 0) PG8_BAR; }
        E(acc, cur, wr, wc, fr, fq); S.done(cur);
        if (!has_next) break;
#pragma unroll
        for (int a = 0; a < 2; ++a)
#pragma unroll
            for (int b = 0; b < 2; ++b)
#pragma unroll
                for (int m = 0; m < 4; ++m)
#pragma unroll
                    for (int n = 0; n < 2; ++n) acc[a][b][m][n] = (f32x4){0.f, 0.f, 0.f, 0.f};
        cur = nxt; cA = nA; cB = nB; ++ui;
        if constexpr (ALIGN_EPI) { if (wr == 1) PG8_BAR; }
    }
    PG8_WAIT_V(0);
    if constexpr (!ALIGN_EPI) { if (wr == 0) PG8_BAR; }
    PG8_BAR;
#undef PG8_SA
#undef PG8_SB
#undef PG8_STAGE
#undef PG8_LDA
#undef PG8_LDB
#undef PG8_MMA
#undef PG8_WAIT_V
#undef PG8_WAIT_L
#undef PG8_BAR
#undef PG8_SCHED
#undef PG8_ABASE
#undef PG8_BBASE
}
}

constexpr int NWAVES = 8;
constexpr int N_LAUNCHES = MK_N_LAUNCHES;
constexpr int NPH = 13;
constexpr int BATCH = 2, SEQ = 8192, D = 4096, M = BATCH * SEQ;
constexpr int NIN = 5 * D;
constexpr int DFF = 11008, NGU = 2 * DFF;
constexpr int NMOD = 6 * D;
constexpr int HEADS = 16, HD = 256, PGRP = 4, PGD = 1024;
constexpr float RMS_EPS = 1e-6f;
constexpr int SCAN_T = 128, SCAN_NC = SEQ / SCAN_T;

constexpr size_t MiB = 1u << 20;
constexpr size_t WS_CTL = 0, CTL_ZERO_BYTES = 1 * MiB;
constexpr size_t WS_MOD = 1 * MiB;
constexpr size_t WS_SP8 = WS_MOD + 256 * 1024;
constexpr size_t WS_CP = WS_MOD + 512 * 1024;
constexpr size_t WS_WRG = 2 * MiB;
constexpr size_t WS_WPOOL = 6 * MiB;
constexpr size_t WS_WBL = 14 * MiB;
constexpr size_t WS_WBP = 46 * MiB;
constexpr size_t WS_WO = 78 * MiB;
constexpr size_t WS_WIN = 110 * MiB;
constexpr size_t WS_XC = 110 * MiB;
constexpr size_t WS_MERGED = 110 * MiB;
constexpr size_t WS_SCANC = 240 * MiB;
constexpr size_t WS_U = 270 * MiB;
constexpr size_t WS_POOLED = 270 * MiB;
constexpr size_t WS_PROJ = 398 * MiB;
constexpr size_t WS_WGU = 398 * MiB;
constexpr size_t WS_WDN = 570 * MiB;
constexpr size_t WS_H = 656 * MiB;
constexpr size_t WS_AU = 1038 * MiB;
constexpr size_t WS_Y = 1038 * MiB;
constexpr size_t WS_Y2 = 1166 * MiB;
constexpr size_t WS_YL = 1294 * MiB;
constexpr size_t WS_X1B = 1294 * MiB;
constexpr size_t WS_YP = 1422 * MiB;
constexpr size_t WS_END = 1550 * MiB;
static_assert(WS_WIN + (size_t)NIN * D * 2 <= WS_U && WS_SCANC + 4 * MiB <= WS_U && WS_XC + (size_t)M * D * 2 <= WS_SCANC, "ws map 1");
static_assert(WS_U + (size_t)M * D * 2 <= WS_PROJ && WS_PROJ + (size_t)M * NIN * 2 <= WS_AU, "ws map 2");
static_assert(WS_WGU + (size_t)NGU * D * 2 <= WS_WDN && WS_WDN + (size_t)D * DFF * 2 <= WS_H && WS_H + (size_t)M * DFF * 2 <= WS_AU, "ws map 3");
static_assert(WS_AU + (size_t)M * D * 4 <= WS_YL && WS_Y2 + (size_t)M * D * 2 <= WS_YL && WS_YP + (size_t)M * D * 2 <= WS_END, "ws map 4");
constexpr int CW_TMO = 0;
constexpr int CW_BAR = 4096;

constexpr int RING_OFF = 0, RING_BYTES = 131072;
constexpr int LDSCTL_OFF = RING_BYTES, MISC_OFF = LDSCTL_OFF + 320;
constexpr int LDS_BYTES = 147456;
static_assert(MISC_OFF + 128 <= LDS_BYTES, "LDS map");

#define GAS __attribute__((address_space(1)))
#define LAS __attribute__((address_space(3)))
typedef unsigned short bf16;
typedef unsigned v4u __attribute__((ext_vector_type(4)));
typedef unsigned v2u __attribute__((ext_vector_type(2)));
typedef float f32x4 __attribute__((ext_vector_type(4)));
typedef float f32x2 __attribute__((ext_vector_type(2)));
typedef GAS unsigned gu32;
#define RLX_AGENT __ATOMIC_RELAXED, __HIP_MEMORY_SCOPE_AGENT
#define LDS_WAIT() asm volatile("s_waitcnt lgkmcnt(0)" ::: "memory")
#define VM_WAIT() asm volatile("s_waitcnt vmcnt(0)" ::: "memory")
using pg8::cvt_pk_bf16; using pg8::bf_lo; using pg8::bf_hi;

#define XB_TMO      128
#define XB_XCNT(j)  (256  + 64 * (j))
#define XB_XSUB(j)  (1280 + 64 * (j))
#define XB_XGEN(j)  (2304 + 64 * (j))
#define XB_TOP      3328
#define XB_TOPGEN   3392
#define XCD_BAR_WORDS 3456
#define XB_SPIN_CAP (1u << 18)

__device__ __forceinline__ unsigned xb_ld(unsigned* p)              { return __hip_atomic_load(p, __ATOMIC_RELAXED, __HIP_MEMORY_SCOPE_AGENT); }
__device__ __forceinline__ unsigned xb_add(unsigned* p, unsigned v) { return __hip_atomic_fetch_add(p, v, __ATOMIC_RELAXED, __HIP_MEMORY_SCOPE_AGENT); }
__device__ __forceinline__ unsigned xb_xcc_id() { return (unsigned)__builtin_amdgcn_s_getreg((3 << 11) | 20) & 0xFu; }
#define XB_SPIN(cond, bar) do { unsigned _sp = 0; while (cond) { __builtin_amdgcn_s_sleep(1); \
    if ((++_sp & 255u) == 0u) { if (xb_ld(&(bar)[XB_TMO])) break; if (_sp > XB_SPIN_CAP) { atomicAdd(&(bar)[XB_TMO], 1u); break; } } } } while (0)

struct XcdBarrier {
    unsigned* bar; unsigned x;
    volatile LAS unsigned* st;
};
__device__ __forceinline__ XcdBarrier xcd_barrier_post(unsigned* bar, volatile LAS unsigned* st) {
    XcdBarrier b; b.bar = bar; b.x = xb_xcc_id(); b.st = st;
    if (threadIdx.x == 0) (void)xb_add(&bar[XB_XCNT(b.x)], 1u);
    return b;
}
__device__ __forceinline__ void xcd_barrier_complete(unsigned* bar, unsigned x, unsigned& nloc, unsigned& nx) {
    const unsigned G = gridDim.x * gridDim.y * gridDim.z;
    unsigned sum, cnt, mine, sp = 0u;
    for (;;) {
        sum = 0u; cnt = 0u; mine = 0u;
#pragma unroll
        for (unsigned j = 0; j < 16; ++j) { const unsigned c = xb_ld(&bar[XB_XCNT(j)]); sum += c; cnt += (c > 0u) ? 1u : 0u; mine = (j == x) ? c : mine; }
        if (sum == G) break;
        __builtin_amdgcn_s_sleep(1);
        if ((++sp & 255u) == 0u) { if (xb_ld(&bar[XB_TMO])) break; if (sp > XB_SPIN_CAP) { atomicAdd(&bar[XB_TMO], 1u); break; } }
    }
    nloc = mine > 0u ? mine : 1u; nx = cnt > 0u ? cnt : 1u;
}
__device__ __forceinline__ void xcd_barrier(const XcdBarrier& b) {
    asm volatile("s_waitcnt vmcnt(0)" ::: "memory");
    __syncthreads();
    if (threadIdx.x == 0) {
        unsigned* bar = b.bar;
        __builtin_amdgcn_s_waitcnt(0);
        unsigned nloc = b.st[0], nx = b.st[1];
        if (nloc == 0u) { xcd_barrier_complete(bar, b.x, nloc, nx); b.st[0] = nloc; b.st[1] = nx; }
        const unsigned old = xb_add(&bar[XB_XSUB(b.x)], 1u);
        const unsigned gen = old / nloc;
        if (old + 1u == (gen + 1u) * nloc) {
            __builtin_amdgcn_fence(__ATOMIC_RELEASE, "agent");
            asm volatile("s_waitcnt vmcnt(0)" ::: "memory");
            const unsigned og = xb_add(&bar[XB_TOP], 1u);
            const unsigned tg = og / nx;
            if (og + 1u == (tg + 1u) * nx) xb_add(&bar[XB_TOPGEN], 1u);
            else XB_SPIN(xb_ld(&bar[XB_TOPGEN]) == tg, bar);
            __builtin_amdgcn_fence(__ATOMIC_ACQUIRE, "agent");
            xb_add(&bar[XB_XGEN(b.x)], 1u);
            asm volatile("s_waitcnt vmcnt(0)" ::: "memory");
        } else {
            XB_SPIN(xb_ld(&bar[XB_XGEN(b.x)]) == gen, bar);
            __builtin_amdgcn_fence(__ATOMIC_ACQUIRE, "agent");
            asm volatile("s_waitcnt vmcnt(0)" ::: "memory");
        }
    }
    __syncthreads();
}

__device__ __forceinline__ float wave_sum(float v) {
#pragma unroll
    for (int o = 1; o < 64; o <<= 1) v += __shfl_xor(v, o);
    return v;
}
__device__ __forceinline__ float dot4(f32x4 a) { return (a.x * a.x + a.y * a.y) + (a.z * a.z + a.w * a.w); }

__device__ __forceinline__ void transpose_item(const float* W, int N, bf16* WT, int ldk, int k0, int n0, int drow0, LAS float* scr, int lane) {
#pragma unroll 8
    for (int i = 0; i < 32; ++i) { const int kk = 2 * i + (lane >> 5); scr[kk * 33 + (lane & 31)] = W[(size_t)(k0 + kk) * N + n0 + (lane & 31)]; }
    LDS_WAIT(); asm volatile("" ::: "memory");
    const int c = lane & 7;
#pragma unroll
    for (int j = 0; j < 4; ++j) { const int n = (lane >> 3) + 8 * j; const LAS float* s = scr + (8 * c) * 33 + n;
        v4u o;
        { o.x = cvt_pk_bf16(s[0 * 33], s[1 * 33]); o.y = cvt_pk_bf16(s[2 * 33], s[3 * 33]); o.z = cvt_pk_bf16(s[4 * 33], s[5 * 33]); o.w = cvt_pk_bf16(s[6 * 33], s[7 * 33]); }
        *(v4u*)(WT + (size_t)(drow0 + n) * ldk + k0 + 8 * c) = o; }
    LDS_WAIT(); asm volatile("" ::: "memory");
}
template <int DMAP>
__device__ __forceinline__ void transpose_matrix(const float* W, int K, int N, bf16* WT, int ldk, int drow_off, LAS float* scr, int lane, int gw, int NGW, int& itbase) {
    const int nblk = N / 32, nitems = (K / 64) * nblk;
    int it = gw - (itbase % NGW); if (it < 0) it += NGW;
    for (; it < nitems; it += NGW) {
        const int kb = it / nblk, nb = it % nblk, n0 = 32 * nb;
        int drow;
        if (DMAP == 1) { const int isup = n0 >= DFF ? 1 : 0, j = n0 - isup * DFF; drow = (j >> 7) * 256 + isup * 128 + (j & 127); }
        else drow = n0;
        transpose_item(W, N, WT, ldk, 64 * kb, n0, drow_off + drow, scr, lane);
    }
    itbase += nitems;
}

__device__ __forceinline__ void unpack4(const v2u q, float (&f)[4]) { f[0] = bf_lo(q.x); f[1] = bf_hi(q.x); f[2] = bf_lo(q.y); f[3] = bf_hi(q.y); }
template <int W>
__device__ __forceinline__ void conv_pool_chunk(const bf16* PROJ, bf16* XC, bf16* POOLED, const float* conv_w, const float* conv_b, int chunk, int ch0) {
    float cw[4][4], cb[4];
#pragma unroll
    for (int k = 0; k < 4; ++k) { const f32x4 a = *(const f32x4*)(conv_w + k * D + ch0); cw[k][0] = a.x; cw[k][1] = a.y; cw[k][2] = a.z; cw[k][3] = a.w; }
    { const f32x4 a = *(const f32x4*)(conv_b + ch0); cb[0] = a.x; cb[1] = a.y; cb[2] = a.z; cb[3] = a.w; }
    const size_t row0 = (size_t)chunk * 64; const int t0 = (int)(row0 % SEQ);
    const bf16* pr = PROJ + row0 * NIN + ch0;
    float cx[4][4];
    v2u ph[W];
    float s[4];
#pragma unroll
    for (int j = 0; j < 4; ++j) s[j] = 0.f;
#pragma unroll
    for (int q = 0; q < 4; ++q)
#pragma unroll
        for (int j = 0; j < 4; ++j) cx[q][j] = 0.f;
#pragma unroll
    for (int q = 0; q < W; ++q) ph[q] = (v2u){0u, 0u};
    if (t0 > 0) {
#pragma unroll
        for (int q = 1; q <= 3; ++q) { const v2u x = *(const v2u*)(pr - (ptrdiff_t)q * NIN); unpack4(x, cx[(64 - q) & 3]); }
#pragma unroll
        for (int q = 1; q < W; ++q) { const v2u x = *(const v2u*)(pr + 2 * D - (ptrdiff_t)q * NIN); ph[(64 - q) & (W - 1)] = x; float f[4]; unpack4(x, f);
#pragma unroll
            for (int j = 0; j < 4; ++j) s[j] += f[j]; }
    }
    const bf16* p = pr; bf16* xo = XC + row0 * D + ch0; bf16* po = POOLED + row0 * D + ch0;
#pragma unroll 1
    for (int rb = 0; rb < 4; ++rb) {
#pragma unroll
        for (int h8 = 0; h8 < 2; ++h8) {
            v2u xnb[8], pnb[8];
#pragma unroll
            for (int q = 0; q < 8; ++q) { xnb[q] = *(const v2u*)(p + (size_t)q * NIN); pnb[q] = *(const v2u*)(p + (size_t)q * NIN + 2 * D); }
#pragma unroll
            for (int q = 0; q < 8; ++q) { const int rr = h8 * 8 + q; const int r = rb * 16 + rr;
                const v2u xn = xnb[q], pn = pnb[q];
                float xf[4]; unpack4(xn, xf);
                float a[4];
#pragma unroll
                for (int j = 0; j < 4; ++j) a[j] = cb[j] + cw[0][j] * cx[(rr + 1) & 3][j] + cw[1][j] * cx[(rr + 2) & 3][j] + cw[2][j] * cx[(rr + 3) & 3][j] + cw[3][j] * xf[j];
#pragma unroll
                for (int j = 0; j < 4; ++j) cx[rr & 3][j] = xf[j];
                { v2u o; o.x = cvt_pk_bf16(a[0], a[1]); o.y = cvt_pk_bf16(a[2], a[3]); *(v2u*)(xo + (size_t)q * D) = o; }
                float pf[4], of[4]; unpack4(pn, pf); unpack4(ph[rr & (W - 1)], of);
                ph[rr & (W - 1)] = pn;
                const int t = t0 + r; const int cnt = (t + 1 < W) ? (t + 1) : W; const float inv = 1.0f / (float)cnt;
#pragma unroll
                for (int j = 0; j < 4; ++j) { s[j] += pf[j] - of[j]; a[j] = s[j] * inv - pf[j]; }
                { v2u o; o.x = cvt_pk_bf16(a[0], a[1]); o.y = cvt_pk_bf16(a[2], a[3]); *(v2u*)(po + (size_t)q * D) = o; }
            }
            p += 8 * NIN; xo += 8 * D; po += 8 * D;
            asm volatile("" ::: "memory");
        }
    }
}

struct Args { const float* in[23]; float* out; unsigned char* ws; int ph_lo, ph_hi, li, pad; };

__global__ void __launch_bounds__(NWAVES * 64, 2) fwd_kernel(Args args) {
    extern __shared__ __attribute__((aligned(16))) unsigned char lds_raw[];
    LAS unsigned char* lds = (LAS unsigned char*)lds_raw;
    volatile LAS unsigned* MISC = (volatile LAS unsigned*)(lds + MISC_OFF);
    const int tid = threadIdx.x, lane = tid & 63, wave = __builtin_amdgcn_readfirstlane(tid >> 6);
    const int G = gridDim.x; const int bx = blockIdx.x; const int vcu = (G % 8 == 0) ? (bx % 8) * (G / 8) + bx / 8 : bx;
    unsigned char* ws = args.ws;
    gu32* ctl = (gu32*)(ws + WS_CTL);
    const float* x = args.in[0]; const float* cvec = args.in[1]; const float* w_ada = args.in[2]; const float* b_ada = args.in[3];
    const float* g_mix_pre = args.in[4]; const float* g_mix_post = args.in[5]; const float* w_in = args.in[6]; const float* conv_w = args.in[7]; const float* conv_b = args.in[8];
    const float* w_rg_a = args.in[9]; const float* b_rg_a = args.in[10]; const float* w_rg_x = args.in[11]; const float* b_rg_x = args.in[12]; const float* lam = args.in[13];
    const float* pool_w = args.in[14]; const float* pool_scale = args.in[15]; const float* w_bl = args.in[16]; const float* w_bp = args.in[17]; const float* w_o = args.in[18];
    const float* g_ffn_pre = args.in[19]; const float* g_ffn_post = args.in[20]; const float* w_gu = args.in[21]; const float* w_dn = args.in[22];
    float* out = args.out;
    float* mod = (float*)(ws + WS_MOD); float* sp8 = (float*)(ws + WS_SP8);
    bf16* Wrg_t = (bf16*)(ws + WS_WRG); bf16* Wpool_t = (bf16*)(ws + WS_WPOOL); bf16* Wbl_t = (bf16*)(ws + WS_WBL); bf16* Wbp_t = (bf16*)(ws + WS_WBP); bf16* Wo_t = (bf16*)(ws + WS_WO);
    bf16* Win_t = (bf16*)(ws + WS_WIN); bf16* Wgu_t = (bf16*)(ws + WS_WGU); bf16* Wdn_t = (bf16*)(ws + WS_WDN);
    bf16* U = (bf16*)(ws + WS_U); bf16* PROJ = (bf16*)(ws + WS_PROJ); bf16* XC = (bf16*)(ws + WS_XC); bf16* POOLED = (bf16*)(ws + WS_POOLED);
    unsigned* AU = (unsigned*)(ws + WS_AU); float* SCP = (float*)(ws + WS_SCANC); float* SCH = SCP + BATCH * SCAN_NC * D;
    bf16* YL = (bf16*)(ws + WS_YL); bf16* YP = (bf16*)(ws + WS_YP); bf16* MERGED = (bf16*)(ws + WS_MERGED); bf16* Y = (bf16*)(ws + WS_Y); bf16* Y2 = (bf16*)(ws + WS_Y2); bf16* H = (bf16*)(ws + WS_H); bf16* X1B = (bf16*)(ws + WS_X1B);

    for (int u = tid; u < (LDS_BYTES - LDSCTL_OFF) / 4; u += NWAVES * 64) ((LAS unsigned*)(lds + LDSCTL_OFF))[u] = 0u;
    __syncthreads();
    XcdBarrier bar; bar.bar = (unsigned*)(ctl + CW_BAR) + args.li * XCD_BAR_WORDS; bar.x = 0; bar.st = nullptr;
    if (N_LAUNCHES != NPH) bar = xcd_barrier_post((unsigned*)(ctl + CW_BAR) + args.li * XCD_BAR_WORDS, MISC + 8);
#define GRID_BAR() do { if (N_LAUNCHES != NPH) xcd_barrier(bar); } while (0)
    const int lo = args.ph_lo, hi = args.ph_hi;
#ifndef PH_MASK
#define PH_MASK 0x1fff
#endif
#define IN(k) (((PH_MASK >> (k)) & 1) && lo <= (k) && (k) < hi)
#ifndef DUP_MASK
#define DUP_MASK 0


#endif
#define DUP(k) ((DUP_MASK >> (k)) & 1)
#define REP(k) _Pragma("unroll 1") for (int rep_ = 0; rep_ < DUP(k) + 1; ++rep_)
#define BOTH(k) (IN(k) && IN((k) + 1))
    const int gw = vcu * NWAVES + wave, NGW = G * NWAVES;

    if (IN(0)) REP(0) {
        {
            LAS float* cact = (LAS float*)lds; LAS float* red = (LAS float*)(lds + 32768);
            for (int i = tid; i < BATCH * D; i += NWAVES * 64) { const float v = cvec[i]; cact[i] = pg8::siluf_(v); }
            __syncthreads();
            const int cg = tid % 24, kg = tid / 24;
            for (int g = vcu; g < NMOD / 96; g += G) {
                if (kg < 21) {
                    f32x4 a0 = {0.f, 0.f, 0.f, 0.f}, a1 = {0.f, 0.f, 0.f, 0.f};
                    const float* wp = w_ada + (size_t)g * 96 + cg * 4;
#pragma unroll 8
                    for (int k = kg; k < D; k += 21) { const f32x4 w = *(const f32x4*)(wp + (size_t)k * NMOD); const float c0 = cact[k], c1 = cact[D + k]; a0 += w * c0; a1 += w * c1; }
                    LAS float* rp = red + (kg * 24 + cg) * 8;
                    rp[0] = a0.x; rp[1] = a0.y; rp[2] = a0.z; rp[3] = a0.w; rp[4] = a1.x; rp[5] = a1.y; rp[6] = a1.z; rp[7] = a1.w;
                }
                __syncthreads();
                if (tid < 192) { const int cgo = tid >> 3, r = tid & 7, b = r >> 2, j = r & 3; float s = 0.f;
#pragma unroll
                    for (int q = 0; q < 21; ++q) s += red[(q * 24 + cgo) * 8 + r];
                    const int n = g * 96 + cgo * 4 + j; mod[b * NMOD + n] = s + b_ada[n]; }
                __syncthreads();
            }
        }
        for (int i = bx * NWAVES * 64 + tid; i < D; i += G * NWAVES * 64) { const float l = lam[i]; sp8[i] = -8.0f * log1pf(expf(-l)); }
        {
            LAS float* scr = (LAS float*)(lds + wave * 16384);
            int itbase = 0;
            transpose_matrix<0>(w_in, D, NIN, Win_t, D, 0, scr, lane, gw, NGW, itbase);
            for (int h = 0; h < HEADS; ++h) {
                const int nblk = HD / 32, nitems = (HD / 64) * nblk * 2;
                int it = gw - (itbase % NGW); if (it < 0) it += NGW;
                for (; it < nitems; it += NGW) { const int which = it / ((HD / 64) * nblk), r = it % ((HD / 64) * nblk), kb = r / nblk, nb = r % nblk, n0 = 32 * nb;
                    const float* W = (which ? w_rg_x : w_rg_a) + (size_t)h * HD * HD;
                    transpose_item(W, HD, Wrg_t, HD, 64 * kb, n0, h * 512 + (n0 >> 7) * 256 + which * 128 + (n0 & 127), scr, lane); }
                itbase += nitems;
            }
            for (int gi = 0; gi < PGRP; ++gi) transpose_matrix<0>(pool_w + (size_t)gi * PGD * PGD, PGD, PGD, Wpool_t, PGD, gi * PGD, scr, lane, gw, NGW, itbase);
            transpose_matrix<0>(w_bl, D, D, Wbl_t, D, 0, scr, lane, gw, NGW, itbase);
            transpose_matrix<0>(w_bp, D, D, Wbp_t, D, 0, scr, lane, gw, NGW, itbase);
            transpose_matrix<0>(w_o, D, D, Wo_t, D, 0, scr, lane, gw, NGW, itbase);
        }
        if (BOTH(0)) GRID_BAR();
    }

    if (IN(1)) REP(1) {
        LAS float* cA = (LAS float*)lds; LAS float* cB = cA + D;
        int cur_b = -1;
        for (int slot = vcu; slot < M / 8; slot += G) {
            const int b = slot / (SEQ / 8);
            if (b != cur_b) { __syncthreads();
                for (int i = tid; i < D; i += NWAVES * 64) { cA[i] = g_mix_pre[i] * (1.0f + mod[b * NMOD + 1 * D + i]); cB[i] = mod[b * NMOD + 0 * D + i]; }
                __syncthreads(); cur_b = b; }
            { const size_t row = (size_t)slot * 8 + wave;
                const f32x4* xr = (const f32x4*)(x + row * D) + lane;
                f32x4 v[16]; float s = 0.f;
#pragma unroll
                for (int j = 0; j < 16; ++j) { v[j] = xr[64 * j]; s += dot4(v[j]); }
                const float rstd = 1.0f / sqrtf(wave_sum(s) * (1.0f / D) + RMS_EPS);
                v2u* o8 = (v2u*)(U + row * D) + lane;
#pragma unroll
                for (int j = 0; j < 16; ++j) { const f32x4 a = ((const LAS f32x4*)cA)[lane + 64 * j], bb = ((const LAS f32x4*)cB)[lane + 64 * j]; const f32x4 o = v[j] * rstd * a + bb;
                    v2u w; w.x = cvt_pk_bf16(o.x, o.y); w.y = cvt_pk_bf16(o.z, o.w); o8[64 * j] = w; }
            }
        }
        if (BOTH(1)) GRID_BAR();
    }

    if (IN(2)) {
#define P2_BODY do { pg8::Gemm g{U, Win_t, M, NIN, D, D, D, 30}; pg8::StaticOrder S; S.init(M, NIN, G, bx); \
        pg8::EpiPlain E{PROJ, NIN}; \
        pg8::gemm_phase<pg8::EpiPlain, pg8::StaticOrder, true, true>(lds + RING_OFF, g, S, E); } while (0)
        P2_BODY; if (DUP(2)) { P2_BODY; }
        if (BOTH(2)) GRID_BAR();
    }

    if (IN(3)) REP(3) {
        for (int id = gw; id < (M / 64) * 16; id += NGW) { const int chunk = id >> 4, cgp = id & 15, ch0 = cgp * 256 + lane * 4;
            switch (cgp >> 2) {
                case 0: conv_pool_chunk<2>(PROJ, XC, POOLED, conv_w, conv_b, chunk, ch0); break;
                case 1: conv_pool_chunk<4>(PROJ, XC, POOLED, conv_w, conv_b, chunk, ch0); break;
                case 2: conv_pool_chunk<8>(PROJ, XC, POOLED, conv_w, conv_b, chunk, ch0); break;
                default: conv_pool_chunk<16>(PROJ, XC, POOLED, conv_w, conv_b, chunk, ch0); break;
            }
        }
        if (BOTH(3)) GRID_BAR();
    }

    if (IN(4)) {
#define P4_BODY do { \
        { pg8::Gemm g{XC, Wrg_t, M, HEADS * 512, HD, D, HD, 1}; pg8::StaticOrder S; S.init(M, HEADS * 512, G, bx); \
          pg8::EpiRg E{XC, AU, b_rg_a, b_rg_x, sp8, D}; \
          pg8::gemm_phase<pg8::EpiRg, pg8::StaticOrder, true, true>(lds + RING_OFF, g, S, E); } \
        { pg8::Gemm g{POOLED, Wpool_t, M, D, PGD, D, PGD, 2}; pg8::StaticOrder S; S.init(M, D, G, bx); \
          pg8::EpiScale E{YP, D, pool_scale}; \
          pg8::gemm_phase<pg8::EpiScale, pg8::StaticOrder, true, true>(lds + RING_OFF, g, S, E); } } while (0)
        P4_BODY; if (DUP(4)) { P4_BODY; }
        if (BOTH(4)) GRID_BAR();
    }

    if (IN(5)) REP(5) {
        for (int id = gw; id < BATCH * SCAN_NC * 16; id += NGW) { const int cgp = id & 15, chunk = (id >> 4) % SCAN_NC, b = id / (16 * SCAN_NC);
            const int ch = cgp * 256 + lane * 4; const size_t row0 = (size_t)b * SEQ + (size_t)chunk * SCAN_T;
            const v4u* p = (const v4u*)(AU + row0 * D + ch);
            float S[4] = {0.f, 0.f, 0.f, 0.f}, h[4] = {0.f, 0.f, 0.f, 0.f};
#pragma unroll 8
            for (int r = 0; r < SCAN_T; ++r) { const v4u w = p[(size_t)r * (D / 4)]; const unsigned ww[4] = {w.x, w.y, w.z, w.w};
#pragma unroll
                for (int j = 0; j < 4; ++j) { const float l = bf_lo(ww[j]), u = bf_hi(ww[j]); h[j] = pg8::fast_exp(l) * h[j] + u; S[j] += l; } }
            const size_t o = ((size_t)(b * SCAN_NC + chunk)) * D + ch;
            *(f32x4*)(SCP + o) = (f32x4){pg8::fast_exp(S[0]), pg8::fast_exp(S[1]), pg8::fast_exp(S[2]), pg8::fast_exp(S[3])}; *(f32x4*)(SCH + o) = (f32x4){h[0], h[1], h[2], h[3]};
        }
        if (BOTH(5)) GRID_BAR();
    }

    if (IN(6)) REP(6) {
        for (int id = gw; id < BATCH * SCAN_NC * 16; id += NGW) { const int cgp = id & 15, chunk = (id >> 4) % SCAN_NC, b = id / (16 * SCAN_NC);
            const int ch = cgp * 256 + lane * 4; const size_t row0 = (size_t)b * SEQ + (size_t)chunk * SCAN_T;
            f32x4 hc = {0.f, 0.f, 0.f, 0.f};
#pragma unroll 8
            for (int c = 0; c < chunk; ++c) { const size_t o = ((size_t)(b * SCAN_NC + c)) * D + ch; const f32x4 P = *(const f32x4*)(SCP + o), Hh = *(const f32x4*)(SCH + o); hc = P * hc + Hh; }
            float h[4] = {hc.x, hc.y, hc.z, hc.w};
            const v4u* p = (const v4u*)(AU + row0 * D + ch); const v2u* gp = (const v2u*)(PROJ + row0 * NIN + D + ch); v2u* yo = (v2u*)(YL + row0 * D + ch);
#pragma unroll 1
            for (int r0 = 0; r0 < SCAN_T; r0 += 8) {
                v4u wb[8]; v2u gb[8];
#pragma unroll
                for (int q = 0; q < 8; ++q) { wb[q] = p[(size_t)(r0 + q) * (D / 4)]; gb[q] = gp[(size_t)(r0 + q) * (NIN / 4)]; }
#pragma unroll
                for (int q = 0; q < 8; ++q) { const v4u w = wb[q]; const v2u gq = gb[q]; const unsigned ww[4] = {w.x, w.y, w.z, w.w};
                    const float gg[4] = {bf_lo(gq.x), bf_hi(gq.x), bf_lo(gq.y), bf_hi(gq.y)}; float y[4];
#pragma unroll
                    for (int j = 0; j < 4; ++j) { const float l = bf_lo(ww[j]), u = bf_hi(ww[j]); h[j] = pg8::fast_exp(l) * h[j] + u; y[j] = h[j] * pg8::gelu_tanh_(gg[j]); }
                    v2u o; o.x = cvt_pk_bf16(y[0], y[1]); o.y = cvt_pk_bf16(y[2], y[3]); yo[(size_t)(r0 + q) * (D / 4)] = o; }
                asm volatile("" ::: "memory");
            }
        }
        if (BOTH(6)) GRID_BAR();
    }

    if (IN(7)) {
#define P7_BODY do { \
        { pg8::Gemm g{YL, Wbl_t, M, D, D, D, D, 30}; pg8::StaticOrder S; S.init(M, D, G, bx); \
          pg8::EpiGate<false> E{MERGED, D, PROJ + 3 * D, NIN}; \
          pg8::gemm_phase<pg8::EpiGate<false>, pg8::StaticOrder, true, true>(lds + RING_OFF, g, S, E); } \
        { pg8::Gemm g{YP, Wbp_t, M, D, D, D, D, 30}; pg8::StaticOrder S; S.init(M, D, G, bx); \
          pg8::EpiGate<true> E{MERGED, D, PROJ + 4 * D, NIN}; \
          pg8::gemm_phase<pg8::EpiGate<true>, pg8::StaticOrder, true, true>(lds + RING_OFF, g, S, E); } } while (0)
        P7_BODY; if (DUP(7)) { P7_BODY; }
        if (BOTH(7)) GRID_BAR();
    }

    if (IN(8)) {
#define P8_BODY do { pg8::Gemm g{MERGED, Wo_t, M, D, D, D, D, 30}; pg8::StaticOrder S; S.init(M, D, G, bx); \
        pg8::EpiPlain E{Y, D}; \
        pg8::gemm_phase<pg8::EpiPlain, pg8::StaticOrder, true, true>(lds + RING_OFF, g, S, E); } while (0)
        P8_BODY; if (DUP(8)) { P8_BODY; }
        if (BOTH(8)) GRID_BAR();
    }

    if (IN(9)) REP(9) {
        {
            LAS float* cG = (LAS float*)lds; LAS float* cA = cG + D; LAS float* cB = cA + D;
            int cur_b = -1;
            for (int slot = vcu; slot < M / 8; slot += G) {
                const int b = slot / (SEQ / 8);
                if (b != cur_b) { __syncthreads();
                    for (int i = tid; i < D; i += NWAVES * 64) { cG[i] = mod[b * NMOD + 2 * D + i] * g_mix_post[i]; cA[i] = g_ffn_pre[i] * (1.0f + mod[b * NMOD + 4 * D + i]); cB[i] = mod[b * NMOD + 3 * D + i]; }
                    __syncthreads(); cur_b = b; }
                { const size_t row = (size_t)slot * 8 + wave;
                    const f32x4* xr = (const f32x4*)(x + row * D) + lane; const v2u* yr = (const v2u*)(Y + row * D) + lane;
                    f32x4 v[16]; v2u yv[16]; float sy = 0.f;
#pragma unroll
                    for (int j = 0; j < 16; ++j) { v[j] = xr[64 * j]; yv[j] = yr[64 * j]; }
#pragma unroll
                    for (int j = 0; j < 16; ++j) { const f32x4 y = {bf_lo(yv[j].x), bf_hi(yv[j].x), bf_lo(yv[j].y), bf_hi(yv[j].y)}; sy += dot4(y); }
                    const float rstdy = 1.0f / sqrtf(wave_sum(sy) * (1.0f / D) + RMS_EPS);
                    float s1 = 0.f; v2u* orow = (v2u*)(X1B + row * D) + lane;
#pragma unroll
                    for (int j = 0; j < 16; ++j) { const f32x4 y = {bf_lo(yv[j].x), bf_hi(yv[j].x), bf_lo(yv[j].y), bf_hi(yv[j].y)}; const f32x4 gq = ((const LAS f32x4*)cG)[lane + 64 * j];
                        v[j] = v[j] + gq * (y * rstdy); s1 += dot4(v[j]); v2u w; w.x = cvt_pk_bf16(v[j].x, v[j].y); w.y = cvt_pk_bf16(v[j].z, v[j].w); orow[64 * j] = w; }
                    const float rstd1 = 1.0f / sqrtf(wave_sum(s1) * (1.0f / D) + RMS_EPS);
                    v2u* o8 = (v2u*)(U + row * D) + lane;
#pragma unroll
                    for (int j = 0; j < 16; ++j) { const f32x4 a = ((const LAS f32x4*)cA)[lane + 64 * j], bb = ((const LAS f32x4*)cB)[lane + 64 * j]; const f32x4 o = v[j] * rstd1 * a + bb;
                        v2u w; w.x = cvt_pk_bf16(o.x, o.y); w.y = cvt_pk_bf16(o.z, o.w); o8[64 * j] = w; }
                }
            }
        }
        __syncthreads();
        {
            LAS float* scr = (LAS float*)(lds + wave * 16384);
            int itbase = 0;
            transpose_matrix<1>(w_gu, D, NGU, Wgu_t, D, 0, scr, lane, gw, NGW, itbase);
            if (((M / 256) * (NGU / 256)) % G == 0) transpose_matrix<0>(w_dn, DFF, D, Wdn_t, DFF, 0, scr, lane, gw, NGW, itbase);
        }
        if (BOTH(9)) GRID_BAR();
    }

    if (IN(10)) {
#define P10_BODY do { pg8::Gemm g{U, Wgu_t, M, NGU, D, D, D, 30}; pg8::StaticOrder S; S.init(M, NGU, G, bx); \
        pg8::EpiSwiglu E{H, DFF}; \
        pg8::gemm_phase<pg8::EpiSwiglu, pg8::StaticOrder, true, true>(lds + RING_OFF, g, S, E); } while (0)
        P10_BODY; if (DUP(10)) { P10_BODY; }
        { const int rem10 = ((M / 256) * (NGU / 256)) % G;
          if (rem10 != 0 && bx >= rem10) { LAS float* scr = (LAS float*)(lds + wave * 16384); int itbase = 0;
              transpose_matrix<0>(w_dn, DFF, D, Wdn_t, DFF, 0, scr, lane, (bx - rem10) * NWAVES + wave, (G - rem10) * NWAVES, itbase); } }
        if (BOTH(10)) GRID_BAR();
    }

    if (IN(11)) {
#define P11_BODY do { pg8::Gemm g{H, Wdn_t, M, D, DFF, DFF, DFF, 30}; pg8::StaticOrder S; S.init(M, D, G, bx); \
        pg8::EpiPlain E{Y2, D}; \
        pg8::gemm_phase<pg8::EpiPlain, pg8::StaticOrder, true, true>(lds + RING_OFF, g, S, E); } while (0)
        P11_BODY; if (DUP(11)) { P11_BODY; }
        if (BOTH(11)) GRID_BAR();
    }

    if (IN(12)) {
        LAS float* cG = (LAS float*)lds;
        int cur_b = -1;
        for (int slot = vcu; slot < M / 8; slot += G) {
            const int b = slot / (SEQ / 8);
            if (b != cur_b) { __syncthreads();
                for (int i = tid; i < D; i += NWAVES * 64) cG[i] = mod[b * NMOD + 5 * D + i] * g_ffn_post[i];
                __syncthreads(); cur_b = b; }
            { const size_t row = (size_t)slot * 8 + wave;
                f32x4* xr = (f32x4*)(out + row * D) + lane; const v2u* yr = (const v2u*)(Y2 + row * D) + lane; const v2u* x1r = (const v2u*)(X1B + row * D) + lane;
                f32x4 v[16]; v2u yv[16]; float sy = 0.f;
#pragma unroll
                for (int j = 0; j < 16; ++j) { const v2u q = x1r[64 * j]; v[j] = (f32x4){bf_lo(q.x), bf_hi(q.x), bf_lo(q.y), bf_hi(q.y)}; yv[j] = yr[64 * j]; }
#pragma unroll
                for (int j = 0; j < 16; ++j) { const f32x4 y = {bf_lo(yv[j].x), bf_hi(yv[j].x), bf_lo(yv[j].y), bf_hi(yv[j].y)}; sy += dot4(y); }
                const float rstdy = 1.0f / sqrtf(wave_sum(sy) * (1.0f / D) + RMS_EPS);
#pragma unroll
                for (int j = 0; j < 16; ++j) { const f32x4 y = {bf_lo(yv[j].x), bf_hi(yv[j].x), bf_lo(yv[j].y), bf_hi(yv[j].y)}; const f32x4 gq = ((const LAS f32x4*)cG)[lane + 64 * j];
                    xr[64 * j] = v[j] + gq * (y * rstdy); }
            }
        }
    }
#undef IN
#undef BOTH
#undef GRID_BAR
}

extern "C" void kernel_launch(void* const* d_in, const int* in_sizes, int n_in, void* d_out, int out_size, void* d_ws, size_t ws_size, hipStream_t stream) {
    static int grid = 0;
    if (grid == 0) {
        if (n_in != 23 || in_sizes[0] != M * D || out_size != M * D || ws_size < WS_END) {
            fprintf(stderr, "kernel_launch: built for 23 inputs, x/out of %d floats, >= %zu bytes of workspace; got n_in %d, in0 %d, out %d, ws %zu; nothing launched\n", M * D, (size_t)WS_END, n_in, n_in > 0 ? in_sizes[0] : -1, out_size, ws_size);
            grid = -1; return; }
        int dev = 0, cus = 0, per_cu = 0;
        if (hipGetDevice(&dev) != hipSuccess || hipDeviceGetAttribute(&cus, hipDeviceAttributeMultiprocessorCount, dev) != hipSuccess) { fprintf(stderr, "kernel_launch: device query failed\n"); grid = -1; return; }
        if (hipFuncSetAttribute((const void*)fwd_kernel, hipFuncAttributeMaxDynamicSharedMemorySize, LDS_BYTES) != hipSuccess) { fprintf(stderr, "kernel_launch: hipFuncSetAttribute failed\n"); grid = -1; return; }
        if (hipOccupancyMaxActiveBlocksPerMultiprocessor(&per_cu, (const void*)fwd_kernel, NWAVES * 64, LDS_BYTES) != hipSuccess || per_cu < 1)
            fprintf(stderr, "kernel_launch: note: occupancy query reports %d workgroups per CU\n", per_cu);
        (void)hipGetLastError();
        grid = cus;
    }
    if (grid < 0) return;
    if (hipMemsetAsync((char*)d_ws + WS_CTL, 0, CTL_ZERO_BYTES, stream) != hipSuccess) { fprintf(stderr, "kernel_launch: memset failed\n"); return; }
    Args a{};
    for (int i = 0; i < 23; ++i) a.in[i] = (const float*)d_in[i];
    a.out = (float*)d_out; a.ws = (unsigned char*)d_ws; a.pad = 0;
    for (int li = 0; li < N_LAUNCHES; ++li) {
        a.ph_lo = (N_LAUNCHES == NPH) ? li : (li * NPH) / N_LAUNCHES; a.ph_hi = (N_LAUNCHES == NPH) ? li + 1 : ((li + 1) * NPH) / N_LAUNCHES; a.li = li;
        hipLaunchKernelGGL(fwd_kernel, dim3(grid), dim3(NWAVES * 64), LDS_BYTES, stream, a);
        const hipError_t le = hipPeekAtLastError();
        if (le != hipSuccess) { fprintf(stderr, "kernel_launch: launch %d failed: %s\n", li, hipGetErrorName(le)); break; }
    }
}
```

```cpp
#include <hip/hip_runtime.h>
#include <cstdio>
#include <cstdint>

#ifndef MK_N_LAUNCHES
#define MK_N_LAUNCHES 1
#endif

namespace pg8 {
#define PG8_LAS __attribute__((address_space(3)))
typedef unsigned short bf16_t;
typedef short bf16x8 __attribute__((ext_vector_type(8)));
typedef float f32x4 __attribute__((ext_vector_type(4)));
typedef unsigned u32x4 __attribute__((ext_vector_type(4)));
typedef unsigned u32x2 __attribute__((ext_vector_type(2)));
constexpr int BM = 256, BK = 64, HALF = 128, HTB = HALF * BK * 2  , STAGE_BYTES = 8 * HTB, NXCD = 8, WGM = 8;

__host__ __device__ __forceinline__ int lds_byte(int r, int c) { const int st = (r >> 4) * 2 + (c >> 5), rr = r & 15, cc = c & 31, ob = rr * 64 + cc * 2; return st * 1024 + (ob ^ (((ob >> 9) & 1) << 5)); }
__host__ __device__ __forceinline__ void stage_rc(int b, int& R, int& C) { const int st = b / 1024, sb = b % 1024, swz = sb ^ (((sb >> 9) & 1) << 5); R = (st >> 1) * 16 + swz / 64; C = (st & 1) * 32 + (swz % 64) / 2; }
__host__ __device__ __forceinline__ int perm32(int rho) { const int n = rho >> 4, i = rho & 15; return 8 * (i >> 2) + 4 * n + (i & 3); }

struct Unit { int pm, pn; };
struct Gemm { const bf16_t* A; const bf16_t* Bt; int M, N, K, lda, ldb, agshift; };

struct StaticOrder {
    int nM, nN, nwg, G, c;
    __host__ __device__ void init(int M, int N, int G_, int c_) { nM = M / BM; nN = N / BM; nwg = nM * nN; G = G_; c = c_; }
    __host__ __device__ bool next(int i, Unit& u) const {
        const long L = (long)i * G + c; if (L >= nwg) return false;
        int wgid = (int)L; { const int q = nwg / NXCD, r = nwg % NXCD, xcd = wgid % NXCD, off = wgid / NXCD; wgid = (xcd < r ? xcd * (q + 1) : r * (q + 1) + (xcd - r) * q) + off; }
        const int nig = WGM * nN, gid = wgid / nig, fm = gid * WGM, gsz = (nM - fm) < WGM ? (nM - fm) : WGM;
        u.pm = fm + ((wgid % nig) % gsz); u.pn = (wgid % nig) / gsz; return true;
    }
    __device__ __forceinline__ void a_ready(const Unit&) const {}
    __device__ __forceinline__ void done(const Unit&) const {}
};

__device__ __forceinline__ unsigned cvt_pk_bf16(float lo, float hi) { unsigned r; asm volatile("v_cvt_pk_bf16_f32 %0, %1, %2" : "=v"(r) : "v"(lo), "v"(hi)); return r; }
__device__ __forceinline__ float bf_lo(unsigned w) { return __uint_as_float(w << 16); }
__device__ __forceinline__ float bf_hi(unsigned w) { return __uint_as_float(w & 0xffff0000u); }
__device__ __forceinline__ float fast_rcp(float x) { return __builtin_amdgcn_rcpf(x); }
__device__ __forceinline__ float fast_exp(float x) { return __builtin_amdgcn_exp2f(x * 1.44269504088896f); }
__device__ __forceinline__ float sigmoidf_(float x) { return fast_rcp(1.0f + fast_exp(-x)); }
__device__ __forceinline__ float siluf_(float x) { return x * sigmoidf_(x); }
__device__ __forceinline__ float gelu_tanh_(float x) { const float z = 1.5957691216057308f * (x + 0.044715f * x * x * x); return x * sigmoidf_(z); }

struct EpiPlain {
    static constexpr bool PERM = true;
    bf16_t* O; int ldc;
    __device__ __forceinline__ void operator()(const f32x4 (&acc)[2][2][4][2], const Unit& u, int wr, int wc, int fr, int fq) const {
        const int row0 = u.pm * BM + wr * 64 + fr, col0 = u.pn * BM + wc * 32 + 8 * fq;
#pragma unroll
        for (int ai = 0; ai < 2; ++ai)
#pragma unroll
            for (int m = 0; m < 4; ++m) { bf16_t* rowp = O + (size_t)(row0 + ai * HALF + m * 16) * ldc + col0;
#pragma unroll
                for (int bj = 0; bj < 2; ++bj) { const f32x4 v0 = acc[ai][bj][m][0], v1 = acc[ai][bj][m][1];
                    u32x4 w; w.x = cvt_pk_bf16(v0[0], v0[1]); w.y = cvt_pk_bf16(v0[2], v0[3]); w.z = cvt_pk_bf16(v1[0], v1[1]); w.w = cvt_pk_bf16(v1[2], v1[3]);
                    *(u32x4*)(rowp + bj * HALF) = w; } }
    }
};
struct EpiScale {
    static constexpr bool PERM = true;
    bf16_t* O; int ldc; const float* scale;
    __device__ __forceinline__ void operator()(const f32x4 (&acc)[2][2][4][2], const Unit& u, int wr, int wc, int fr, int fq) const {
        const int row0 = u.pm * BM + wr * 64 + fr, col0 = u.pn * BM + wc * 32 + 8 * fq;
        f32x4 sv[2][2];
#pragma unroll
        for (int bj = 0; bj < 2; ++bj)
#pragma unroll
            for (int n = 0; n < 2; ++n) sv[bj][n] = *(const f32x4*)(scale + col0 + bj * HALF + 4 * n);
#pragma unroll
        for (int ai = 0; ai < 2; ++ai)
#pragma unroll
            for (int m = 0; m < 4; ++m) { bf16_t* rowp = O + (size_t)(row0 + ai * HALF + m * 16) * ldc + col0;
#pragma unroll
                for (int bj = 0; bj < 2; ++bj) { const f32x4 v0 = acc[ai][bj][m][0] * sv[bj][0], v1 = acc[ai][bj][m][1] * sv[bj][1];
                    u32x4 w; w.x = cvt_pk_bf16(v0[0], v0[1]); w.y = cvt_pk_bf16(v0[2], v0[3]); w.z = cvt_pk_bf16(v1[0], v1[1]); w.w = cvt_pk_bf16(v1[2], v1[3]);
                    *(u32x4*)(rowp + bj * HALF) = w; } }
    }
};
template <bool ADD> struct EpiGate {
    static constexpr bool PERM = true;
    bf16_t* O; int ldc; const bf16_t* Gt; int ldg;
    __device__ __forceinline__ void operator()(const f32x4 (&acc)[2][2][4][2], const Unit& u, int wr, int wc, int fr, int fq) const {
        const int row0 = u.pm * BM + wr * 64 + fr, col0 = u.pn * BM + wc * 32 + 8 * fq;
#pragma unroll
        for (int ai = 0; ai < 2; ++ai) {
            u32x4 g[4][2], p[4][2];
#pragma unroll
            for (int m = 0; m < 4; ++m) { const size_t row = (size_t)(row0 + ai * HALF + m * 16);
#pragma unroll
                for (int bj = 0; bj < 2; ++bj) { g[m][bj] = *(const u32x4*)(Gt + row * ldg + col0 + bj * HALF); if (ADD) p[m][bj] = *(const u32x4*)(O + row * ldc + col0 + bj * HALF); } }
            asm volatile("" ::: "memory");
#pragma unroll
            for (int m = 0; m < 4; ++m) { const size_t row = (size_t)(row0 + ai * HALF + m * 16); bf16_t* rowp = O + row * ldc + col0;
#pragma unroll
                for (int bj = 0; bj < 2; ++bj) { const u32x4 gg = g[m][bj]; const f32x4 v0 = acc[ai][bj][m][0], v1 = acc[ai][bj][m][1];
                    float o[8];
                    o[0] = sigmoidf_(bf_lo(gg.x)) * v0[0]; o[1] = sigmoidf_(bf_hi(gg.x)) * v0[1]; o[2] = sigmoidf_(bf_lo(gg.y)) * v0[2]; o[3] = sigmoidf_(bf_hi(gg.y)) * v0[3];
                    o[4] = sigmoidf_(bf_lo(gg.z)) * v1[0]; o[5] = sigmoidf_(bf_hi(gg.z)) * v1[1]; o[6] = sigmoidf_(bf_lo(gg.w)) * v1[2]; o[7] = sigmoidf_(bf_hi(gg.w)) * v1[3];
                    if (ADD) { const u32x4 pp = p[m][bj];
                        o[0] += bf_lo(pp.x); o[1] += bf_hi(pp.x); o[2] += bf_lo(pp.y); o[3] += bf_hi(pp.y); o[4] += bf_lo(pp.z); o[5] += bf_hi(pp.z); o[6] += bf_lo(pp.w); o[7] += bf_hi(pp.w); }
                    u32x4 w; w.x = cvt_pk_bf16(o[0], o[1]); w.y = cvt_pk_bf16(o[2], o[3]); w.z = cvt_pk_bf16(o[4], o[5]); w.w = cvt_pk_bf16(o[6], o[7]);
                    *(u32x4*)(rowp + bj * HALF) = w; } }
            asm volatile("" ::: "memory");
        }
    }
};
struct EpiSwiglu {
    static constexpr bool PERM = true;
    bf16_t* O; int ldc;
    __device__ __forceinline__ void operator()(const f32x4 (&acc)[2][2][4][2], const Unit& u, int wr, int wc, int fr, int fq) const {
        const int row0 = u.pm * BM + wr * 64 + fr, col0 = u.pn * HALF + wc * 32 + 8 * fq;
#pragma unroll
        for (int ai = 0; ai < 2; ++ai)
#pragma unroll
            for (int m = 0; m < 4; ++m) { bf16_t* rowp = O + (size_t)(row0 + ai * HALF + m * 16) * ldc + col0;
                const f32x4 g0 = acc[ai][0][m][0], g1 = acc[ai][0][m][1], u0 = acc[ai][1][m][0], u1 = acc[ai][1][m][1];
                u32x4 w; w.x = cvt_pk_bf16(siluf_(g0[0]) * u0[0], siluf_(g0[1]) * u0[1]); w.y = cvt_pk_bf16(siluf_(g0[2]) * u0[2], siluf_(g0[3]) * u0[3]);
                w.z = cvt_pk_bf16(siluf_(g1[0]) * u1[0], siluf_(g1[1]) * u1[1]); w.w = cvt_pk_bf16(siluf_(g1[2]) * u1[2], siluf_(g1[3]) * u1[3]);
                *(u32x4*)rowp = w; }
    }
};
struct EpiRg {
    static constexpr bool PERM = false;
    const bf16_t* XC; unsigned* AU; const float* b_a; const float* b_x; const float* sp8; int ldx;
    __device__ __forceinline__ void operator()(const f32x4 (&acc)[2][2][4][2], const Unit& u, int wr, int wc, int fr, int fq) const {
        const int row0 = u.pm * BM + wr * 64 + fr, chb = u.pn * HALF + wc * 32 + 4 * fq;
        u32x2 xw[2][4][2];
#pragma unroll
        for (int ai = 0; ai < 2; ++ai)
#pragma unroll
            for (int m = 0; m < 4; ++m)
#pragma unroll
                for (int n = 0; n < 2; ++n) xw[ai][m][n] = *(const u32x2*)(XC + (size_t)(row0 + ai * HALF + m * 16) * ldx + chb + 16 * n);
        asm volatile("" ::: "memory");
#pragma unroll
        for (int n = 0; n < 2; ++n) { const int ch = chb + 16 * n;
            const f32x4 ba = *(const f32x4*)(b_a + ch), bx = *(const f32x4*)(b_x + ch), sp = *(const f32x4*)(sp8 + ch);
#pragma unroll
            for (int ai = 0; ai < 2; ++ai)
#pragma unroll
                for (int m = 0; m < 4; ++m) { const size_t row = (size_t)(row0 + ai * HALF + m * 16);
                    const u32x2 xq = xw[ai][m][n];
                    const float xv[4] = {bf_lo(xq.x), bf_hi(xq.x), bf_lo(xq.y), bf_hi(xq.y)};
                    const f32x4 rp = acc[ai][0][m][n] + ba, ip = acc[ai][1][m][n] + bx;
                    unsigned w[4]; float la[4], em1[4], ig[4];
#pragma unroll
                    for (int j = 0; j < 4; ++j) { const float r = sigmoidf_(rp[j]); ig[j] = sigmoidf_(ip[j]); la[j] = sp[j] * r; const float x2 = la[j] + la[j];
                        em1[j] = x2 * (1.0f + x2 * (0.5f + x2 * (0.16666667f + x2 * (0.041666668f + x2 * (0.0083333338f + x2 * 0.0013888889f))))); }
                    if (__any(fminf(fminf(la[0], la[1]), fminf(la[2], la[3])) <= -0.125f)) {
#pragma unroll
                        for (int j = 0; j < 4; ++j) { const float x2 = la[j] + la[j]; em1[j] = (x2 > -0.25f) ? em1[j] : (fast_exp(x2) - 1.0f); } }
#pragma unroll
                    for (int j = 0; j < 4; ++j) { const float mult = __builtin_sqrtf(fmaxf(-em1[j], 0.0f)); w[j] = cvt_pk_bf16(la[j], mult * ig[j] * xv[j]); }
                    u32x4 o; o.x = w[0]; o.y = w[1]; o.z = w[2]; o.w = w[3];
                    *(u32x4*)(AU + row * ldx + ch) = o;
                    __builtin_amdgcn_sched_barrier(0); } }
    }
};

template <class Epi, class Sched, bool ALIGN_EPI = false, bool SP2 = false>
__device__ __forceinline__ void gemm_phase(PG8_LAS unsigned char* lds, const Gemm g, const Sched& S, const Epi& E) {
    const int tid = threadIdx.x, wid = __builtin_amdgcn_readfirstlane(tid >> 6), lane = tid & 63, wr = wid >> 2, wc = wid & 3, fr = lane & 15, fq = lane >> 4;
    const int K = g.K, nt = K / BK;
    unsigned voffA[2], voffB[2];
#pragma unroll
    for (int i = 0; i < 2; ++i) { int R, C; stage_rc(tid * 16 + i * 8192, R, C); const int Rb = Epi::PERM ? ((R & ~31) + perm32(R & 31)) : R;
        voffA[i] = (unsigned)(R * g.lda + C) * 2u; voffB[i] = (unsigned)(Rb * g.ldb + C) * 2u; }
    const size_t kstep = (size_t)(BK * 2);
    const size_t hstepA = (size_t)HALF * g.lda * 2, hstepB = (size_t)HALF * g.ldb * 2;
    const size_t tstepA = 2 * hstepA, tstepB = 2 * hstepB;
    const unsigned ldsw = (unsigned)wid * 1024u;
    const int aoff = lds_byte(wr * 64 + fr, fq * 8), boff = lds_byte(wc * 32 + fr, fq * 8);
#define PG8_SA(b, h) (((b) * 2 + (h)) * HTB)
#define PG8_SB(b, h) ((4 + (b) * 2 + (h)) * HTB)
#define PG8_STAGE(bufoff, gbase, voff) do { _Pragma("unroll") for (int _i = 0; _i < 2; ++_i) \
        __builtin_amdgcn_global_load_lds((const unsigned*)((const char*)(gbase) + (voff)[_i]), (PG8_LAS unsigned*)(lds + (bufoff) + ldsw + _i * 8192), 16, 0, 0); } while (0)
#define PG8_LDA(dst, b, h) do { _Pragma("unroll") for (int m = 0; m < 4; ++m) _Pragma("unroll") for (int k = 0; k < 2; ++k) dst[m][k] = *(const PG8_LAS bf16x8*)(lds + PG8_SA(b, h) + aoff + m * 2048 + k * 1024); } while (0)
#define PG8_LDB(dst, b, h) do { _Pragma("unroll") for (int n = 0; n < 2; ++n) _Pragma("unroll") for (int k = 0; k < 2; ++k) dst[n][k] = *(const PG8_LAS bf16x8*)(lds + PG8_SB(b, h) + boff + n * 2048 + k * 1024); } while (0)
#define PG8_MMA(ai, bj, At, Bt) do { __builtin_amdgcn_s_setprio(1); _Pragma("unroll") for (int m = 0; m < 4; ++m) _Pragma("unroll") for (int n = 0; n < 2; ++n) _Pragma("unroll") for (int k = 0; k < 2; ++k) \
        acc[ai][bj][m][n] = __builtin_amdgcn_mfma_f32_16x16x32_bf16(Bt[n][k], At[m][k], acc[ai][bj][m][n], 0, 0, 0); __builtin_amdgcn_s_setprio(0); } while (0)
#define PG8_WAIT_V(n) asm volatile("s_waitcnt vmcnt(" #n ")" ::: "memory")
#define PG8_WAIT_L(n) asm volatile("s_waitcnt lgkmcnt(" #n ")" ::: "memory")
#define PG8_BAR __builtin_amdgcn_s_barrier()
#define PG8_SCHED __builtin_amdgcn_sched_barrier(0)
#define PG8_ABASE(u) ((const char*)g.A + (size_t)(u).pm * tstepA + (size_t)((u).pn >> g.agshift) * (size_t)K * 2)
#define PG8_BBASE(u) ((const char*)g.Bt + (size_t)(u).pn * tstepB)
    Unit cur, nxt; int ui = 0;
    if (!S.next(0, cur)) return;
    f32x4 acc[2][2][4][2];
#pragma unroll
    for (int a = 0; a < 2; ++a)
#pragma unroll
        for (int b = 0; b < 2; ++b)
#pragma unroll
            for (int m = 0; m < 4; ++m)
#pragma unroll
                for (int n = 0; n < 2; ++n) acc[a][b][m][n] = (f32x4){0.f, 0.f, 0.f, 0.f};
    bf16x8 At[4][2], B0[2][2], B1[2][2];
    const char* cA = PG8_ABASE(cur); const char* cB = PG8_BBASE(cur);
    S.a_ready(cur);
    if constexpr (SP2) {
        PG8_STAGE(PG8_SB(0, 0), cB, voffB); PG8_STAGE(PG8_SB(0, 1), cB + hstepB, voffB); PG8_STAGE(PG8_SA(0, 0), cA, voffA); PG8_STAGE(PG8_SA(0, 1), cA + hstepA, voffA);
        if (wr == 1) PG8_BAR;
        PG8_WAIT_V(2); PG8_BAR;
        PG8_STAGE(PG8_SB(1, 0), cB + kstep, voffB); PG8_STAGE(PG8_SA(1, 0), cA + kstep, voffA); PG8_STAGE(PG8_SB(1, 1), cB + hstepB + kstep, voffB);
        PG8_WAIT_V(6); PG8_BAR;
    } else {
        PG8_STAGE(PG8_SB(0, 0), cB, voffB); PG8_STAGE(PG8_SA(0, 0), cA, voffA); PG8_STAGE(PG8_SB(0, 1), cB + hstepB, voffB); PG8_STAGE(PG8_SA(0, 1), cA + hstepA, voffA);
        if (wr == 1) PG8_BAR;
        PG8_WAIT_V(4); PG8_BAR;
        PG8_STAGE(PG8_SB(1, 0), cB + kstep, voffB); PG8_STAGE(PG8_SA(1, 0), cA + kstep, voffA); PG8_STAGE(PG8_SB(1, 1), cB + hstepB + kstep, voffB);
        PG8_WAIT_V(6); PG8_BAR;
    }
    for (;;) {
        const bool has_next = S.next(ui + 1, nxt);
        const char* nA = has_next ? PG8_ABASE(nxt) : cA; const char* nB = has_next ? PG8_BBASE(nxt) : cB;
#pragma unroll 1
        for (int t = 0; t < nt; t += 2) {
            const bool last = (t == nt - 2);
            const char* a1 = cA + (size_t)(t + 1) * kstep;
            const char* a2 = last ? nA : cA + (size_t)(t + 2) * kstep; const char* b2 = last ? nB : cB + (size_t)(t + 2) * kstep;
            const char* a3 = a2 + kstep; const char* b3 = b2 + kstep;
            if (last && has_next) S.a_ready(nxt);
            if constexpr (SP2) {
            PG8_LDB(B0, 0, 0); PG8_LDB(B1, 0, 1); PG8_SCHED; PG8_LDA(At, 0, 0); PG8_STAGE(PG8_SA(1, 1), a1 + hstepA, voffA);
            PG8_WAIT_V(8); PG8_WAIT_L(0); PG8_BAR; PG8_MMA(0, 0, At, B0); PG8_MMA(0, 1, At, B1); PG8_BAR; PG8_SCHED;
            PG8_LDA(At, 0, 1); PG8_STAGE(PG8_SB(0, 0), b2, voffB); PG8_STAGE(PG8_SB(0, 1), b2 + hstepB, voffB); PG8_STAGE(PG8_SA(0, 0), a2, voffA);
            PG8_WAIT_V(8); PG8_WAIT_L(0); PG8_BAR; PG8_MMA(1, 0, At, B0); PG8_MMA(1, 1, At, B1); PG8_BAR; PG8_SCHED;
            PG8_LDB(B0, 1, 0); PG8_LDB(B1, 1, 1); PG8_SCHED; PG8_LDA(At, 1, 0); PG8_STAGE(PG8_SA(0, 1), a2 + hstepA, voffA);
            PG8_WAIT_V(8); PG8_WAIT_L(0); PG8_BAR; PG8_MMA(0, 0, At, B0); PG8_MMA(0, 1, At, B1); PG8_BAR; PG8_SCHED;
            PG8_LDA(At, 1, 1); PG8_STAGE(PG8_SB(1, 0), b3, voffB); PG8_STAGE(PG8_SB(1, 1), b3 + hstepB, voffB); PG8_STAGE(PG8_SA(1, 0), a3, voffA);
            PG8_WAIT_V(8); PG8_WAIT_L(0); PG8_BAR; PG8_MMA(1, 0, At, B0); PG8_MMA(1, 1, At, B1); PG8_BAR; PG8_SCHED;
            } else {
            PG8_LDB(B0, 0, 0); PG8_SCHED; PG8_LDA(At, 0, 0); PG8_STAGE(PG8_SA(1, 1), a1 + hstepA, voffA);
            PG8_WAIT_L(8); PG8_BAR; PG8_WAIT_L(0); PG8_MMA(0, 0, At, B0); PG8_BAR; PG8_SCHED;
            PG8_LDB(B1, 0, 1); PG8_STAGE(PG8_SB(0, 0), b2, voffB);
            PG8_BAR; PG8_WAIT_L(0); PG8_MMA(0, 1, At, B1); PG8_BAR;
            PG8_LDA(At, 0, 1); PG8_STAGE(PG8_SA(0, 0), a2, voffA);
            PG8_BAR; PG8_WAIT_L(0); PG8_MMA(1, 0, At, B0); PG8_BAR; PG8_SCHED;
            PG8_STAGE(PG8_SB(0, 1), b2 + hstepB, voffB);
            PG8_WAIT_V(6); PG8_BAR; PG8_MMA(1, 1, At, B1); PG8_BAR;
            PG8_LDB(B0, 1, 0); PG8_SCHED; PG8_LDA(At, 1, 0); PG8_STAGE(PG8_SA(0, 1), a2 + hstepA, voffA);
            PG8_WAIT_L(8); PG8_BAR; PG8_WAIT_L(0); PG8_MMA(0, 0, At, B0); PG8_BAR; PG8_SCHED;
            PG8_LDB(B1, 1, 1); PG8_STAGE(PG8_SB(1, 0), b3, voffB);
            PG8_BAR; PG8_WAIT_L(0); PG8_MMA(0, 1, At, B1); PG8_BAR;
            PG8_LDA(At, 1, 1); PG8_STAGE(PG8_SA(1, 0), a3, voffA);
            PG8_BAR; PG8_WAIT_L(0); PG8_MMA(1, 0, At, B0); PG8_BAR; PG8_SCHED;
            PG8_STAGE(PG8_SB(1, 1), b3 + hstepB, voffB);
            PG8_WAIT_V(6); PG8_BAR; PG8_MMA(1, 1, At, B1); PG8_BAR;
            }
        }
        if constexpr (ALIGN_EPI) { if (wr == 0) PG8_BAR; }
        E(acc, cur, wr, wc, fr, fq); S.done(cur);
        if (!has_next) break;
#pragma unroll
        for (int a = 0; a < 2; ++a)
#pragma unroll
            for (int b = 0; b < 2; ++b)
#pragma unroll
                for (int m = 0; m < 4; ++m)
#pragma unroll
                    for (int n = 0; n < 2; ++n) acc[a][b][m][n] = (f32x4){0.f, 0.f, 0.f, 0.f};
        cur = nxt; cA = nA; cB = nB; ++ui;
        if constexpr (ALIGN_EPI) { if (wr == 1) PG8_BAR; }
    }
    PG8_WAIT_V(0);
    if constexpr (!ALIGN_EPI) { if (wr == 0) PG8_BAR; }
    PG8_BAR;
#undef PG8_SA
#undef PG8_SB
#undef PG8_STAGE
#undef PG8_LDA
#undef PG8_LDB
#undef PG8_MMA
#undef PG8_WAIT_V
#undef PG8_WAIT_L
#undef PG8_BAR
#undef PG8_SCHED
#undef PG8_ABASE
#undef PG8_BBASE
}
}

constexpr int NWAVES = 8;
constexpr int N_LAUNCHES = MK_N_LAUNCHES;
constexpr int NPH = 13;
constexpr int BATCH = 2, SEQ = 8192, D = 4096, M = BATCH * SEQ;
constexpr int NIN = 5 * D;
constexpr int DFF = 11008, NGU = 2 * DFF;
constexpr int NMOD = 6 * D;
constexpr int HEADS = 16, HD = 256, PGRP = 4, PGD = 1024;
constexpr float RMS_EPS = 1e-6f;
constexpr int SCAN_T = 128, SCAN_NC = SEQ / SCAN_T;

constexpr size_t MiB = 1u << 20;
constexpr size_t WS_CTL = 0, CTL_ZERO_BYTES = 1 * MiB;
constexpr size_t WS_MOD = 1 * MiB;
constexpr size_t WS_SP8 = WS_MOD + 256 * 1024;
constexpr size_t WS_CP = WS_MOD + 512 * 1024;
constexpr size_t WS_WRG = 2 * MiB;
constexpr size_t WS_WPOOL = 6 * MiB;
constexpr size_t WS_WBL = 14 * MiB;
constexpr size_t WS_WBP = 46 * MiB;
constexpr size_t WS_WO = 78 * MiB;
constexpr size_t WS_WIN = 110 * MiB;
constexpr size_t WS_XC = 110 * MiB;
constexpr size_t WS_MERGED = 110 * MiB;
constexpr size_t WS_SCANC = 240 * MiB;
constexpr size_t WS_U = 270 * MiB;
constexpr size_t WS_POOLED = 270 * MiB;
constexpr size_t WS_PROJ = 398 * MiB;
constexpr size_t WS_WGU = 398 * MiB;
constexpr size_t WS_WDN = 570 * MiB;
constexpr size_t WS_H = 656 * MiB;
constexpr size_t WS_AU = 1038 * MiB;
constexpr size_t WS_Y = 1038 * MiB;
constexpr size_t WS_Y2 = 1166 * MiB;
constexpr size_t WS_YL = 1294 * MiB;
constexpr size_t WS_X1B = 1294 * MiB;
constexpr size_t WS_YP = 1422 * MiB;
constexpr size_t WS_END = 1550 * MiB;
static_assert(WS_WIN + (size_t)NIN * D * 2 <= WS_U && WS_SCANC + 4 * MiB <= WS_U && WS_XC + (size_t)M * D * 2 <= WS_SCANC, "ws map 1");
static_assert(WS_U + (size_t)M * D * 2 <= WS_PROJ && WS_PROJ + (size_t)M * NIN * 2 <= WS_AU, "ws map 2");
static_assert(WS_WGU + (size_t)NGU * D * 2 <= WS_WDN && WS_WDN + (size_t)D * DFF * 2 <= WS_H && WS_H + (size_t)M * DFF * 2 <= WS_AU, "ws map 3");
static_assert(WS_AU + (size_t)M * D * 4 <= WS_YL && WS_Y2 + (size_t)M * D * 2 <= WS_YL && WS_YP + (size_t)M * D * 2 <= WS_END, "ws map 4");
constexpr int CW_TMO = 0;
constexpr int CW_BAR = 4096;

constexpr int RING_OFF = 0, RING_BYTES = 131072;
constexpr int LDSCTL_OFF = RING_BYTES, MISC_OFF = LDSCTL_OFF + 320;
constexpr int LDS_BYTES = 147456;
static_assert(MISC_OFF + 128 <= LDS_BYTES, "LDS map");

#define GAS __attribute__((address_space(1)))
#define LAS __attribute__((address_space(3)))
typedef unsigned short bf16;
typedef unsigned v4u __attribute__((ext_vector_type(4)));
typedef unsigned v2u __attribute__((ext_vector_type(2)));
typedef float f32x4 __attribute__((ext_vector_type(4)));
typedef float f32x2 __attribute__((ext_vector_type(2)));
typedef GAS unsigned gu32;
#define RLX_AGENT __ATOMIC_RELAXED, __HIP_MEMORY_SCOPE_AGENT
#define LDS_WAIT() asm volatile("s_waitcnt lgkmcnt(0)" ::: "memory")
#define VM_WAIT() asm volatile("s_waitcnt vmcnt(0)" ::: "memory")
using pg8::cvt_pk_bf16; using pg8::bf_lo; using pg8::bf_hi;

#define XB_TMO      128
#define XB_XCNT(j)  (256  + 64 * (j))
#define XB_XSUB(j)  (1280 + 64 * (j))
#define XB_XGEN(j)  (2304 + 64 * (j))
#define XB_TOP      3328
#define XB_TOPGEN   3392
#define XCD_BAR_WORDS 3456
#define XB_SPIN_CAP (1u << 18)

__device__ __forceinline__ unsigned xb_ld(unsigned* p)              { return __hip_atomic_load(p, __ATOMIC_RELAXED, __HIP_MEMORY_SCOPE_AGENT); }
__device__ __forceinline__ unsigned xb_add(unsigned* p, unsigned v) { return __hip_atomic_fetch_add(p, v, __ATOMIC_RELAXED, __HIP_MEMORY_SCOPE_AGENT); }
__device__ __forceinline__ unsigned xb_xcc_id() { return (unsigned)__builtin_amdgcn_s_getreg((3 << 11) | 20) & 0xFu; }
#define XB_SPIN(cond, bar) do { unsigned _sp = 0; while (cond) { __builtin_amdgcn_s_sleep(1); \
    if ((++_sp & 255u) == 0u) { if (xb_ld(&(bar)[XB_TMO])) break; if (_sp > XB_SPIN_CAP) { atomicAdd(&(bar)[XB_TMO], 1u); break; } } } } while (0)

struct XcdBarrier {
    unsigned* bar; unsigned x;
    volatile LAS unsigned* st;
};
__device__ __forceinline__ XcdBarrier xcd_barrier_post(unsigned* bar, volatile LAS unsigned* st) {
    XcdBarrier b; b.bar = bar; b.x = xb_xcc_id(); b.st = st;
    if (threadIdx.x == 0) (void)xb_add(&bar[XB_XCNT(b.x)], 1u);
    return b;
}
__device__ __forceinline__ void xcd_barrier_complete(unsigned* bar, unsigned x, unsigned& nloc, unsigned& nx) {
    const unsigned G = gridDim.x * gridDim.y * gridDim.z;
    unsigned sum, cnt, mine, sp = 0u;
    for (;;) {
        sum = 0u; cnt = 0u; mine = 0u;
#pragma unroll
        for (unsigned j = 0; j < 16; ++j) { const unsigned c = xb_ld(&bar[XB_XCNT(j)]); sum += c; cnt += (c > 0u) ? 1u : 0u; mine = (j == x) ? c : mine; }
        if (sum == G) break;
        __builtin_amdgcn_s_sleep(1);
        if ((++sp & 255u) == 0u) { if (xb_ld(&bar[XB_TMO])) break; if (sp > XB_SPIN_CAP) { atomicAdd(&bar[XB_TMO], 1u); break; } }
    }
    nloc = mine > 0u ? mine : 1u; nx = cnt > 0u ? cnt : 1u;
}
__device__ __forceinline__ void xcd_barrier(const XcdBarrier& b) {
    asm volatile("s_waitcnt vmcnt(0)" ::: "memory");
    __syncthreads();
    if (threadIdx.x == 0) {
        unsigned* bar = b.bar;
        __builtin_amdgcn_s_waitcnt(0);
        unsigned nloc = b.st[0], nx = b.st[1];
        if (nloc == 0u) { xcd_barrier_complete(bar, b.x, nloc, nx); b.st[0] = nloc; b.st[1] = nx; }
        const unsigned old = xb_add(&bar[XB_XSUB(b.x)], 1u);
        const unsigned gen = old / nloc;
        if (old + 1u == (gen + 1u) * nloc) {
            __builtin_amdgcn_fence(__ATOMIC_RELEASE, "agent");
            asm volatile("s_waitcnt vmcnt(0)" ::: "memory");
            const unsigned og = xb_add(&bar[XB_TOP], 1u);
            const unsigned tg = og / nx;
            if (og + 1u == (tg + 1u) * nx) xb_add(&bar[XB_TOPGEN], 1u);
            else XB_SPIN(xb_ld(&bar[XB_TOPGEN]) == tg, bar);
            __builtin_amdgcn_fence(__ATOMIC_ACQUIRE, "agent");
            xb_add(&bar[XB_XGEN(b.x)], 1u);
            asm volatile("s_waitcnt vmcnt(0)" ::: "memory");
        } else {
            XB_SPIN(xb_ld(&bar[XB_XGEN(b.x)]) == gen, bar);
            __builtin_amdgcn_fence(__ATOMIC_ACQUIRE, "agent");
            asm volatile("s_waitcnt vmcnt(0)" ::: "memory");
        }
    }
    __syncthreads();
}

__device__ __forceinline__ float wave_sum(float v) {
#pragma unroll
    for (int o = 1; o < 64; o <<= 1) v += __shfl_xor(v, o);
    return v;
}
__device__ __forceinline__ float dot4(f32x4 a) { return (a.x * a.x + a.y * a.y) + (a.z * a.z + a.w * a.w); }

__device__ __forceinline__ void transpose_item(const float* W, int N, bf16* WT, int ldk, int k0, int n0, int drow0, LAS float* scr, int lane) {
#pragma unroll 8
    for (int i = 0; i < 32; ++i) { const int kk = 2 * i + (lane >> 5); scr[kk * 33 + (lane & 31)] = W[(size_t)(k0 + kk) * N + n0 + (lane & 31)]; }
    LDS_WAIT(); asm volatile("" ::: "memory");
    const int c = lane & 7;
#pragma unroll
    for (int j = 0; j < 4; ++j) { const int n = (lane >> 3) + 8 * j; const LAS float* s = scr + (8 * c) * 33 + n;
        v4u o;
        { o.x = cvt_pk_bf16(s[0 * 33], s[1 * 33]); o.y = cvt_pk_bf16(s[2 * 33], s[3 * 33]); o.z = cvt_pk_bf16(s[4 * 33], s[5 * 33]); o.w = cvt_pk_bf16(s[6 * 33], s[7 * 33]); }
        *(v4u*)(WT + (size_t)(drow0 + n) * ldk + k0 + 8 * c) = o; }
    LDS_WAIT(); asm volatile("" ::: "memory");
}
template <int DMAP>
__device__ __forceinline__ void transpose_matrix(const float* W, int K, int N, bf16* WT, int ldk, int drow_off, LAS float* scr, int lane, int gw, int NGW, int& itbase) {
    const int nblk = N / 32, nitems = (K / 64) * nblk;
    int it = gw - (itbase % NGW); if (it < 0) it += NGW;
    for (; it < nitems; it += NGW) {
        const int kb = it / nblk, nb = it % nblk, n0 = 32 * nb;
        int drow;
        if (DMAP == 1) { const int isup = n0 >= DFF ? 1 : 0, j = n0 - isup * DFF; drow = (j >> 7) * 256 + isup * 128 + (j & 127); }
        else drow = n0;
        transpose_item(W, N, WT, ldk, 64 * kb, n0, drow_off + drow, scr, lane);
    }
    itbase += nitems;
}

__device__ __forceinline__ void unpack4(const v2u q, float (&f)[4]) { f[0] = bf_lo(q.x); f[1] = bf_hi(q.x); f[2] = bf_lo(q.y); f[3] = bf_hi(q.y); }
template <int W>
__device__ __forceinline__ void conv_pool_chunk(const bf16* PROJ, bf16* XC, bf16* POOLED, const float* conv_w, const float* conv_b, int chunk, int ch0) {
    float cw[4][4], cb[4];
#pragma unroll
    for (int k = 0; k < 4; ++k) { const f32x4 a = *(const f32x4*)(conv_w + k * D + ch0); cw[k][0] = a.x; cw[k][1] = a.y; cw[k][2] = a.z; cw[k][3] = a.w; }
    { const f32x4 a = *(const f32x4*)(conv_b + ch0); cb[0] = a.x; cb[1] = a.y; cb[2] = a.z; cb[3] = a.w; }
    const size_t row0 = (size_t)chunk * 64; const int t0 = (int)(row0 % SEQ);
    const bf16* pr = PROJ + row0 * NIN + ch0;
    float cx[4][4];
    v2u ph[W];
    float s[4];
#pragma unroll
    for (int j = 0; j < 4; ++j) s[j] = 0.f;
#pragma unroll
    for (int q = 0; q < 4; ++q)
#pragma unroll
        for (int j = 0; j < 4; ++j) cx[q][j] = 0.f;
#pragma unroll
    for (int q = 0; q < W; ++q) ph[q] = (v2u){0u, 0u};
    if (t0 > 0) {
#pragma unroll
        for (int q = 1; q <= 3; ++q) { const v2u x = *(const v2u*)(pr - (ptrdiff_t)q * NIN); unpack4(x, cx[(64 - q) & 3]); }
#pragma unroll
        for (int q = 1; q < W; ++q) { const v2u x = *(const v2u*)(pr + 2 * D - (ptrdiff_t)q * NIN); ph[(64 - q) & (W - 1)] = x; float f[4]; unpack4(x, f);
#pragma unroll
            for (int j = 0; j < 4; ++j) s[j] += f[j]; }
    }
    const bf16* p = pr; bf16* xo = XC + row0 * D + ch0; bf16* po = POOLED + row0 * D + ch0;
#pragma unroll 1
    for (int rb = 0; rb < 4; ++rb) {
#pragma unroll
        for (int h8 = 0; h8 < 2; ++h8) {
            v2u xnb[8], pnb[8];
#pragma unroll
            for (int q = 0; q < 8; ++q) { xnb[q] = *(const v2u*)(p + (size_t)q * NIN); pnb[q] = *(const v2u*)(p + (size_t)q * NIN + 2 * D); }
#pragma unroll
            for (int q = 0; q < 8; ++q) { const int rr = h8 * 8 + q; const int r = rb * 16 + rr;
                const v2u xn = xnb[q], pn = pnb[q];
                float xf[4]; unpack4(xn, xf);
                float a[4];
#pragma unroll
                for (int j = 0; j < 4; ++j) a[j] = cb[j] + cw[0][j] * cx[(rr + 1) & 3][j] + cw[1][j] * cx[(rr + 2) & 3][j] + cw[2][j] * cx[(rr + 3) & 3][j] + cw[3][j] * xf[j];
#pragma unroll
                for (int j = 0; j < 4; ++j) cx[rr & 3][j] = xf[j];
                { v2u o; o.x = cvt_pk_bf16(a[0], a[1]); o.y = cvt_pk_bf16(a[2], a[3]); *(v2u*)(xo + (size_t)q * D) = o; }
                float pf[4], of[4]; unpack4(pn, pf); unpack4(ph[rr & (W - 1)], of);
                ph[rr & (W - 1)] = pn;
                const int t = t0 + r; const int cnt = (t + 1 < W) ? (t + 1) : W; const float inv = 1.0f / (float)cnt;
#pragma unroll
                for (int j = 0; j < 4; ++j) { s[j] += pf[j] - of[j]; a[j] = s[j] * inv - pf[j]; }
                { v2u o; o.x = cvt_pk_bf16(a[0], a[1]); o.y = cvt_pk_bf16(a[2], a[3]); *(v2u*)(po + (size_t)q * D) = o; }
            }
            p += 8 * NIN; xo += 8 * D; po += 8 * D;
            asm volatile("" ::: "memory");
        }
    }
}

constexpr int RG_PITCH = 544;
__device__ __forceinline__ void rg_gate4(const f32x4 rp, const f32x4 ip, const f32x4 sp, const v2u xq, unsigned (&w)[4]) {
    const float xv[4] = {bf_lo(xq.x), bf_hi(xq.x), bf_lo(xq.y), bf_hi(xq.y)};
    float la[4], em1[4], ig[4];
#pragma unroll
    for (int j = 0; j < 4; ++j) { const float r = pg8::sigmoidf_(rp[j]); ig[j] = pg8::sigmoidf_(ip[j]); la[j] = sp[j] * r; const float x2 = la[j] + la[j];
        em1[j] = x2 * (1.0f + x2 * (0.5f + x2 * (0.16666667f + x2 * (0.041666668f + x2 * (0.0083333338f + x2 * 0.0013888889f))))); }
    if (__any(fminf(fminf(la[0], la[1]), fminf(la[2], la[3])) <= -0.125f)) {
#pragma unroll
        for (int j = 0; j < 4; ++j) { const float x2 = la[j] + la[j]; em1[j] = (x2 > -0.25f) ? em1[j] : (pg8::fast_exp(x2) - 1.0f); } }
#pragma unroll
    for (int j = 0; j < 4; ++j) { const float mult = __builtin_sqrtf(fmaxf(-em1[j], 0.0f)); w[j] = cvt_pk_bf16(la[j], mult * ig[j] * xv[j]); }
}
__device__ __forceinline__ void rg_direct(const bf16* XC, const bf16* Wrg_t, unsigned* AU, const float* b_a, const float* b_x, const float* sp8,
                                          LAS unsigned char* lds, int tid, int lane, int wave, int vcu, int G) {
    typedef pg8::bf16x8 bf16x8;
    const int fr = lane & 15, fq = lane >> 4;
    for (int vq = vcu; vq < 256; vq += G) {
        const int h = vq >> 4, s = (vq >> 1) & 7, half = vq & 1;
        __syncthreads();
        { const int n = tid >> 3, p = tid & 7, chl = s * 32 + (n & 31), srow = h * 512 + (chl >> 7) * 256 + (n >> 5) * 128 + (chl & 127);
          const v4u* src = (const v4u*)(Wrg_t + (size_t)srow * HD + p * 32); LAS v4u* dst = (LAS v4u*)(lds + n * RG_PITCH + p * 64);
#pragma unroll
          for (int q = 0; q < 4; ++q) dst[q] = src[q]; }
        __syncthreads();
        const int c0 = h * HD + s * 32;
        f32x4 ba[2], bx[2], sp[2];
#pragma unroll
        for (int c2 = 0; c2 < 2; ++c2) { const int ch = c0 + 16 * c2 + 4 * fq; ba[c2] = *(const f32x4*)(b_a + ch); bx[c2] = *(const f32x4*)(b_x + ch); sp[c2] = *(const f32x4*)(sp8 + ch); }
        const bf16* abase = XC + h * HD + 8 * fq; const bf16* xbase = XC + c0 + 4 * fq; unsigned* obase = AU + c0 + 4 * fq;
        const LAS unsigned char* bl = lds + fr * RG_PITCH + 16 * fq;
        bf16x8 af[2][8]; v2u xq[2][2];
        { const size_t row0 = (size_t)(half * 256 + wave) * 32;
#pragma unroll
          for (int r2 = 0; r2 < 2; ++r2) { const size_t ro = (row0 + 16 * r2 + fr) * D;
#pragma unroll
              for (int kb = 0; kb < 8; ++kb) af[r2][kb] = *(const bf16x8*)(abase + ro + 32 * kb);
#pragma unroll
              for (int c2 = 0; c2 < 2; ++c2) xq[r2][c2] = *(const v2u*)(xbase + ro + 16 * c2); } }
#pragma unroll 1
        for (int i = 0; i < 32; ++i) {
            const size_t row0 = (size_t)(half * 256 + wave + 8 * i) * 32;
            bf16x8 afn[2][8]; v2u xqn[2][2];
            if (i + 1 < 32) { const size_t rown = row0 + 256;
#pragma unroll
                for (int r2 = 0; r2 < 2; ++r2) { const size_t ro = (rown + 16 * r2 + fr) * D;
#pragma unroll
                    for (int kb = 0; kb < 8; ++kb) afn[r2][kb] = *(const bf16x8*)(abase + ro + 32 * kb);
#pragma unroll
                    for (int c2 = 0; c2 < 2; ++c2) xqn[r2][c2] = *(const v2u*)(xbase + ro + 16 * c2); } }
            else {
#pragma unroll
                for (int r2 = 0; r2 < 2; ++r2) {
#pragma unroll
                    for (int kb = 0; kb < 8; ++kb) afn[r2][kb] = af[r2][kb];
#pragma unroll
                    for (int c2 = 0; c2 < 2; ++c2) xqn[r2][c2] = xq[r2][c2]; } }
            f32x4 acc[2][4];
#pragma unroll
            for (int r2 = 0; r2 < 2; ++r2)
#pragma unroll
                for (int cb = 0; cb < 4; ++cb) acc[r2][cb] = (f32x4){0.f, 0.f, 0.f, 0.f};
#pragma unroll
            for (int kb = 0; kb < 8; ++kb)
#pragma unroll
                for (int cb = 0; cb < 4; ++cb) { const bf16x8 bf = *(const LAS bf16x8*)(bl + cb * 16 * RG_PITCH + kb * 64);
#pragma unroll
                    for (int r2 = 0; r2 < 2; ++r2) acc[r2][cb] = __builtin_amdgcn_mfma_f32_16x16x32_bf16(bf, af[r2][kb], acc[r2][cb], 0, 0, 0); }
#pragma unroll
            for (int r2 = 0; r2 < 2; ++r2) { const size_t ro = (row0 + 16 * r2 + fr) * D;
#pragma unroll
                for (int c2 = 0; c2 < 2; ++c2) { unsigned w[4]; rg_gate4(acc[r2][c2] + ba[c2], acc[r2][c2 + 2] + bx[c2], sp[c2], xq[r2][c2], w);
                    v4u o; o.x = w[0]; o.y = w[1]; o.z = w[2]; o.w = w[3]; *(v4u*)(obase + ro + 16 * c2) = o; } }
#pragma unroll
            for (int r2 = 0; r2 < 2; ++r2) {
#pragma unroll
                for (int kb = 0; kb < 8; ++kb) af[r2][kb] = afn[r2][kb];
#pragma unroll
                for (int c2 = 0; c2 < 2; ++c2) xq[r2][c2] = xqn[r2][c2]; }
        }
    }
    __syncthreads();
}

#define LRU_FUSED 1
template <int CTRL> __device__ __forceinline__ float dpp_row(float identity, float v) {
    return __int_as_float(__builtin_amdgcn_update_dpp(__float_as_int(identity), __float_as_int(v), CTRL, 0xf, 0xf, false)); }
constexpr int LRU_XOFF = 36864;
__device__ __forceinline__ void lru_fused(const bf16* XC, const bf16* Wrg_t, const bf16* PROJ, bf16* YL, const float* b_a, const float* b_x, const float* sp8,
                                          LAS unsigned char* lds, int tid, int lane, int wave, int vcu, int G) {
    typedef pg8::bf16x8 bf16x8;
    const int fr = lane & 15, fq = lane >> 4;
    for (int vq = vcu; vq < 256; vq += G) {
        const int h = vq >> 4, s = (vq >> 1) & 7, bsel = vq & 1;
        __syncthreads();
        { const int n = tid >> 3, p = tid & 7, chl = s * 32 + (n & 31), srow = h * 512 + (chl >> 7) * 256 + (n >> 5) * 128 + (chl & 127);
          const v4u* src = (const v4u*)(Wrg_t + (size_t)srow * HD + p * 32); LAS v4u* dst = (LAS v4u*)(lds + n * RG_PITCH + p * 64);
#pragma unroll
          for (int q = 0; q < 4; ++q) dst[q] = src[q]; }
        __syncthreads();
        const int c0 = h * HD + s * 32;
        f32x4 ba[2], bx[2], sp[2];
#pragma unroll
        for (int c2 = 0; c2 < 2; ++c2) { const int ch = c0 + 16 * c2 + 4 * fq; ba[c2] = *(const f32x4*)(b_a + ch); bx[c2] = *(const f32x4*)(b_x + ch); sp[c2] = *(const f32x4*)(sp8 + ch); }
        const bf16* abase = XC + h * HD + 8 * fq; const bf16* xbase = XC + c0 + 4 * fq; const bf16* gbase = PROJ + D + c0 + 4 * fq; bf16* obase = YL + c0 + 4 * fq;
        const LAS unsigned char* bl = lds + fr * RG_PITCH + 16 * fq;
        LAS float* xch = (LAS float*)(lds + LRU_XOFF);
        f32x4 carry[2] = {{0.f, 0.f, 0.f, 0.f}, {0.f, 0.f, 0.f, 0.f}};
        bf16x8 af[2][8]; v2u xq[2][2], gq[2][2];
        { const size_t row0 = (size_t)bsel * SEQ + (size_t)wave * 32;
#pragma unroll
          for (int r2 = 0; r2 < 2; ++r2) { const size_t ro = (row0 + 16 * r2 + fr) * D, rg = (row0 + 16 * r2 + fr) * NIN;
#pragma unroll
              for (int kb = 0; kb < 8; ++kb) af[r2][kb] = *(const bf16x8*)(abase + ro + 32 * kb);
#pragma unroll
              for (int c2 = 0; c2 < 2; ++c2) { xq[r2][c2] = *(const v2u*)(xbase + ro + 16 * c2); gq[r2][c2] = *(const v2u*)(gbase + rg + 16 * c2); } } }
#pragma unroll 1
        for (int i = 0; i < SEQ / 256; ++i) {
            const size_t row0 = (size_t)bsel * SEQ + (size_t)i * 256 + (size_t)wave * 32;
            f32x4 acc[2][4];
#pragma unroll
            for (int r2 = 0; r2 < 2; ++r2)
#pragma unroll
                for (int cb = 0; cb < 4; ++cb) acc[r2][cb] = (f32x4){0.f, 0.f, 0.f, 0.f};
            {
                bf16x8 bq[2][4];
#pragma unroll
                for (int cb = 0; cb < 4; ++cb) bq[0][cb] = *(const LAS bf16x8*)(bl + cb * 16 * RG_PITCH);
#pragma unroll
                for (int kb = 0; kb < 8; ++kb) {
                    if (kb + 1 < 8) {
#pragma unroll
                        for (int cb = 0; cb < 4; ++cb) bq[(kb + 1) & 1][cb] = *(const LAS bf16x8*)(bl + cb * 16 * RG_PITCH + (kb + 1) * 64); }
                    __builtin_amdgcn_sched_barrier(0);
#pragma unroll
                    for (int cb = 0; cb < 4; ++cb)
#pragma unroll
                        for (int r2 = 0; r2 < 2; ++r2) acc[r2][cb] = __builtin_amdgcn_mfma_f32_16x16x32_bf16(bq[kb & 1][cb], af[r2][kb], acc[r2][cb], 0, 0, 0);
                    __builtin_amdgcn_sched_barrier(0);
                }
            }
            v2u xqn[2][2], gqn[2][2];
            { const size_t rown = (i + 1 < SEQ / 256) ? row0 + 256 : row0;
#pragma unroll
                for (int r2 = 0; r2 < 2; ++r2) { const size_t ro = (rown + 16 * r2 + fr) * D, rg = (rown + 16 * r2 + fr) * NIN;
#pragma unroll
                    for (int kb = 0; kb < 8; ++kb) af[r2][kb] = *(const bf16x8*)(abase + ro + 32 * kb);
#pragma unroll
                    for (int c2 = 0; c2 < 2; ++c2) { xqn[r2][c2] = *(const v2u*)(xbase + ro + 16 * c2); gqn[r2][c2] = *(const v2u*)(gbase + rg + 16 * c2); } } }
            float A[2][2][4], U[2][2][4];
#pragma unroll
            for (int r2 = 0; r2 < 2; ++r2)
#pragma unroll
                for (int c2 = 0; c2 < 2; ++c2) { const f32x4 rp = acc[r2][c2] + ba[c2], ip = acc[r2][c2 + 2] + bx[c2]; const v2u xw = xq[r2][c2];
                    const float xv[4] = {bf_lo(xw.x), bf_hi(xw.x), bf_lo(xw.y), bf_hi(xw.y)};
                    float la[4], em1[4], ig[4];
#pragma unroll
                    for (int j = 0; j < 4; ++j) { const float r = pg8::sigmoidf_(rp[j]); ig[j] = pg8::sigmoidf_(ip[j]); la[j] = sp[c2][j] * r; const float x2 = la[j] + la[j];
                        em1[j] = x2 * (1.0f + x2 * (0.5f + x2 * (0.16666667f + x2 * (0.041666668f + x2 * (0.0083333338f + x2 * 0.0013888889f))))); }
                    if (__any(fminf(fminf(la[0], la[1]), fminf(la[2], la[3])) <= -0.125f)) {
#pragma unroll
                        for (int j = 0; j < 4; ++j) { const float x2 = la[j] + la[j]; em1[j] = (x2 > -0.25f) ? em1[j] : (pg8::fast_exp(x2) - 1.0f); } }
#pragma unroll
                    for (int j = 0; j < 4; ++j) { A[r2][c2][j] = pg8::fast_exp(la[j]); U[r2][c2][j] = __builtin_sqrtf(fmaxf(-em1[j], 0.0f)) * ig[j] * xv[j]; } }
#define LRU_STEP(d) \
                        "v_fmac_f32_dpp %4, %4, %0 row_shr:" #d " row_mask:0xf bank_mask:0xf\n\tv_mul_f32_dpp %0, %0, %0 row_shr:" #d " row_mask:0xf bank_mask:0xf\n\t" \
                        "v_fmac_f32_dpp %5, %5, %1 row_shr:" #d " row_mask:0xf bank_mask:0xf\n\tv_mul_f32_dpp %1, %1, %1 row_shr:" #d " row_mask:0xf bank_mask:0xf\n\t" \
                        "v_fmac_f32_dpp %6, %6, %2 row_shr:" #d " row_mask:0xf bank_mask:0xf\n\tv_mul_f32_dpp %2, %2, %2 row_shr:" #d " row_mask:0xf bank_mask:0xf\n\t" \
                        "v_fmac_f32_dpp %7, %7, %3 row_shr:" #d " row_mask:0xf bank_mask:0xf\n\tv_mul_f32_dpp %3, %3, %3 row_shr:" #d " row_mask:0xf bank_mask:0xf\n\t"
#pragma unroll
            for (int r2 = 0; r2 < 2; ++r2)
#pragma unroll
                for (int c2 = 0; c2 < 2; ++c2)
                    asm volatile("s_nop 1\n\t" LRU_STEP(1) LRU_STEP(2) LRU_STEP(4) LRU_STEP(8)
                                 : "+v"(A[r2][c2][0]), "+v"(A[r2][c2][1]), "+v"(A[r2][c2][2]), "+v"(A[r2][c2][3]), "+v"(U[r2][c2][0]), "+v"(U[r2][c2][1]), "+v"(U[r2][c2][2]), "+v"(U[r2][c2][3]));
#undef LRU_STEP
            const int l15 = (lane & 48) | 15;
#pragma unroll
            for (int c2 = 0; c2 < 2; ++c2)
#pragma unroll
                for (int j = 0; j < 4; ++j) { const float a15 = __shfl(A[0][c2][j], l15), u15 = __shfl(U[0][c2][j], l15);
                    U[1][c2][j] = A[1][c2][j] * u15 + U[1][c2][j]; A[1][c2][j] = A[1][c2][j] * a15; }
            LAS float* xp = xch + (i & 1) * 512;
            if (fr == 15) {
#pragma unroll
                for (int c2 = 0; c2 < 2; ++c2) { *(LAS f32x4*)(xp + wave * 32 + 16 * c2 + 4 * fq) = (f32x4){A[1][c2][0], A[1][c2][1], A[1][c2][2], A[1][c2][3]};
                    *(LAS f32x4*)(xp + 256 + wave * 32 + 16 * c2 + 4 * fq) = (f32x4){U[1][c2][0], U[1][c2][1], U[1][c2][2], U[1][c2][3]}; } }
            asm volatile("s_waitcnt lgkmcnt(0)" ::: "memory"); __builtin_amdgcn_s_barrier(); asm volatile("" ::: "memory");
            f32x4 hin[2] = {carry[0], carry[1]};
#pragma unroll
            for (int w = 0; w < NWAVES; ++w)
#pragma unroll
                for (int c2 = 0; c2 < 2; ++c2) { const f32x4 P = *(const LAS f32x4*)(xp + w * 32 + 16 * c2 + 4 * fq), Hh = *(const LAS f32x4*)(xp + 256 + w * 32 + 16 * c2 + 4 * fq);
                    carry[c2] = P * carry[c2] + Hh; if (w == wave - 1) hin[c2] = carry[c2]; }
#pragma unroll
            for (int r2 = 0; r2 < 2; ++r2) { const size_t ro = (row0 + 16 * r2 + fr) * D;
#pragma unroll
                for (int c2 = 0; c2 < 2; ++c2) { const v2u gw = gq[r2][c2]; const float gg[4] = {bf_lo(gw.x), bf_hi(gw.x), bf_lo(gw.y), bf_hi(gw.y)}; float y[4];
#pragma unroll
                    for (int j = 0; j < 4; ++j) { const float hh = U[r2][c2][j] + A[r2][c2][j] * hin[c2][j]; y[j] = hh * pg8::gelu_tanh_(gg[j]); }
                    v2u o; o.x = cvt_pk_bf16(y[0], y[1]); o.y = cvt_pk_bf16(y[2], y[3]); *(v2u*)(obase + ro + 16 * c2) = o; } }
#pragma unroll
            for (int r2 = 0; r2 < 2; ++r2)
#pragma unroll
                for (int c2 = 0; c2 < 2; ++c2) { xq[r2][c2] = xqn[r2][c2]; gq[r2][c2] = gqn[r2][c2]; }
        }
    }
    __syncthreads();
}

struct Args { const float* in[23]; float* out; unsigned char* ws; int ph_lo, ph_hi, li, pad; };

__global__ void __launch_bounds__(NWAVES * 64, 2) fwd_kernel(Args args) {
    extern __shared__ __attribute__((aligned(16))) unsigned char lds_raw[];
    LAS unsigned char* lds = (LAS unsigned char*)lds_raw;
    volatile LAS unsigned* MISC = (volatile LAS unsigned*)(lds + MISC_OFF);
    const int tid = threadIdx.x, lane = tid & 63, wave = __builtin_amdgcn_readfirstlane(tid >> 6);
    const int G = gridDim.x; const int bx = blockIdx.x; const int vcu = (G % 8 == 0) ? (bx % 8) * (G / 8) + bx / 8 : bx;
    unsigned char* ws = args.ws;
    gu32* ctl = (gu32*)(ws + WS_CTL);
    const float* x = args.in[0]; const float* cvec = args.in[1]; const float* w_ada = args.in[2]; const float* b_ada = args.in[3];
    const float* g_mix_pre = args.in[4]; const float* g_mix_post = args.in[5]; const float* w_in = args.in[6]; const float* conv_w = args.in[7]; const float* conv_b = args.in[8];
    const float* w_rg_a = args.in[9]; const float* b_rg_a = args.in[10]; const float* w_rg_x = args.in[11]; const float* b_rg_x = args.in[12]; const float* lam = args.in[13];
    const float* pool_w = args.in[14]; const float* pool_scale = args.in[15]; const float* w_bl = args.in[16]; const float* w_bp = args.in[17]; const float* w_o = args.in[18];
    const float* g_ffn_pre = args.in[19]; const float* g_ffn_post = args.in[20]; const float* w_gu = args.in[21]; const float* w_dn = args.in[22];
    float* out = args.out;
    float* mod = (float*)(ws + WS_MOD); float* sp8 = (float*)(ws + WS_SP8);
    bf16* Wrg_t = (bf16*)(ws + WS_WRG); bf16* Wpool_t = (bf16*)(ws + WS_WPOOL); bf16* Wbl_t = (bf16*)(ws + WS_WBL); bf16* Wbp_t = (bf16*)(ws + WS_WBP); bf16* Wo_t = (bf16*)(ws + WS_WO);
    bf16* Win_t = (bf16*)(ws + WS_WIN); bf16* Wgu_t = (bf16*)(ws + WS_WGU); bf16* Wdn_t = (bf16*)(ws + WS_WDN);
    bf16* U = (bf16*)(ws + WS_U); bf16* PROJ = (bf16*)(ws + WS_PROJ); bf16* XC = (bf16*)(ws + WS_XC); bf16* POOLED = (bf16*)(ws + WS_POOLED);
    unsigned* AU = (unsigned*)(ws + WS_AU); float* SCP = (float*)(ws + WS_SCANC); float* SCH = SCP + BATCH * SCAN_NC * D;
    bf16* YL = (bf16*)(ws + WS_YL); bf16* YP = (bf16*)(ws + WS_YP); bf16* MERGED = (bf16*)(ws + WS_MERGED); bf16* Y = (bf16*)(ws + WS_Y); bf16* Y2 = (bf16*)(ws + WS_Y2); bf16* H = (bf16*)(ws + WS_H); bf16* X1B = (bf16*)(ws + WS_X1B);

    for (int u = tid; u < (LDS_BYTES - LDSCTL_OFF) / 4; u += NWAVES * 64) ((LAS unsigned*)(lds + LDSCTL_OFF))[u] = 0u;
    __syncthreads();
    XcdBarrier bar; bar.bar = (unsigned*)(ctl + CW_BAR) + args.li * XCD_BAR_WORDS; bar.x = 0; bar.st = nullptr;
    if (N_LAUNCHES != NPH) bar = xcd_barrier_post((unsigned*)(ctl + CW_BAR) + args.li * XCD_BAR_WORDS, MISC + 8);
#define GRID_BAR() do { if (N_LAUNCHES != NPH) xcd_barrier(bar); } while (0)
    const int lo = args.ph_lo, hi = args.ph_hi;
#ifndef PH_MASK
#define PH_MASK (0x1fff & ~0x60)
#endif
#define IN(k) (((PH_MASK >> (k)) & 1) && lo <= (k) && (k) < hi)
#ifndef DUP_MASK
#define DUP_MASK 0


#endif
#define DUP(k) ((DUP_MASK >> (k)) & 1)
#define REP(k) _Pragma("unroll 1") for (int rep_ = 0; rep_ < DUP(k) + 1; ++rep_)
#define BOTH(k) (IN(k) && (k) + 1 < hi)
    const int gw = vcu * NWAVES + wave, NGW = G * NWAVES;

    if (IN(0)) REP(0) {
        {
            LAS float* cact = (LAS float*)lds; LAS float* red = (LAS float*)(lds + 32768);
            for (int i = tid; i < BATCH * D; i += NWAVES * 64) { const float v = cvec[i]; cact[i] = pg8::siluf_(v); }
            __syncthreads();
            const int cg = tid % 24, kg = tid / 24;
            for (int g = vcu; g < NMOD / 96; g += G) {
                if (kg < 21) {
                    f32x4 a0 = {0.f, 0.f, 0.f, 0.f}, a1 = {0.f, 0.f, 0.f, 0.f};
                    const float* wp = w_ada + (size_t)g * 96 + cg * 4;
#pragma unroll 8
                    for (int k = kg; k < D; k += 21) { const f32x4 w = *(const f32x4*)(wp + (size_t)k * NMOD); const float c0 = cact[k], c1 = cact[D + k]; a0 += w * c0; a1 += w * c1; }
                    LAS float* rp = red + (kg * 24 + cg) * 8;
                    rp[0] = a0.x; rp[1] = a0.y; rp[2] = a0.z; rp[3] = a0.w; rp[4] = a1.x; rp[5] = a1.y; rp[6] = a1.z; rp[7] = a1.w;
                }
                __syncthreads();
                if (tid < 192) { const int cgo = tid >> 3, r = tid & 7, b = r >> 2, j = r & 3; float s = 0.f;
#pragma unroll
                    for (int q = 0; q < 21; ++q) s += red[(q * 24 + cgo) * 8 + r];
                    const int n = g * 96 + cgo * 4 + j; mod[b * NMOD + n] = s + b_ada[n]; }
                __syncthreads();
            }
        }
        for (int i = bx * NWAVES * 64 + tid; i < D; i += G * NWAVES * 64) { const float l = lam[i]; sp8[i] = -8.0f * log1pf(expf(-l)); }
        {
            LAS float* scr = (LAS float*)(lds + wave * 16384);
            int itbase = 0;
            transpose_matrix<0>(w_in, D, NIN, Win_t, D, 0, scr, lane, gw, NGW, itbase);
            for (int h = 0; h < HEADS; ++h) {
                const int nblk = HD / 32, nitems = (HD / 64) * nblk * 2;
                int it = gw - (itbase % NGW); if (it < 0) it += NGW;
                for (; it < nitems; it += NGW) { const int which = it / ((HD / 64) * nblk), r = it % ((HD / 64) * nblk), kb = r / nblk, nb = r % nblk, n0 = 32 * nb;
                    const float* W = (which ? w_rg_x : w_rg_a) + (size_t)h * HD * HD;
                    transpose_item(W, HD, Wrg_t, HD, 64 * kb, n0, h * 512 + (n0 >> 7) * 256 + which * 128 + (n0 & 127), scr, lane); }
                itbase += nitems;
            }
            for (int gi = 0; gi < PGRP; ++gi) transpose_matrix<0>(pool_w + (size_t)gi * PGD * PGD, PGD, PGD, Wpool_t, PGD, gi * PGD, scr, lane, gw, NGW, itbase);
            transpose_matrix<0>(w_bl, D, D, Wbl_t, D, 0, scr, lane, gw, NGW, itbase);
            transpose_matrix<0>(w_bp, D, D, Wbp_t, D, 0, scr, lane, gw, NGW, itbase);
            transpose_matrix<0>(w_o, D, D, Wo_t, D, 0, scr, lane, gw, NGW, itbase);
        }
        if (BOTH(0)) GRID_BAR();
    }

    if (IN(1)) REP(1) {
        LAS float* cA = (LAS float*)lds; LAS float* cB = cA + D;
        int cur_b = -1;
        for (int slot = vcu; slot < M / 8; slot += G) {
            const int b = slot / (SEQ / 8);
            if (b != cur_b) { __syncthreads();
                for (int i = tid; i < D; i += NWAVES * 64) { cA[i] = g_mix_pre[i] * (1.0f + mod[b * NMOD + 1 * D + i]); cB[i] = mod[b * NMOD + 0 * D + i]; }
                __syncthreads(); cur_b = b; }
            { const size_t row = (size_t)slot * 8 + wave;
                const f32x4* xr = (const f32x4*)(x + row * D) + lane;
                f32x4 v[16]; float s = 0.f;
#pragma unroll
                for (int j = 0; j < 16; ++j) { v[j] = xr[64 * j]; s += dot4(v[j]); }
                const float rstd = 1.0f / sqrtf(wave_sum(s) * (1.0f / D) + RMS_EPS);
                v2u* o8 = (v2u*)(U + row * D) + lane;
#pragma unroll
                for (int j = 0; j < 16; ++j) { const f32x4 a = ((const LAS f32x4*)cA)[lane + 64 * j], bb = ((const LAS f32x4*)cB)[lane + 64 * j]; const f32x4 o = v[j] * rstd * a + bb;
                    v2u w; w.x = cvt_pk_bf16(o.x, o.y); w.y = cvt_pk_bf16(o.z, o.w); o8[64 * j] = w; }
            }
        }
        if (BOTH(1)) GRID_BAR();
    }

    if (IN(2)) {
#define P2_BODY do { pg8::Gemm g{U, Win_t, M, NIN, D, D, D, 30}; pg8::StaticOrder S; S.init(M, NIN, G, bx); \
        pg8::EpiPlain E{PROJ, NIN}; \
        pg8::gemm_phase<pg8::EpiPlain, pg8::StaticOrder, true, true>(lds + RING_OFF, g, S, E); } while (0)
        P2_BODY; if (DUP(2)) { P2_BODY; }
        if (BOTH(2)) GRID_BAR();
    }

    if (IN(3)) REP(3) {
        for (int id = gw; id < (M / 64) * 16; id += NGW) { const int chunk = id >> 4, cgp = id & 15, ch0 = cgp * 256 + lane * 4;
            switch (cgp >> 2) {
                case 0: conv_pool_chunk<2>(PROJ, XC, POOLED, conv_w, conv_b, chunk, ch0); break;
                case 1: conv_pool_chunk<4>(PROJ, XC, POOLED, conv_w, conv_b, chunk, ch0); break;
                case 2: conv_pool_chunk<8>(PROJ, XC, POOLED, conv_w, conv_b, chunk, ch0); break;
                default: conv_pool_chunk<16>(PROJ, XC, POOLED, conv_w, conv_b, chunk, ch0); break;
            }
        }
        if (BOTH(3)) GRID_BAR();
    }

    if (IN(4)) {
#define P4_BODY do { \
        lru_fused(XC, Wrg_t, PROJ, YL, b_rg_a, b_rg_x, sp8, lds, tid, lane, wave, vcu, G); \
        { pg8::Gemm g{POOLED, Wpool_t, M, D, PGD, D, PGD, 2}; pg8::StaticOrder S; S.init(M, D, G, bx); \
          pg8::EpiScale E{YP, D, pool_scale}; \
          pg8::gemm_phase<pg8::EpiScale, pg8::StaticOrder, true, true>(lds + RING_OFF, g, S, E); } } while (0)
        P4_BODY; if (DUP(4)) { P4_BODY; }
        if (BOTH(4)) GRID_BAR();
    }

    if (IN(5)) REP(5) {
        for (int id = gw; id < BATCH * SCAN_NC * 16; id += NGW) { const int cgp = id & 15, chunk = (id >> 4) % SCAN_NC, b = id / (16 * SCAN_NC);
            const int ch = cgp * 256 + lane * 4; const size_t row0 = (size_t)b * SEQ + (size_t)chunk * SCAN_T;
            const v4u* p = (const v4u*)(AU + row0 * D + ch);
            float S[4] = {0.f, 0.f, 0.f, 0.f}, h[4] = {0.f, 0.f, 0.f, 0.f};
#pragma unroll 8
            for (int r = 0; r < SCAN_T; ++r) { const v4u w = p[(size_t)r * (D / 4)]; const unsigned ww[4] = {w.x, w.y, w.z, w.w};
#pragma unroll
                for (int j = 0; j < 4; ++j) { const float l = bf_lo(ww[j]), u = bf_hi(ww[j]); h[j] = pg8::fast_exp(l) * h[j] + u; S[j] += l; } }
            const size_t o = ((size_t)(b * SCAN_NC + chunk)) * D + ch;
            *(f32x4*)(SCP + o) = (f32x4){pg8::fast_exp(S[0]), pg8::fast_exp(S[1]), pg8::fast_exp(S[2]), pg8::fast_exp(S[3])}; *(f32x4*)(SCH + o) = (f32x4){h[0], h[1], h[2], h[3]};
        }
        if (BOTH(5)) GRID_BAR();
    }

    if (IN(6)) REP(6) {
        for (int id = gw; id < BATCH * SCAN_NC * 16; id += NGW) { const int cgp = id & 15, chunk = (id >> 4) % SCAN_NC, b = id / (16 * SCAN_NC);
            const int ch = cgp * 256 + lane * 4; const size_t row0 = (size_t)b * SEQ + (size_t)chunk * SCAN_T;
            f32x4 hc = {0.f, 0.f, 0.f, 0.f};
#pragma unroll 8
            for (int c = 0; c < chunk; ++c) { const size_t o = ((size_t)(b * SCAN_NC + c)) * D + ch; const f32x4 P = *(const f32x4*)(SCP + o), Hh = *(const f32x4*)(SCH + o); hc = P * hc + Hh; }
            float h[4] = {hc.x, hc.y, hc.z, hc.w};
            const v4u* p = (const v4u*)(AU + row0 * D + ch); const v2u* gp = (const v2u*)(PROJ + row0 * NIN + D + ch); v2u* yo = (v2u*)(YL + row0 * D + ch);
#pragma unroll 1
            for (int r0 = 0; r0 < SCAN_T; r0 += 8) {
                v4u wb[8]; v2u gb[8];
#pragma unroll
                for (int q = 0; q < 8; ++q) { wb[q] = p[(size_t)(r0 + q) * (D / 4)]; gb[q] = gp[(size_t)(r0 + q) * (NIN / 4)]; }
#pragma unroll
                for (int q = 0; q < 8; ++q) { const v4u w = wb[q]; const v2u gq = gb[q]; const unsigned ww[4] = {w.x, w.y, w.z, w.w};
                    const float gg[4] = {bf_lo(gq.x), bf_hi(gq.x), bf_lo(gq.y), bf_hi(gq.y)}; float y[4];
#pragma unroll
                    for (int j = 0; j < 4; ++j) { const float l = bf_lo(ww[j]), u = bf_hi(ww[j]); h[j] = pg8::fast_exp(l) * h[j] + u; y[j] = h[j] * pg8::gelu_tanh_(gg[j]); }
                    v2u o; o.x = cvt_pk_bf16(y[0], y[1]); o.y = cvt_pk_bf16(y[2], y[3]); yo[(size_t)(r0 + q) * (D / 4)] = o; }
                asm volatile("" ::: "memory");
            }
        }
        if (BOTH(6)) GRID_BAR();
    }

    if (IN(7)) {
#define P7_BODY do { \
        { pg8::Gemm g{YL, Wbl_t, M, D, D, D, D, 30}; pg8::StaticOrder S; S.init(M, D, G, bx); \
          pg8::EpiGate<false> E{MERGED, D, PROJ + 3 * D, NIN}; \
          pg8::gemm_phase<pg8::EpiGate<false>, pg8::StaticOrder, true, true>(lds + RING_OFF, g, S, E); } \
        { pg8::Gemm g{YP, Wbp_t, M, D, D, D, D, 30}; pg8::StaticOrder S; S.init(M, D, G, bx); \
          pg8::EpiGate<true> E{MERGED, D, PROJ + 4 * D, NIN}; \
          pg8::gemm_phase<pg8::EpiGate<true>, pg8::StaticOrder, true, true>(lds + RING_OFF, g, S, E); } } while (0)
        P7_BODY; if (DUP(7)) { P7_BODY; }
        if (BOTH(7)) GRID_BAR();
    }

    if (IN(8)) {
#define P8_BODY do { pg8::Gemm g{MERGED, Wo_t, M, D, D, D, D, 30}; pg8::StaticOrder S; S.init(M, D, G, bx); \
        pg8::EpiPlain E{Y, D}; \
        pg8::gemm_phase<pg8::EpiPlain, pg8::StaticOrder, true, true>(lds + RING_OFF, g, S, E); } while (0)
        P8_BODY; if (DUP(8)) { P8_BODY; }
        if (BOTH(8)) GRID_BAR();
    }

    if (IN(9)) REP(9) {
        {
            LAS float* cG = (LAS float*)lds; LAS float* cA = cG + D; LAS float* cB = cA + D;
            int cur_b = -1;
            for (int slot = vcu; slot < M / 8; slot += G) {
                const int b = slot / (SEQ / 8);
                if (b != cur_b) { __syncthreads();
                    for (int i = tid; i < D; i += NWAVES * 64) { cG[i] = mod[b * NMOD + 2 * D + i] * g_mix_post[i]; cA[i] = g_ffn_pre[i] * (1.0f + mod[b * NMOD + 4 * D + i]); cB[i] = mod[b * NMOD + 3 * D + i]; }
                    __syncthreads(); cur_b = b; }
                { const size_t row = (size_t)slot * 8 + wave;
                    const f32x4* xr = (const f32x4*)(x + row * D) + lane; const v2u* yr = (const v2u*)(Y + row * D) + lane;
                    f32x4 v[16]; v2u yv[16]; float sy = 0.f;
#pragma unroll
                    for (int j = 0; j < 16; ++j) { v[j] = xr[64 * j]; yv[j] = yr[64 * j]; }
#pragma unroll
                    for (int j = 0; j < 16; ++j) { const f32x4 y = {bf_lo(yv[j].x), bf_hi(yv[j].x), bf_lo(yv[j].y), bf_hi(yv[j].y)}; sy += dot4(y); }
                    const float rstdy = 1.0f / sqrtf(wave_sum(sy) * (1.0f / D) + RMS_EPS);
                    float s1 = 0.f; v2u* orow = (v2u*)(X1B + row * D) + lane;
#pragma unroll
                    for (int j = 0; j < 16; ++j) { const f32x4 y = {bf_lo(yv[j].x), bf_hi(yv[j].x), bf_lo(yv[j].y), bf_hi(yv[j].y)}; const f32x4 gq = ((const LAS f32x4*)cG)[lane + 64 * j];
                        v[j] = v[j] + gq * (y * rstdy); s1 += dot4(v[j]); v2u w; w.x = cvt_pk_bf16(v[j].x, v[j].y); w.y = cvt_pk_bf16(v[j].z, v[j].w); orow[64 * j] = w; }
                    const float rstd1 = 1.0f / sqrtf(wave_sum(s1) * (1.0f / D) + RMS_EPS);
                    v2u* o8 = (v2u*)(U + row * D) + lane;
#pragma unroll
                    for (int j = 0; j < 16; ++j) { const f32x4 a = ((const LAS f32x4*)cA)[lane + 64 * j], bb = ((const LAS f32x4*)cB)[lane + 64 * j]; const f32x4 o = v[j] * rstd1 * a + bb;
                        v2u w; w.x = cvt_pk_bf16(o.x, o.y); w.y = cvt_pk_bf16(o.z, o.w); o8[64 * j] = w; }
                }
            }
        }
        __syncthreads();
        {
            LAS float* scr = (LAS float*)(lds + wave * 16384);
            int itbase = 0;
            transpose_matrix<1>(w_gu, D, NGU, Wgu_t, D, 0, scr, lane, gw, NGW, itbase);
            if (((M / 256) * (NGU / 256)) % G == 0) transpose_matrix<0>(w_dn, DFF, D, Wdn_t, DFF, 0, scr, lane, gw, NGW, itbase);
        }
        if (BOTH(9)) GRID_BAR();
    }

    if (IN(10)) {
#define P10_BODY do { pg8::Gemm g{U, Wgu_t, M, NGU, D, D, D, 30}; pg8::StaticOrder S; S.init(M, NGU, G, bx); \
        pg8::EpiSwiglu E{H, DFF}; \
        pg8::gemm_phase<pg8::EpiSwiglu, pg8::StaticOrder, true, true>(lds + RING_OFF, g, S, E); } while (0)
        P10_BODY; if (DUP(10)) { P10_BODY; }
        { const int rem10 = ((M / 256) * (NGU / 256)) % G;
          if (rem10 != 0 && bx >= rem10) { LAS float* scr = (LAS float*)(lds + wave * 16384); int itbase = 0;
              transpose_matrix<0>(w_dn, DFF, D, Wdn_t, DFF, 0, scr, lane, (bx - rem10) * NWAVES + wave, (G - rem10) * NWAVES, itbase); } }
        if (BOTH(10)) GRID_BAR();
    }

    if (IN(11)) {
#define P11_BODY do { pg8::Gemm g{H, Wdn_t, M, D, DFF, DFF, DFF, 30}; pg8::StaticOrder S; S.init(M, D, G, bx); \
        pg8::EpiPlain E{Y2, D}; \
        pg8::gemm_phase<pg8::EpiPlain, pg8::StaticOrder, true, true>(lds + RING_OFF, g, S, E); } while (0)
        P11_BODY; if (DUP(11)) { P11_BODY; }
        if (BOTH(11)) GRID_BAR();
    }

    if (IN(12)) {
        LAS float* cG = (LAS float*)lds;
        int cur_b = -1;
        for (int slot = vcu; slot < M / 8; slot += G) {
            const int b = slot / (SEQ / 8);
            if (b != cur_b) { __syncthreads();
                for (int i = tid; i < D; i += NWAVES * 64) cG[i] = mod[b * NMOD + 5 * D + i] * g_ffn_post[i];
                __syncthreads(); cur_b = b; }
            { const size_t row = (size_t)slot * 8 + wave;
                f32x4* xr = (f32x4*)(out + row * D) + lane; const v2u* yr = (const v2u*)(Y2 + row * D) + lane; const v2u* x1r = (const v2u*)(X1B + row * D) + lane;
                f32x4 v[16]; v2u yv[16]; float sy = 0.f;
#pragma unroll
                for (int j = 0; j < 16; ++j) { const v2u q = x1r[64 * j]; v[j] = (f32x4){bf_lo(q.x), bf_hi(q.x), bf_lo(q.y), bf_hi(q.y)}; yv[j] = yr[64 * j]; }
#pragma unroll
                for (int j = 0; j < 16; ++j) { const f32x4 y = {bf_lo(yv[j].x), bf_hi(yv[j].x), bf_lo(yv[j].y), bf_hi(yv[j].y)}; sy += dot4(y); }
                const float rstdy = 1.0f / sqrtf(wave_sum(sy) * (1.0f / D) + RMS_EPS);
#pragma unroll
                for (int j = 0; j < 16; ++j) { const f32x4 y = {bf_lo(yv[j].x), bf_hi(yv[j].x), bf_lo(yv[j].y), bf_hi(yv[j].y)}; const f32x4 gq = ((const LAS f32x4*)cG)[lane + 64 * j];
                    xr[64 * j] = v[j] + gq * (y * rstdy); }
            }
        }
    }
#undef IN
#undef BOTH
#undef GRID_BAR
}

extern "C" void kernel_launch(void* const* d_in, const int* in_sizes, int n_in, void* d_out, int out_size, void* d_ws, size_t ws_size, hipStream_t stream) {
    static int grid = 0;
    if (grid == 0) {
        if (n_in != 23 || in_sizes[0] != M * D || out_size != M * D || ws_size < WS_END) {
            fprintf(stderr, "kernel_launch: built for 23 inputs, x/out of %d floats, >= %zu bytes of workspace; got n_in %d, in0 %d, out %d, ws %zu; nothing launched\n", M * D, (size_t)WS_END, n_in, n_in > 0 ? in_sizes[0] : -1, out_size, ws_size);
            grid = -1; return; }
        int dev = 0, cus = 0, per_cu = 0;
        if (hipGetDevice(&dev) != hipSuccess || hipDeviceGetAttribute(&cus, hipDeviceAttributeMultiprocessorCount, dev) != hipSuccess) { fprintf(stderr, "kernel_launch: device query failed\n"); grid = -1; return; }
        if (hipFuncSetAttribute((const void*)fwd_kernel, hipFuncAttributeMaxDynamicSharedMemorySize, LDS_BYTES) != hipSuccess) { fprintf(stderr, "kernel_launch: hipFuncSetAttribute failed\n"); grid = -1; return; }
        if (hipOccupancyMaxActiveBlocksPerMultiprocessor(&per_cu, (const void*)fwd_kernel, NWAVES * 64, LDS_BYTES) != hipSuccess || per_cu < 1)
            fprintf(stderr, "kernel_launch: note: occupancy query reports %d workgroups per CU\n", per_cu);
        (void)hipGetLastError();
        grid = cus;
    }
    if (grid < 0) return;
    if (hipMemsetAsync((char*)d_ws + WS_CTL, 0, CTL_ZERO_BYTES, stream) != hipSuccess) { fprintf(stderr, "kernel_launch: memset failed\n"); return; }
    Args a{};
    for (int i = 0; i < 23; ++i) a.in[i] = (const float*)d_in[i];
    a.out = (float*)d_out; a.ws = (unsigned char*)d_ws; a.pad = 0;
    for (int li = 0; li < N_LAUNCHES; ++li) {
        a.ph_lo = (N_LAUNCHES == NPH) ? li : (li * NPH) / N_LAUNCHES; a.ph_hi = (N_LAUNCHES == NPH) ? li + 1 : ((li + 1) * NPH) / N_LAUNCHES; a.li = li;
        hipLaunchKernelGGL(fwd_kernel, dim3(grid), dim3(NWAVES * 64), LDS_BYTES, stream, a);
        const hipError_t le = hipPeekAtLastError();
        if (le != hipSuccess) { fprintf(stderr, "kernel_launch: launch %d failed: %s\n", li, hipGetErrorName(le)); break; }
    }
}
```

```cpp
#include <hip/hip_runtime.h>
#include <cstdio>
#include <cstdint>

#ifndef MK_N_LAUNCHES
#define MK_N_LAUNCHES 1
#endif

namespace pg8 {
#define PG8_LAS __attribute__((address_space(3)))
typedef unsigned short bf16_t;
typedef short bf16x8 __attribute__((ext_vector_type(8)));
typedef float f32x4 __attribute__((ext_vector_type(4)));
typedef unsigned u32x4 __attribute__((ext_vector_type(4)));
typedef unsigned u32x2 __attribute__((ext_vector_type(2)));
typedef int i32x4 __attribute__((ext_vector_type(4)));
template <bool C, class A, class B> struct sel_t { typedef A type; };
template <class A, class B> struct sel_t<false, A, B> { typedef B type; };
constexpr int BM = 256, BK = 64, HALF = 128, HTB = HALF * BK * 2  , STAGE_BYTES = 8 * HTB, NXCD = 8, WGM = 8;

__host__ __device__ __forceinline__ int lds_byte(int r, int c) { const int st = (r >> 4) * 2 + (c >> 5), rr = r & 15, cc = c & 31, ob = rr * 64 + cc * 2; return st * 1024 + (ob ^ (((ob >> 9) & 1) << 5)); }
__host__ __device__ __forceinline__ void stage_rc(int b, int& R, int& C) { const int st = b / 1024, sb = b % 1024, swz = sb ^ (((sb >> 9) & 1) << 5); R = (st >> 1) * 16 + swz / 64; C = (st & 1) * 32 + (swz % 64) / 2; }
__host__ __device__ __forceinline__ int perm32(int rho) { const int n = rho >> 4, i = rho & 15; return 8 * (i >> 2) + 4 * n + (i & 3); }

struct Unit { int pm, pn; };
struct Gemm { const bf16_t* A; const bf16_t* Bt; int M, N, K, lda, ldb, agshift; };

struct StaticOrder {
    int nM, nN, nwg, G, c;
    __host__ __device__ void init(int M, int N, int G_, int c_) { nM = M / BM; nN = N / BM; nwg = nM * nN; G = G_; c = c_; }
    __host__ __device__ bool next(int i, Unit& u) const {
        const long L = (long)i * G + c; if (L >= nwg) return false;
        int wgid = (int)L; { const int q = nwg / NXCD, r = nwg % NXCD, xcd = wgid % NXCD, off = wgid / NXCD; wgid = (xcd < r ? xcd * (q + 1) : r * (q + 1) + (xcd - r) * q) + off; }
        const int nig = WGM * nN, gid = wgid / nig, fm = gid * WGM, gsz = (nM - fm) < WGM ? (nM - fm) : WGM;
        u.pm = fm + ((wgid % nig) % gsz); u.pn = (wgid % nig) / gsz; return true;
    }
    __device__ __forceinline__ void a_ready(const Unit&) const {}
    __device__ __forceinline__ void done(const Unit&) const {}
};
struct Grid16Order {
    int nM, nN, nwg, G, c;
    __host__ __device__ void init(int M, int N, int G_, int c_) { nM = M / BM; nN = N / BM; nwg = nM * nN; G = G_; c = c_; }
    __host__ __device__ bool next(int i, Unit& u) const {
        const int ncg = nN / 16; if (i >= (nM / 16) * ncg) return false;
        const int rg = i / ncg, cg = i % ncg, xcd = c % NXCD, j = c / NXCD;
        u.pm = rg * 16 + (xcd >> 2) * 8 + (j & 7); u.pn = cg * 16 + (xcd & 3) * 4 + (j >> 3); return true;
    }
    __device__ __forceinline__ void a_ready(const Unit&) const {}
    __device__ __forceinline__ void done(const Unit&) const {}
};

__device__ __forceinline__ unsigned cvt_pk_bf16(float lo, float hi) { unsigned r; asm volatile("v_cvt_pk_bf16_f32 %0, %1, %2" : "=v"(r) : "v"(lo), "v"(hi)); return r; }
__device__ __forceinline__ float bf_lo(unsigned w) { return __uint_as_float(w << 16); }
__device__ __forceinline__ float bf_hi(unsigned w) { return __uint_as_float(w & 0xffff0000u); }
__device__ __forceinline__ float fast_rcp(float x) { return __builtin_amdgcn_rcpf(x); }
__device__ __forceinline__ float fast_exp(float x) { return __builtin_amdgcn_exp2f(x * 1.44269504088896f); }
__device__ __forceinline__ float sigmoidf_(float x) { return fast_rcp(1.0f + fast_exp(-x)); }
__device__ __forceinline__ float siluf_(float x) { return x * sigmoidf_(x); }
__device__ __forceinline__ float gelu_tanh_(float x) { const float z = 1.5957691216057308f * (x + 0.044715f * x * x * x); return x * sigmoidf_(z); }

struct EpiPlain {
    static constexpr bool PERM = true, I8 = false;
    bf16_t* O; int ldc;
    __device__ __forceinline__ void operator()(const f32x4 (&acc)[2][2][4][2], const Unit& u, int wr, int wc, int fr, int fq) const {
        const int row0 = u.pm * BM + wr * 64 + fr, col0 = u.pn * BM + wc * 32 + 8 * fq;
#pragma unroll
        for (int ai = 0; ai < 2; ++ai)
#pragma unroll
            for (int m = 0; m < 4; ++m) { bf16_t* rowp = O + (size_t)(row0 + ai * HALF + m * 16) * ldc + col0;
#pragma unroll
                for (int bj = 0; bj < 2; ++bj) { const f32x4 v0 = acc[ai][bj][m][0], v1 = acc[ai][bj][m][1];
                    u32x4 w; w.x = cvt_pk_bf16(v0[0], v0[1]); w.y = cvt_pk_bf16(v0[2], v0[3]); w.z = cvt_pk_bf16(v1[0], v1[1]); w.w = cvt_pk_bf16(v1[2], v1[3]);
                    *(u32x4*)(rowp + bj * HALF) = w; } }
    }
};
struct EpiI8 {
    static constexpr bool PERM = true, I8 = true;
    bf16_t* O; int ldc; const float* rs; const float* cs;
    __device__ __forceinline__ void operator()(const i32x4 (&acc)[2][2][4][2], const Unit& u, int wr, int wc, int fr, int fq, const PG8_LAS float* sb) const {
        const int row0 = u.pm * BM + wr * 64 + fr, col0 = u.pn * BM + wc * 32 + 8 * fq;
        f32x4 sv[2][2];
#pragma unroll
        for (int bj = 0; bj < 2; ++bj)
#pragma unroll
            for (int n = 0; n < 2; ++n) sv[bj][n] = *(const PG8_LAS f32x4*)(sb + wc * 32 + 8 * fq + bj * HALF + 4 * n);
#pragma unroll
        for (int ai = 0; ai < 2; ++ai)
#pragma unroll
            for (int m = 0; m < 4; ++m) { const int row = row0 + ai * HALF + m * 16; const float r = sb[256 + wr * 64 + fr + ai * HALF + m * 16]; bf16_t* rowp = O + (size_t)row * ldc + col0;
#pragma unroll
                for (int bj = 0; bj < 2; ++bj) { const f32x4 v0 = __builtin_convertvector(acc[ai][bj][m][0], f32x4) * sv[bj][0] * r, v1 = __builtin_convertvector(acc[ai][bj][m][1], f32x4) * sv[bj][1] * r;
                    u32x4 w; w.x = cvt_pk_bf16(v0[0], v0[1]); w.y = cvt_pk_bf16(v0[2], v0[3]); w.z = cvt_pk_bf16(v1[0], v1[1]); w.w = cvt_pk_bf16(v1[2], v1[3]);
                    *(u32x4*)(rowp + bj * HALF) = w; } }
    }
};
struct EpiI8Silu {
    static constexpr bool PERM = true, I8 = true;
    bf16_t* O; int ldc; const float* rs; const float* cs;
    __device__ __forceinline__ void operator()(const i32x4 (&acc)[2][2][4][2], const Unit& u, int wr, int wc, int fr, int fq) const {
        const int row0 = u.pm * BM + wr * 64 + fr, col0 = u.pn * BM + wc * 32 + 8 * fq;
        f32x4 sv[2][2];
#pragma unroll
        for (int bj = 0; bj < 2; ++bj)
#pragma unroll
            for (int n = 0; n < 2; ++n) sv[bj][n] = *(const f32x4*)(cs + col0 + bj * HALF + 4 * n);
#pragma unroll
        for (int ai = 0; ai < 2; ++ai)
#pragma unroll
            for (int m = 0; m < 4; ++m) { const int row = row0 + ai * HALF + m * 16; const float r = rs[row]; bf16_t* rowp = O + (size_t)row * ldc + col0;
#pragma unroll
                for (int bj = 0; bj < 2; ++bj) { const f32x4 v0 = __builtin_convertvector(acc[ai][bj][m][0], f32x4) * sv[bj][0] * r, v1 = __builtin_convertvector(acc[ai][bj][m][1], f32x4) * sv[bj][1] * r;
                    u32x4 w; w.x = cvt_pk_bf16(siluf_(v0[0]), siluf_(v0[1])); w.y = cvt_pk_bf16(siluf_(v0[2]), siluf_(v0[3])); w.z = cvt_pk_bf16(siluf_(v1[0]), siluf_(v1[1])); w.w = cvt_pk_bf16(siluf_(v1[2]), siluf_(v1[3]));
                    *(u32x4*)(rowp + bj * HALF) = w; } }
    }
};
struct EpiI8Swiglu {
    static constexpr bool PERM = true, I8 = true;
    bf16_t* O; int ldc; const float* rs; const float* cs;
    __device__ __forceinline__ void operator()(const i32x4 (&acc)[2][2][4][2], const Unit& u, int wr, int wc, int fr, int fq, const PG8_LAS float* sb) const {
        const int row0 = u.pm * BM + wr * 64 + fr, col0 = u.pn * HALF + wc * 32 + 8 * fq, ccol0 = u.pn * BM + wc * 32 + 8 * fq;
        f32x4 sv[2][2];
#pragma unroll
        for (int bj = 0; bj < 2; ++bj)
#pragma unroll
            for (int n = 0; n < 2; ++n) sv[bj][n] = *(const PG8_LAS f32x4*)(sb + wc * 32 + 8 * fq + bj * HALF + 4 * n);
#pragma unroll
        for (int ai = 0; ai < 2; ++ai)
#pragma unroll
            for (int m = 0; m < 4; ++m) { const int row = row0 + ai * HALF + m * 16; const float r = sb[256 + wr * 64 + fr + ai * HALF + m * 16]; bf16_t* rowp = O + (size_t)row * ldc + col0;
                const f32x4 g0 = __builtin_convertvector(acc[ai][0][m][0], f32x4) * sv[0][0] * r, g1 = __builtin_convertvector(acc[ai][0][m][1], f32x4) * sv[0][1] * r;
                const f32x4 u0 = __builtin_convertvector(acc[ai][1][m][0], f32x4) * sv[1][0] * r, u1 = __builtin_convertvector(acc[ai][1][m][1], f32x4) * sv[1][1] * r;
                u32x4 w; w.x = cvt_pk_bf16(siluf_(g0[0]) * u0[0], siluf_(g0[1]) * u0[1]); w.y = cvt_pk_bf16(siluf_(g0[2]) * u0[2], siluf_(g0[3]) * u0[3]);
                w.z = cvt_pk_bf16(siluf_(g1[0]) * u1[0], siluf_(g1[1]) * u1[1]); w.w = cvt_pk_bf16(siluf_(g1[2]) * u1[2], siluf_(g1[3]) * u1[3]);
                *(u32x4*)rowp = w; }
    }
};
struct EpiMulPrev {
    static constexpr bool PERM = true, I8 = false;
    bf16_t* O; int ldc;
    __device__ __forceinline__ void operator()(const f32x4 (&acc)[2][2][4][2], const Unit& u, int wr, int wc, int fr, int fq) const {
        const int row0 = u.pm * BM + wr * 64 + fr, col0 = u.pn * BM + wc * 32 + 8 * fq;
#pragma unroll
        for (int ai = 0; ai < 2; ++ai) {
            u32x4 p[4][2];
#pragma unroll
            for (int m = 0; m < 4; ++m)
#pragma unroll
                for (int bj = 0; bj < 2; ++bj) p[m][bj] = *(const u32x4*)(O + (size_t)(row0 + ai * HALF + m * 16) * ldc + col0 + bj * HALF);
            asm volatile("" ::: "memory");
#pragma unroll
            for (int m = 0; m < 4; ++m) { bf16_t* rowp = O + (size_t)(row0 + ai * HALF + m * 16) * ldc + col0;
#pragma unroll
                for (int bj = 0; bj < 2; ++bj) { const u32x4 pp = p[m][bj]; const f32x4 v0 = acc[ai][bj][m][0], v1 = acc[ai][bj][m][1];
                    u32x4 w; w.x = cvt_pk_bf16(bf_lo(pp.x) * v0[0], bf_hi(pp.x) * v0[1]); w.y = cvt_pk_bf16(bf_lo(pp.y) * v0[2], bf_hi(pp.y) * v0[3]);
                    w.z = cvt_pk_bf16(bf_lo(pp.z) * v1[0], bf_hi(pp.z) * v1[1]); w.w = cvt_pk_bf16(bf_lo(pp.w) * v1[2], bf_hi(pp.w) * v1[3]);
                    *(u32x4*)(rowp + bj * HALF) = w; } }
            asm volatile("" ::: "memory");
        }
    }
};
struct EpiScale {
    static constexpr bool PERM = true, I8 = false;
    bf16_t* O; int ldc; const float* scale;
    __device__ __forceinline__ void operator()(const f32x4 (&acc)[2][2][4][2], const Unit& u, int wr, int wc, int fr, int fq) const {
        const int row0 = u.pm * BM + wr * 64 + fr, col0 = u.pn * BM + wc * 32 + 8 * fq;
        f32x4 sv[2][2];
#pragma unroll
        for (int bj = 0; bj < 2; ++bj)
#pragma unroll
            for (int n = 0; n < 2; ++n) sv[bj][n] = *(const f32x4*)(scale + col0 + bj * HALF + 4 * n);
#pragma unroll
        for (int ai = 0; ai < 2; ++ai)
#pragma unroll
            for (int m = 0; m < 4; ++m) { bf16_t* rowp = O + (size_t)(row0 + ai * HALF + m * 16) * ldc + col0;
#pragma unroll
                for (int bj = 0; bj < 2; ++bj) { const f32x4 v0 = acc[ai][bj][m][0] * sv[bj][0], v1 = acc[ai][bj][m][1] * sv[bj][1];
                    u32x4 w; w.x = cvt_pk_bf16(v0[0], v0[1]); w.y = cvt_pk_bf16(v0[2], v0[3]); w.z = cvt_pk_bf16(v1[0], v1[1]); w.w = cvt_pk_bf16(v1[2], v1[3]);
                    *(u32x4*)(rowp + bj * HALF) = w; } }
    }
};
struct EpiGateI8 {
    static constexpr bool PERM = true, I8 = true;
    bf16_t* O; int ldc; const bf16_t* Gt; int ldg; const float* rs; const float* cs;
    __device__ __forceinline__ void operator()(const i32x4 (&acc)[2][2][4][2], const Unit& u, int wr, int wc, int fr, int fq, const PG8_LAS float* sb) const {
        const int row0 = u.pm * BM + wr * 64 + fr, col0 = u.pn * BM + wc * 32 + 8 * fq;
        f32x4 sv[2][2];
#pragma unroll
        for (int bj = 0; bj < 2; ++bj)
#pragma unroll
            for (int n = 0; n < 2; ++n) sv[bj][n] = *(const PG8_LAS f32x4*)(sb + wc * 32 + 8 * fq + bj * HALF + 4 * n);
#pragma unroll
        for (int ai = 0; ai < 2; ++ai) {
            u32x4 g[4][2];
#pragma unroll
            for (int m = 0; m < 4; ++m) { const size_t row = (size_t)(row0 + ai * HALF + m * 16);
#pragma unroll
                for (int bj = 0; bj < 2; ++bj) g[m][bj] = *(const u32x4*)(Gt + row * ldg + col0 + bj * HALF); }
            asm volatile("" ::: "memory");
#pragma unroll
            for (int m = 0; m < 4; ++m) { const size_t row = (size_t)(row0 + ai * HALF + m * 16); bf16_t* rowp = O + row * ldc + col0; const float r = sb[256 + wr * 64 + fr + ai * HALF + m * 16];
#pragma unroll
                for (int bj = 0; bj < 2; ++bj) { const u32x4 gg = g[m][bj];
                    const f32x4 v0 = __builtin_convertvector(acc[ai][bj][m][0], f32x4) * sv[bj][0] * r, v1 = __builtin_convertvector(acc[ai][bj][m][1], f32x4) * sv[bj][1] * r;
                    float o[8];
                    o[0] = sigmoidf_(bf_lo(gg.x)) * v0[0]; o[1] = sigmoidf_(bf_hi(gg.x)) * v0[1]; o[2] = sigmoidf_(bf_lo(gg.y)) * v0[2]; o[3] = sigmoidf_(bf_hi(gg.y)) * v0[3];
                    o[4] = sigmoidf_(bf_lo(gg.z)) * v1[0]; o[5] = sigmoidf_(bf_hi(gg.z)) * v1[1]; o[6] = sigmoidf_(bf_lo(gg.w)) * v1[2]; o[7] = sigmoidf_(bf_hi(gg.w)) * v1[3];
                    u32x4 w; w.x = cvt_pk_bf16(o[0], o[1]); w.y = cvt_pk_bf16(o[2], o[3]); w.z = cvt_pk_bf16(o[4], o[5]); w.w = cvt_pk_bf16(o[6], o[7]);
                    *(u32x4*)(rowp + bj * HALF) = w; } }
            asm volatile("" ::: "memory");
        }
    }
};
template <bool ADD> struct EpiGate {
    static constexpr bool PERM = true, I8 = false;
    bf16_t* O; int ldc; const bf16_t* Gt; int ldg;
    __device__ __forceinline__ void operator()(const f32x4 (&acc)[2][2][4][2], const Unit& u, int wr, int wc, int fr, int fq) const {
        const int row0 = u.pm * BM + wr * 64 + fr, col0 = u.pn * BM + wc * 32 + 8 * fq;
#pragma unroll
        for (int ai = 0; ai < 2; ++ai) {
            u32x4 g[4][2], p[4][2];
#pragma unroll
            for (int m = 0; m < 4; ++m) { const size_t row = (size_t)(row0 + ai * HALF + m * 16);
#pragma unroll
                for (int bj = 0; bj < 2; ++bj) { g[m][bj] = *(const u32x4*)(Gt + row * ldg + col0 + bj * HALF); if (ADD) p[m][bj] = *(const u32x4*)(O + row * ldc + col0 + bj * HALF); } }
            asm volatile("" ::: "memory");
#pragma unroll
            for (int m = 0; m < 4; ++m) { const size_t row = (size_t)(row0 + ai * HALF + m * 16); bf16_t* rowp = O + row * ldc + col0;
#pragma unroll
                for (int bj = 0; bj < 2; ++bj) { const u32x4 gg = g[m][bj]; const f32x4 v0 = acc[ai][bj][m][0], v1 = acc[ai][bj][m][1];
                    float o[8];
                    o[0] = sigmoidf_(bf_lo(gg.x)) * v0[0]; o[1] = sigmoidf_(bf_hi(gg.x)) * v0[1]; o[2] = sigmoidf_(bf_lo(gg.y)) * v0[2]; o[3] = sigmoidf_(bf_hi(gg.y)) * v0[3];
                    o[4] = sigmoidf_(bf_lo(gg.z)) * v1[0]; o[5] = sigmoidf_(bf_hi(gg.z)) * v1[1]; o[6] = sigmoidf_(bf_lo(gg.w)) * v1[2]; o[7] = sigmoidf_(bf_hi(gg.w)) * v1[3];
                    if (ADD) { const u32x4 pp = p[m][bj];
                        o[0] += bf_lo(pp.x); o[1] += bf_hi(pp.x); o[2] += bf_lo(pp.y); o[3] += bf_hi(pp.y); o[4] += bf_lo(pp.z); o[5] += bf_hi(pp.z); o[6] += bf_lo(pp.w); o[7] += bf_hi(pp.w); }
                    u32x4 w; w.x = cvt_pk_bf16(o[0], o[1]); w.y = cvt_pk_bf16(o[2], o[3]); w.z = cvt_pk_bf16(o[4], o[5]); w.w = cvt_pk_bf16(o[6], o[7]);
                    *(u32x4*)(rowp + bj * HALF) = w; } }
            asm volatile("" ::: "memory");
        }
    }
};
struct EpiSwiglu {
    static constexpr bool PERM = true, I8 = false;
    bf16_t* O; int ldc;
    __device__ __forceinline__ void operator()(const f32x4 (&acc)[2][2][4][2], const Unit& u, int wr, int wc, int fr, int fq) const {
        const int row0 = u.pm * BM + wr * 64 + fr, col0 = u.pn * HALF + wc * 32 + 8 * fq;
#pragma unroll
        for (int ai = 0; ai < 2; ++ai)
#pragma unroll
            for (int m = 0; m < 4; ++m) { bf16_t* rowp = O + (size_t)(row0 + ai * HALF + m * 16) * ldc + col0;
                const f32x4 g0 = acc[ai][0][m][0], g1 = acc[ai][0][m][1], u0 = acc[ai][1][m][0], u1 = acc[ai][1][m][1];
                u32x4 w; w.x = cvt_pk_bf16(siluf_(g0[0]) * u0[0], siluf_(g0[1]) * u0[1]); w.y = cvt_pk_bf16(siluf_(g0[2]) * u0[2], siluf_(g0[3]) * u0[3]);
                w.z = cvt_pk_bf16(siluf_(g1[0]) * u1[0], siluf_(g1[1]) * u1[1]); w.w = cvt_pk_bf16(siluf_(g1[2]) * u1[2], siluf_(g1[3]) * u1[3]);
                *(u32x4*)rowp = w; }
    }
};
__device__ __forceinline__ f32x4 mma16(const bf16x8 a, const bf16x8 b, const f32x4 c) { return __builtin_amdgcn_mfma_f32_16x16x32_bf16(a, b, c, 0, 0, 0); }
__device__ __forceinline__ i32x4 mma16(const bf16x8 a, const bf16x8 b, const i32x4 c) { return __builtin_amdgcn_mfma_i32_16x16x64_i8(__builtin_bit_cast(i32x4, a), __builtin_bit_cast(i32x4, b), c, 0, 0, 0); }
constexpr int SCB_OFF = STAGE_BYTES + 1024;
__device__ __forceinline__ void stage_scales(PG8_LAS unsigned char* sb, const float* cs_tile, const float* rs_tile, int tid, int wid) {
    const float* src = (tid < 256) ? cs_tile + tid : rs_tile + (tid - 256);
    __builtin_amdgcn_global_load_lds((const unsigned*)src, (PG8_LAS unsigned*)(sb + wid * 256), 4, 0, 0);
}
template <class Epi, class Sched, bool ALIGN_EPI = false, bool SP2 = false>
__device__ __forceinline__ void gemm_phase(PG8_LAS unsigned char* lds, const Gemm g, const Sched& S, const Epi& E) {
    const int tid = threadIdx.x, wid = __builtin_amdgcn_readfirstlane(tid >> 6), lane = tid & 63, wr = wid >> 2, wc = wid & 3, fr = lane & 15, fq = lane >> 4;
    const int K = g.K, nt = K / BK;
    unsigned voffA[2], voffB[2];
#pragma unroll
    for (int i = 0; i < 2; ++i) { int R, C; stage_rc(tid * 16 + i * 8192, R, C); const int Rb = Epi::PERM ? ((R & ~31) + perm32(R & 31)) : R;
        voffA[i] = (unsigned)(R * g.lda + C) * 2u; voffB[i] = (unsigned)(Rb * g.ldb + C) * 2u; }
    const size_t kstep = (size_t)(BK * 2);
    const size_t hstepA = (size_t)HALF * g.lda * 2, hstepB = (size_t)HALF * g.ldb * 2;
    const size_t tstepA = 2 * hstepA, tstepB = 2 * hstepB;
    const unsigned ldsw = (unsigned)wid * 1024u;
    const int aoff = lds_byte(wr * 64 + fr, fq * 8), boff = lds_byte(wc * 32 + fr, fq * 8);
#define PG8_SA(b, h) (((b) * 2 + (h)) * HTB)
#define PG8_SB(b, h) ((4 + (b) * 2 + (h)) * HTB)
#define PG8_STAGE(bufoff, gbase, voff) do { _Pragma("unroll") for (int _i = 0; _i < 2; ++_i) \
        __builtin_amdgcn_global_load_lds((const unsigned*)((const char*)(gbase) + (voff)[_i]), (PG8_LAS unsigned*)(lds + (bufoff) + ldsw + _i * 8192), 16, 0, 0); } while (0)
#define PG8_LDA(dst, b, h) do { _Pragma("unroll") for (int m = 0; m < 4; ++m) _Pragma("unroll") for (int k = 0; k < 2; ++k) dst[m][k] = *(const PG8_LAS bf16x8*)(lds + PG8_SA(b, h) + aoff + m * 2048 + k * 1024); } while (0)
#define PG8_LDB(dst, b, h) do { _Pragma("unroll") for (int n = 0; n < 2; ++n) _Pragma("unroll") for (int k = 0; k < 2; ++k) dst[n][k] = *(const PG8_LAS bf16x8*)(lds + PG8_SB(b, h) + boff + n * 2048 + k * 1024); } while (0)
#define PG8_MMA(ai, bj, At, Bt) do { __builtin_amdgcn_s_setprio(1); _Pragma("unroll") for (int m = 0; m < 4; ++m) _Pragma("unroll") for (int n = 0; n < 2; ++n) _Pragma("unroll") for (int k = 0; k < 2; ++k) \
        acc[ai][bj][m][n] = mma16(Bt[n][k], At[m][k], acc[ai][bj][m][n]); __builtin_amdgcn_s_setprio(0); } while (0)
#define PG8_WAIT_V(n) asm volatile("s_waitcnt vmcnt(" #n ")" ::: "memory")
#define PG8_WAIT_L(n) asm volatile("s_waitcnt lgkmcnt(" #n ")" ::: "memory")
#define PG8_BAR __builtin_amdgcn_s_barrier()
#define PG8_SCHED __builtin_amdgcn_sched_barrier(0)
#define PG8_ABASE(u) ((const char*)g.A + (size_t)(u).pm * tstepA + (size_t)((u).pn >> g.agshift) * (size_t)K * 2)
#define PG8_BBASE(u) ((const char*)g.Bt + (size_t)(u).pn * tstepB)
    Unit cur, nxt; int ui = 0;
    if (!S.next(0, cur)) return;
    typedef typename sel_t<Epi::I8, i32x4, f32x4>::type acc_t;
    acc_t acc[2][2][4][2];
#pragma unroll
    for (int a = 0; a < 2; ++a)
#pragma unroll
        for (int b = 0; b < 2; ++b)
#pragma unroll
            for (int m = 0; m < 4; ++m)
#pragma unroll
                for (int n = 0; n < 2; ++n) acc[a][b][m][n] = acc_t{};
    bf16x8 At[4][2], B0[2][2], B1[2][2];
    const char* cA = PG8_ABASE(cur); const char* cB = PG8_BBASE(cur);
    S.a_ready(cur);
    if constexpr (Epi::I8) stage_scales(lds + SCB_OFF, E.cs + (size_t)cur.pn * BM, E.rs + (size_t)cur.pm * BM, tid, wid);
    if constexpr (SP2) {
        PG8_STAGE(PG8_SB(0, 0), cB, voffB); PG8_STAGE(PG8_SB(0, 1), cB + hstepB, voffB); PG8_STAGE(PG8_SA(0, 0), cA, voffA); PG8_STAGE(PG8_SA(0, 1), cA + hstepA, voffA);
        if (wr == 1) PG8_BAR;
        PG8_WAIT_V(2); PG8_BAR;
        PG8_STAGE(PG8_SB(1, 0), cB + kstep, voffB); PG8_STAGE(PG8_SA(1, 0), cA + kstep, voffA); PG8_STAGE(PG8_SB(1, 1), cB + hstepB + kstep, voffB);
        PG8_WAIT_V(6); PG8_BAR;
    } else {
        PG8_STAGE(PG8_SB(0, 0), cB, voffB); PG8_STAGE(PG8_SA(0, 0), cA, voffA); PG8_STAGE(PG8_SB(0, 1), cB + hstepB, voffB); PG8_STAGE(PG8_SA(0, 1), cA + hstepA, voffA);
        if (wr == 1) PG8_BAR;
        PG8_WAIT_V(4); PG8_BAR;
        PG8_STAGE(PG8_SB(1, 0), cB + kstep, voffB); PG8_STAGE(PG8_SA(1, 0), cA + kstep, voffA); PG8_STAGE(PG8_SB(1, 1), cB + hstepB + kstep, voffB);
        PG8_WAIT_V(6); PG8_BAR;
    }
    for (;;) {
        const bool has_next = S.next(ui + 1, nxt);
        const char* nA = has_next ? PG8_ABASE(nxt) : cA; const char* nB = has_next ? PG8_BBASE(nxt) : cB;
#pragma unroll 1
        for (int t = 0; t < nt; t += 2) {
            const bool last = (t == nt - 2);
            const char* a1 = cA + (size_t)(t + 1) * kstep;
            const char* a2 = last ? nA : cA + (size_t)(t + 2) * kstep; const char* b2 = last ? nB : cB + (size_t)(t + 2) * kstep;
            const char* a3 = a2 + kstep; const char* b3 = b2 + kstep;
            if (last && has_next) S.a_ready(nxt);
            if constexpr (SP2) {
            PG8_LDB(B0, 0, 0); PG8_LDB(B1, 0, 1); PG8_SCHED; PG8_LDA(At, 0, 0); PG8_STAGE(PG8_SA(1, 1), a1 + hstepA, voffA);
            PG8_WAIT_V(8); PG8_WAIT_L(0); PG8_BAR; PG8_MMA(0, 0, At, B0); PG8_MMA(0, 1, At, B1); PG8_BAR; PG8_SCHED;
            PG8_LDA(At, 0, 1); PG8_STAGE(PG8_SB(0, 0), b2, voffB); PG8_STAGE(PG8_SB(0, 1), b2 + hstepB, voffB); PG8_STAGE(PG8_SA(0, 0), a2, voffA);
            PG8_WAIT_V(8); PG8_WAIT_L(0); PG8_BAR; PG8_MMA(1, 0, At, B0); PG8_MMA(1, 1, At, B1); PG8_BAR; PG8_SCHED;
            PG8_LDB(B0, 1, 0); PG8_LDB(B1, 1, 1); PG8_SCHED; PG8_LDA(At, 1, 0); PG8_STAGE(PG8_SA(0, 1), a2 + hstepA, voffA);
            PG8_WAIT_V(8); PG8_WAIT_L(0); PG8_BAR; PG8_MMA(0, 0, At, B0); PG8_MMA(0, 1, At, B1); PG8_BAR; PG8_SCHED;
            PG8_LDA(At, 1, 1); PG8_STAGE(PG8_SB(1, 0), b3, voffB); PG8_STAGE(PG8_SB(1, 1), b3 + hstepB, voffB); PG8_STAGE(PG8_SA(1, 0), a3, voffA);
            PG8_WAIT_V(8); PG8_WAIT_L(0); PG8_BAR; PG8_MMA(1, 0, At, B0); PG8_MMA(1, 1, At, B1); PG8_BAR; PG8_SCHED;
            } else {
            PG8_LDB(B0, 0, 0); PG8_SCHED; PG8_LDA(At, 0, 0); PG8_STAGE(PG8_SA(1, 1), a1 + hstepA, voffA);
            PG8_WAIT_L(8); PG8_BAR; PG8_WAIT_L(0); PG8_MMA(0, 0, At, B0); PG8_BAR; PG8_SCHED;
            PG8_LDB(B1, 0, 1); PG8_STAGE(PG8_SB(0, 0), b2, voffB);
            PG8_BAR; PG8_WAIT_L(0); PG8_MMA(0, 1, At, B1); PG8_BAR;
            PG8_LDA(At, 0, 1); PG8_STAGE(PG8_SA(0, 0), a2, voffA);
            PG8_BAR; PG8_WAIT_L(0); PG8_MMA(1, 0, At, B0); PG8_BAR; PG8_SCHED;
            PG8_STAGE(PG8_SB(0, 1), b2 + hstepB, voffB);
            PG8_WAIT_V(6); PG8_BAR; PG8_MMA(1, 1, At, B1); PG8_BAR;
            PG8_LDB(B0, 1, 0); PG8_SCHED; PG8_LDA(At, 1, 0); PG8_STAGE(PG8_SA(0, 1), a2 + hstepA, voffA);
            PG8_WAIT_L(8); PG8_BAR; PG8_WAIT_L(0); PG8_MMA(0, 0, At, B0); PG8_BAR; PG8_SCHED;
            PG8_LDB(B1, 1, 1); PG8_STAGE(PG8_SB(1, 0), b3, voffB);
            PG8_BAR; PG8_WAIT_L(0); PG8_MMA(0, 1, At, B1); PG8_BAR;
            PG8_LDA(At, 1, 1); PG8_STAGE(PG8_SA(1, 0), a3, voffA);
            PG8_BAR; PG8_WAIT_L(0); PG8_MMA(1, 0, At, B0); PG8_BAR; PG8_SCHED;
            PG8_STAGE(PG8_SB(1, 1), b3 + hstepB, voffB);
            PG8_WAIT_V(6); PG8_BAR; PG8_MMA(1, 1, At, B1); PG8_BAR;
            }
        }
        if constexpr (ALIGN_EPI) { if (wr == 0) PG8_BAR; }
        if constexpr (Epi::I8) E(acc, cur, wr, wc, fr, fq, (const PG8_LAS float*)(lds + SCB_OFF + (ui & 1) * 2048)); else E(acc, cur, wr, wc, fr, fq);
        S.done(cur);
        if (!has_next) break;
#pragma unroll
        for (int a = 0; a < 2; ++a)
#pragma unroll
            for (int b = 0; b < 2; ++b)
#pragma unroll
                for (int m = 0; m < 4; ++m)
#pragma unroll
                    for (int n = 0; n < 2; ++n) acc[a][b][m][n] = acc_t{};
        cur = nxt; cA = nA; cB = nB; ++ui;
        if constexpr (Epi::I8) stage_scales(lds + SCB_OFF + (ui & 1) * 2048, E.cs + (size_t)cur.pn * BM, E.rs + (size_t)cur.pm * BM, tid, wid);
        if constexpr (ALIGN_EPI) { if (wr == 1) PG8_BAR; }
    }
    PG8_WAIT_V(0);
    if constexpr (!ALIGN_EPI) { if (wr == 0) PG8_BAR; }
    PG8_BAR;
#undef PG8_SA
#undef PG8_SB
#undef PG8_STAGE
#undef PG8_LDA
#undef PG8_LDB
#undef PG8_MMA
#undef PG8_WAIT_V
#undef PG8_WAIT_L
#undef PG8_BAR
#undef PG8_SCHED
#undef PG8_ABASE
#undef PG8_BBASE
}
}

constexpr int NWAVES = 8;
constexpr int N_LAUNCHES = MK_N_LAUNCHES;
constexpr int NPH = 13;
constexpr int BATCH = 2, SEQ = 8192, D = 4096, M = BATCH * SEQ;
constexpr int NIN = 5 * D;
constexpr int DFF = 11008, NGU = 2 * DFF;
constexpr int NMOD = 6 * D;
constexpr int HEADS = 16, HD = 256, PGRP = 4, PGD = 1024;
constexpr float RMS_EPS = 1e-6f;
constexpr int SCAN_T = 128, SCAN_NC = SEQ / SCAN_T;

constexpr size_t MiB = 1u << 20;
constexpr size_t WS_CTL = 0, CTL_ZERO_BYTES = 1 * MiB;
constexpr size_t WS_MOD = 1 * MiB;
constexpr size_t WS_SP8 = WS_MOD + 256 * 1024;
constexpr size_t WS_CP = WS_MOD + 512 * 1024;
constexpr size_t WS_WRG = 2 * MiB;
constexpr size_t WS_WPOOL = 6 * MiB;
constexpr size_t WS_WBL = 14 * MiB;
constexpr size_t WS_WBP = 46 * MiB;
constexpr size_t WS_WO = 78 * MiB;
constexpr size_t WS_WIN = 110 * MiB;
constexpr size_t WS_XC = 110 * MiB;
constexpr size_t WS_MERGED = 110 * MiB;
constexpr size_t WS_SCANC = 240 * MiB;
constexpr size_t WS_U = 270 * MiB;
constexpr size_t WS_POOLED = 270 * MiB;
constexpr size_t WS_PROJ = 398 * MiB;
constexpr size_t WS_WGU = 398 * MiB;
constexpr size_t WS_WDN = 570 * MiB;
constexpr size_t WS_H = 656 * MiB;
constexpr size_t WS_AU = 1038 * MiB;
constexpr size_t WS_Y = 1038 * MiB;
constexpr size_t WS_Y2 = 1166 * MiB;
constexpr size_t WS_YL = 1294 * MiB;
constexpr size_t WS_X1B = 1294 * MiB;
constexpr size_t WS_YP = 1422 * MiB;
constexpr size_t WS_END = 1550 * MiB;
static_assert(WS_WIN + (size_t)NIN * D * 2 <= WS_U && WS_SCANC + 4 * MiB <= WS_U && WS_XC + (size_t)M * D * 2 <= WS_SCANC, "ws map 1");
static_assert(WS_U + (size_t)M * D * 2 <= WS_PROJ && WS_PROJ + (size_t)M * NIN * 2 <= WS_AU, "ws map 2");
static_assert(WS_WGU + (size_t)NGU * D * 2 <= WS_WDN && WS_WDN + (size_t)D * DFF * 2 <= WS_H && WS_H + (size_t)M * DFF * 2 <= WS_AU, "ws map 3");
static_assert(WS_AU + (size_t)M * D * 4 <= WS_YL && WS_Y2 + (size_t)M * D * 2 <= WS_YL && WS_YP + (size_t)M * D * 2 <= WS_END, "ws map 4");
constexpr int CW_TMO = 0;
constexpr int CW_BAR = 4096;

constexpr int RING_OFF = 0, RING_BYTES = 131072;
constexpr int LDSCTL_OFF = RING_BYTES, MISC_OFF = LDSCTL_OFF + 320;
constexpr int LDS_BYTES = 147456;
static_assert(MISC_OFF + 128 <= LDS_BYTES, "LDS map");

#define GAS __attribute__((address_space(1)))
#define LAS __attribute__((address_space(3)))
typedef unsigned short bf16;
typedef unsigned v4u __attribute__((ext_vector_type(4)));
typedef unsigned v2u __attribute__((ext_vector_type(2)));
typedef float f32x4 __attribute__((ext_vector_type(4)));
typedef float f32x2 __attribute__((ext_vector_type(2)));
typedef GAS unsigned gu32;
#define RLX_AGENT __ATOMIC_RELAXED, __HIP_MEMORY_SCOPE_AGENT
#define LDS_WAIT() asm volatile("s_waitcnt lgkmcnt(0)" ::: "memory")
#define VM_WAIT() asm volatile("s_waitcnt vmcnt(0)" ::: "memory")
using pg8::cvt_pk_bf16; using pg8::bf_lo; using pg8::bf_hi;

#define XB_TMO      128
#define XB_XCNT(j)  (256  + 64 * (j))
#define XB_XSUB(j)  (1280 + 64 * (j))
#define XB_XGEN(j)  (2304 + 64 * (j))
#define XB_TOP      3328
#define XB_TOPGEN   3392
#define XCD_BAR_WORDS 3456
#define XB_SPIN_CAP (1u << 18)

__device__ __forceinline__ unsigned xb_ld(unsigned* p)              { return __hip_atomic_load(p, __ATOMIC_RELAXED, __HIP_MEMORY_SCOPE_AGENT); }
__device__ __forceinline__ unsigned xb_add(unsigned* p, unsigned v) { return __hip_atomic_fetch_add(p, v, __ATOMIC_RELAXED, __HIP_MEMORY_SCOPE_AGENT); }
__device__ __forceinline__ unsigned xb_xcc_id() { return (unsigned)__builtin_amdgcn_s_getreg((3 << 11) | 20) & 0xFu; }
#define XB_SPIN(cond, bar) do { unsigned _sp = 0; while (cond) { __builtin_amdgcn_s_sleep(1); \
    if ((++_sp & 255u) == 0u) { if (xb_ld(&(bar)[XB_TMO])) break; if (_sp > XB_SPIN_CAP) { atomicAdd(&(bar)[XB_TMO], 1u); break; } } } } while (0)

struct XcdBarrier {
    unsigned* bar; unsigned x;
    volatile LAS unsigned* st;
};
__device__ __forceinline__ XcdBarrier xcd_barrier_post(unsigned* bar, volatile LAS unsigned* st) {
    XcdBarrier b; b.bar = bar; b.x = xb_xcc_id(); b.st = st;
    if (threadIdx.x == 0) (void)xb_add(&bar[XB_XCNT(b.x)], 1u);
    return b;
}
__device__ __forceinline__ void xcd_barrier_complete(unsigned* bar, unsigned x, unsigned& nloc, unsigned& nx) {
    const unsigned G = gridDim.x * gridDim.y * gridDim.z;
    unsigned sum, cnt, mine, sp = 0u;
    for (;;) {
        sum = 0u; cnt = 0u; mine = 0u;
#pragma unroll
        for (unsigned j = 0; j < 16; ++j) { const unsigned c = xb_ld(&bar[XB_XCNT(j)]); sum += c; cnt += (c > 0u) ? 1u : 0u; mine = (j == x) ? c : mine; }
        if (sum == G) break;
        __builtin_amdgcn_s_sleep(1);
        if ((++sp & 255u) == 0u) { if (xb_ld(&bar[XB_TMO])) break; if (sp > XB_SPIN_CAP) { atomicAdd(&bar[XB_TMO], 1u); break; } }
    }
    nloc = mine > 0u ? mine : 1u; nx = cnt > 0u ? cnt : 1u;
}
__device__ __forceinline__ void xcd_barrier(const XcdBarrier& b) {
    asm volatile("s_waitcnt vmcnt(0)" ::: "memory");
    __syncthreads();
    if (threadIdx.x == 0) {
        unsigned* bar = b.bar;
        __builtin_amdgcn_s_waitcnt(0);
        unsigned nloc = b.st[0], nx = b.st[1];
        if (nloc == 0u) { xcd_barrier_complete(bar, b.x, nloc, nx); b.st[0] = nloc; b.st[1] = nx; }
        const unsigned old = xb_add(&bar[XB_XSUB(b.x)], 1u);
        const unsigned gen = old / nloc;
        if (old + 1u == (gen + 1u) * nloc) {
            __builtin_amdgcn_fence(__ATOMIC_RELEASE, "agent");
            asm volatile("s_waitcnt vmcnt(0)" ::: "memory");
            const unsigned og = xb_add(&bar[XB_TOP], 1u);
            const unsigned tg = og / nx;
            if (og + 1u == (tg + 1u) * nx) xb_add(&bar[XB_TOPGEN], 1u);
            else XB_SPIN(xb_ld(&bar[XB_TOPGEN]) == tg, bar);
            __builtin_amdgcn_fence(__ATOMIC_ACQUIRE, "agent");
            xb_add(&bar[XB_XGEN(b.x)], 1u);
            asm volatile("s_waitcnt vmcnt(0)" ::: "memory");
        } else {
            XB_SPIN(xb_ld(&bar[XB_XGEN(b.x)]) == gen, bar);
            __builtin_amdgcn_fence(__ATOMIC_ACQUIRE, "agent");
            asm volatile("s_waitcnt vmcnt(0)" ::: "memory");
        }
    }
    __syncthreads();
}

__device__ __forceinline__ float wave_sum(float v) {
#pragma unroll
    for (int o = 1; o < 64; o <<= 1) v += __shfl_xor(v, o);
    return v;
}
__device__ __forceinline__ float dot4(f32x4 a) { return (a.x * a.x + a.y * a.y) + (a.z * a.z + a.w * a.w); }

__device__ __forceinline__ void transpose_item(const float* W, int N, bf16* WT, int ldk, int k0, int n0, int drow0, LAS float* scr, int lane) {
#pragma unroll 8
    for (int i = 0; i < 32; ++i) { const int kk = 2 * i + (lane >> 5); scr[kk * 33 + (lane & 31)] = W[(size_t)(k0 + kk) * N + n0 + (lane & 31)]; }
    LDS_WAIT(); asm volatile("" ::: "memory");
    const int c = lane & 7;
#pragma unroll
    for (int j = 0; j < 4; ++j) { const int n = (lane >> 3) + 8 * j; const LAS float* s = scr + (8 * c) * 33 + n;
        v4u o;
        { o.x = cvt_pk_bf16(s[0 * 33], s[1 * 33]); o.y = cvt_pk_bf16(s[2 * 33], s[3 * 33]); o.z = cvt_pk_bf16(s[4 * 33], s[5 * 33]); o.w = cvt_pk_bf16(s[6 * 33], s[7 * 33]); }
        *(v4u*)(WT + (size_t)(drow0 + n) * ldk + k0 + 8 * c) = o; }
    LDS_WAIT(); asm volatile("" ::: "memory");
}
template <int DMAP>
__device__ __forceinline__ void transpose_matrix(const float* W, int K, int N, bf16* WT, int ldk, int drow_off, LAS float* scr, int lane, int gw, int NGW, int& itbase, int ncols = 0) {
    const int nblk = (ncols ? ncols : N) / 32, nitems = (K / 64) * nblk;
    int it = gw - (itbase % NGW); if (it < 0) it += NGW;
    for (; it < nitems; it += NGW) {
        const int kb = it / nblk, nb = it % nblk, n0 = 32 * nb;
        int drow;
        if (DMAP == 1) { const int isup = n0 >= DFF ? 1 : 0, j = n0 - isup * DFF; drow = (j >> 7) * 256 + isup * 128 + (j & 127); }
        else drow = n0;
        transpose_item(W, N, WT, ldk, 64 * kb, n0, drow_off + drow, scr, lane);
    }
    itbase += nitems;
}

__device__ __forceinline__ void unpack4(const v2u q, float (&f)[4]) { f[0] = bf_lo(q.x); f[1] = bf_hi(q.x); f[2] = bf_lo(q.y); f[3] = bf_hi(q.y); }
template <int W>
__device__ __forceinline__ void conv_pool_chunk(const bf16* PROJ, bf16* XC, bf16* POOLED, const float* conv_w, const float* conv_b, int chunk, int ch0) {
    float cw[4][4], cb[4];
#pragma unroll
    for (int k = 0; k < 4; ++k) { const f32x4 a = *(const f32x4*)(conv_w + k * D + ch0); cw[k][0] = a.x; cw[k][1] = a.y; cw[k][2] = a.z; cw[k][3] = a.w; }
    { const f32x4 a = *(const f32x4*)(conv_b + ch0); cb[0] = a.x; cb[1] = a.y; cb[2] = a.z; cb[3] = a.w; }
    const size_t row0 = (size_t)chunk * 64; const int t0 = (int)(row0 % SEQ);
    const bf16* pr = PROJ + row0 * NIN + ch0;
    float cx[4][4];
    v2u ph[W];
    float s[4];
#pragma unroll
    for (int j = 0; j < 4; ++j) s[j] = 0.f;
#pragma unroll
    for (int q = 0; q < 4; ++q)
#pragma unroll
        for (int j = 0; j < 4; ++j) cx[q][j] = 0.f;
#pragma unroll
    for (int q = 0; q < W; ++q) ph[q] = (v2u){0u, 0u};
    if (t0 > 0) {
#pragma unroll
        for (int q = 1; q <= 3; ++q) { const v2u x = *(const v2u*)(pr - (ptrdiff_t)q * NIN); unpack4(x, cx[(64 - q) & 3]); }
#pragma unroll
        for (int q = 1; q < W; ++q) { const v2u x = *(const v2u*)(pr + 2 * D - (ptrdiff_t)q * NIN); ph[(64 - q) & (W - 1)] = x; float f[4]; unpack4(x, f);
#pragma unroll
            for (int j = 0; j < 4; ++j) s[j] += f[j]; }
    }
    const bf16* p = pr; bf16* xo = XC + row0 * D + ch0; bf16* po = POOLED + row0 * D + ch0;
#pragma unroll 1
    for (int rb = 0; rb < 4; ++rb) {
#pragma unroll
        for (int h8 = 0; h8 < 2; ++h8) {
            v2u xnb[8], pnb[8];
#pragma unroll
            for (int q = 0; q < 8; ++q) { xnb[q] = *(const v2u*)(p + (size_t)q * NIN); pnb[q] = *(const v2u*)(p + (size_t)q * NIN + 2 * D); }
#pragma unroll
            for (int q = 0; q < 8; ++q) { const int rr = h8 * 8 + q; const int r = rb * 16 + rr;
                const v2u xn = xnb[q], pn = pnb[q];
                float xf[4]; unpack4(xn, xf);
                float a[4];
#pragma unroll
                for (int j = 0; j < 4; ++j) a[j] = cb[j] + cw[0][j] * cx[(rr + 1) & 3][j] + cw[1][j] * cx[(rr + 2) & 3][j] + cw[2][j] * cx[(rr + 3) & 3][j] + cw[3][j] * xf[j];
#pragma unroll
                for (int j = 0; j < 4; ++j) cx[rr & 3][j] = xf[j];
                { v2u o; o.x = cvt_pk_bf16(a[0], a[1]); o.y = cvt_pk_bf16(a[2], a[3]); *(v2u*)(xo + (size_t)q * D) = o; }
                float pf[4], of[4]; unpack4(pn, pf); unpack4(ph[rr & (W - 1)], of);
                ph[rr & (W - 1)] = pn;
                const int t = t0 + r; const int cnt = (t + 1 < W) ? (t + 1) : W; const float inv = 1.0f / (float)cnt;
#pragma unroll
                for (int j = 0; j < 4; ++j) { s[j] += pf[j] - of[j]; a[j] = s[j] * inv - pf[j]; }
                { v2u o; o.x = cvt_pk_bf16(a[0], a[1]); o.y = cvt_pk_bf16(a[2], a[3]); *(v2u*)(po + (size_t)q * D) = o; }
            }
            p += 8 * NIN; xo += 8 * D; po += 8 * D;
            asm volatile("" ::: "memory");
        }
    }
}

constexpr int RG_PITCH = 544;
template <int CTRL> __device__ __forceinline__ float dpp_row(float identity, float v) {
    return __int_as_float(__builtin_amdgcn_update_dpp(__float_as_int(identity), __float_as_int(v), CTRL, 0xf, 0xf, false)); }
constexpr int LRU_XOFF = 36864;
__device__ __forceinline__ void lru_fused(const bf16* XC, const bf16* Wrg_t, const bf16* PROJ, bf16* YL, const float* b_a, const float* b_x, const float* sp8,
                                          LAS unsigned char* lds, int tid, int lane, int wave, int vcu, int G) {
    typedef pg8::bf16x8 bf16x8;
    const int fr = lane & 15, fq = lane >> 4;
    for (int vq = vcu; vq < 256; vq += G) {
        const int h = vq >> 4, s = (vq >> 1) & 7, bsel = vq & 1;
        __syncthreads();
        { const int n = tid >> 3, p = tid & 7, chl = s * 32 + (n & 31), srow = h * 512 + (chl >> 7) * 256 + (n >> 5) * 128 + (chl & 127);
          const v4u* src = (const v4u*)(Wrg_t + (size_t)srow * HD + p * 32); LAS v4u* dst = (LAS v4u*)(lds + n * RG_PITCH + p * 64);
#pragma unroll
          for (int q = 0; q < 4; ++q) dst[q] = src[q]; }
        __syncthreads();
        const int c0 = h * HD + s * 32;
        f32x4 ba[2], bx[2], sp[2];
#pragma unroll
        for (int c2 = 0; c2 < 2; ++c2) { const int ch = c0 + 16 * c2 + 4 * fq; ba[c2] = *(const f32x4*)(b_a + ch); bx[c2] = *(const f32x4*)(b_x + ch); sp[c2] = *(const f32x4*)(sp8 + ch) * 1.44269504088896f; }
        const bf16* abase = XC + h * HD + 8 * fq; const bf16* xbase = XC + c0 + 4 * fq; const bf16* gbase = PROJ + D + c0 + 4 * fq; bf16* obase = YL + c0 + 4 * fq;
        const LAS unsigned char* bl = lds + fr * RG_PITCH + 16 * fq;
        LAS float* xch = (LAS float*)(lds + LRU_XOFF);
        bf16x8 af[2][8]; v2u xq[2][2], gq[2][2];
        { const size_t row0 = (size_t)bsel * SEQ + (size_t)wave * 32;
#pragma unroll
          for (int r2 = 0; r2 < 2; ++r2) { const size_t ro = (row0 + 16 * r2 + fr) * D, rg = (row0 + 16 * r2 + fr) * NIN;
#pragma unroll
              for (int kb = 0; kb < 8; ++kb) af[r2][kb] = *(const bf16x8*)(abase + ro + 32 * kb);
#pragma unroll
              for (int c2 = 0; c2 < 2; ++c2) { xq[r2][c2] = *(const v2u*)(xbase + ro + 16 * c2); gq[r2][c2] = *(const v2u*)(gbase + rg + 16 * c2); } } }
#pragma unroll 1
        for (int i = 0; i < SEQ / 256; ++i) {
            const size_t row0 = (size_t)bsel * SEQ + (size_t)i * 256 + (size_t)wave * 32;
            f32x4 acc[2][4];
#pragma unroll
            for (int r2 = 0; r2 < 2; ++r2)
#pragma unroll
                for (int cb = 0; cb < 4; ++cb) acc[r2][cb] = (f32x4){0.f, 0.f, 0.f, 0.f};
            {
                bf16x8 bq[2][4];
#pragma unroll
                for (int cb = 0; cb < 4; ++cb) bq[0][cb] = *(const LAS bf16x8*)(bl + cb * 16 * RG_PITCH);
#pragma unroll
                for (int kb = 0; kb < 8; ++kb) {
                    if (kb + 1 < 8) {
#pragma unroll
                        for (int cb = 0; cb < 4; ++cb) bq[(kb + 1) & 1][cb] = *(const LAS bf16x8*)(bl + cb * 16 * RG_PITCH + (kb + 1) * 64); }
                    __builtin_amdgcn_sched_barrier(0);
#pragma unroll
                    for (int cb = 0; cb < 4; ++cb)
#pragma unroll
                        for (int r2 = 0; r2 < 2; ++r2) acc[r2][cb] = __builtin_amdgcn_mfma_f32_16x16x32_bf16(bq[kb & 1][cb], af[r2][kb], acc[r2][cb], 0, 0, 0);
                    __builtin_amdgcn_sched_barrier(0);
                }
            }
            v2u xqn[2][2], gqn[2][2];
            { const size_t rown = (i + 1 < SEQ / 256) ? row0 + 256 : row0;
#pragma unroll
                for (int r2 = 0; r2 < 2; ++r2) { const size_t ro = (rown + 16 * r2 + fr) * D, rg = (rown + 16 * r2 + fr) * NIN;
#pragma unroll
                    for (int kb = 0; kb < 8; ++kb) af[r2][kb] = *(const bf16x8*)(abase + ro + 32 * kb);
#pragma unroll
                    for (int c2 = 0; c2 < 2; ++c2) { xqn[r2][c2] = *(const v2u*)(xbase + ro + 16 * c2); gqn[r2][c2] = *(const v2u*)(gbase + rg + 16 * c2); } } }
            float A[2][2][4], U[2][2][4];
#pragma unroll
            for (int r2 = 0; r2 < 2; ++r2)
#pragma unroll
                for (int c2 = 0; c2 < 2; ++c2) { const f32x4 rp = acc[r2][c2] + ba[c2], ip = acc[r2][c2 + 2] + bx[c2]; const v2u xw = xq[r2][c2];
                    const float xv[4] = {bf_lo(xw.x), bf_hi(xw.x), bf_lo(xw.y), bf_hi(xw.y)};
#pragma unroll
                    for (int j = 0; j < 4; ++j) { const float r = pg8::sigmoidf_(rp[j]), ig = pg8::sigmoidf_(ip[j]);
                        const float av = __builtin_amdgcn_exp2f(sp[c2][j] * r);
                        A[r2][c2][j] = av; U[r2][c2][j] = __builtin_amdgcn_sqrtf(fmaxf(__builtin_fmaf(-av, av, 1.0f), 0.0f)) * (ig * xv[j]); } }
#define LRU_STEP(d) \
                        "v_fmac_f32_dpp %4, %4, %0 row_shr:" #d " row_mask:0xf bank_mask:0xf\n\tv_mul_f32_dpp %0, %0, %0 row_shr:" #d " row_mask:0xf bank_mask:0xf\n\t" \
                        "v_fmac_f32_dpp %5, %5, %1 row_shr:" #d " row_mask:0xf bank_mask:0xf\n\tv_mul_f32_dpp %1, %1, %1 row_shr:" #d " row_mask:0xf bank_mask:0xf\n\t" \
                        "v_fmac_f32_dpp %6, %6, %2 row_shr:" #d " row_mask:0xf bank_mask:0xf\n\tv_mul_f32_dpp %2, %2, %2 row_shr:" #d " row_mask:0xf bank_mask:0xf\n\t" \
                        "v_fmac_f32_dpp %7, %7, %3 row_shr:" #d " row_mask:0xf bank_mask:0xf\n\tv_mul_f32_dpp %3, %3, %3 row_shr:" #d " row_mask:0xf bank_mask:0xf\n\t"
#pragma unroll
            for (int r2 = 0; r2 < 2; ++r2)
#pragma unroll
                for (int c2 = 0; c2 < 2; ++c2)
                    asm volatile("s_nop 1\n\t" LRU_STEP(1) LRU_STEP(2) LRU_STEP(4) LRU_STEP(8)
                                 : "+v"(A[r2][c2][0]), "+v"(A[r2][c2][1]), "+v"(A[r2][c2][2]), "+v"(A[r2][c2][3]), "+v"(U[r2][c2][0]), "+v"(U[r2][c2][1]), "+v"(U[r2][c2][2]), "+v"(U[r2][c2][3]));
#undef LRU_STEP
            const int l15 = (lane & 48) | 15;
#pragma unroll
            for (int c2 = 0; c2 < 2; ++c2)
#pragma unroll
                for (int j = 0; j < 4; ++j) { const float a15 = __shfl(A[0][c2][j], l15), u15 = __shfl(U[0][c2][j], l15);
                    U[1][c2][j] = A[1][c2][j] * u15 + U[1][c2][j]; A[1][c2][j] = A[1][c2][j] * a15; }
            LAS float* xp = xch + (i & 1) * 512;
            if (fr == 15) {
#pragma unroll
                for (int c2 = 0; c2 < 2; ++c2) { *(LAS f32x4*)(xp + wave * 32 + 16 * c2 + 4 * fq) = (f32x4){A[1][c2][0], A[1][c2][1], A[1][c2][2], A[1][c2][3]};
                    *(LAS f32x4*)(xp + 256 + wave * 32 + 16 * c2 + 4 * fq) = (f32x4){U[1][c2][0], U[1][c2][1], U[1][c2][2], U[1][c2][3]}; } }
            asm volatile("s_waitcnt lgkmcnt(0)" ::: "memory"); __builtin_amdgcn_s_barrier(); asm volatile("" ::: "memory");
            LAS float* cinp = xch + 1024 + (i & 1) * 32;
            f32x4 hin[2];
#pragma unroll
            for (int c2 = 0; c2 < 2; ++c2) hin[c2] = (i == 0) ? (f32x4){0.f, 0.f, 0.f, 0.f} : *(const LAS f32x4*)(cinp + 16 * c2 + 4 * fq);
#pragma unroll
            for (int w = 0; w < NWAVES - 1; ++w) if (w < wave) {
#pragma unroll
                for (int c2 = 0; c2 < 2; ++c2) { const f32x4 P = *(const LAS f32x4*)(xp + w * 32 + 16 * c2 + 4 * fq), Hh = *(const LAS f32x4*)(xp + 256 + w * 32 + 16 * c2 + 4 * fq);
                    hin[c2] = P * hin[c2] + Hh; } }
            if (wave == NWAVES - 1 && fr == 0) {
                LAS float* cout = xch + 1024 + ((i + 1) & 1) * 32;
#pragma unroll
                for (int c2 = 0; c2 < 2; ++c2) { const f32x4 P = *(const LAS f32x4*)(xp + (NWAVES - 1) * 32 + 16 * c2 + 4 * fq), Hh = *(const LAS f32x4*)(xp + 256 + (NWAVES - 1) * 32 + 16 * c2 + 4 * fq);
                    *(LAS f32x4*)(cout + 16 * c2 + 4 * fq) = P * hin[c2] + Hh; } }
#pragma unroll
            for (int r2 = 0; r2 < 2; ++r2) { const size_t ro = (row0 + 16 * r2 + fr) * D;
#pragma unroll
                for (int c2 = 0; c2 < 2; ++c2) { const v2u gw = gq[r2][c2]; const float gg[4] = {bf_lo(gw.x), bf_hi(gw.x), bf_lo(gw.y), bf_hi(gw.y)}; float y[4];
#pragma unroll
                    for (int j = 0; j < 4; ++j) { const float hh = U[r2][c2][j] + A[r2][c2][j] * hin[c2][j]; const float gx = gg[j], gz = gx * __builtin_fmaf(gx * gx, -0.10294324f, -2.30220819f);
                        y[j] = hh * gx * pg8::fast_rcp(1.0f + __builtin_amdgcn_exp2f(gz)); }
                    v2u o; o.x = cvt_pk_bf16(y[0], y[1]); o.y = cvt_pk_bf16(y[2], y[3]); *(v2u*)(obase + ro + 16 * c2) = o; } }
#pragma unroll
            for (int r2 = 0; r2 < 2; ++r2)
#pragma unroll
                for (int c2 = 0; c2 < 2; ++c2) { xq[r2][c2] = xqn[r2][c2]; gq[r2][c2] = gqn[r2][c2]; }
        }
    }
    __syncthreads();
}

__device__ __forceinline__ unsigned q8(float v, float inv) { const float q = fminf(fmaxf(__builtin_rintf(v * inv), -127.f), 127.f); return (unsigned)(int)q & 0xffu; }
__device__ __forceinline__ unsigned pack_q8(float a, float b, float c, float d, float inv) { return q8(a, inv) | (q8(b, inv) << 8) | (q8(c, inv) << 16) | (q8(d, inv) << 24); }
template <int CTRL, int BANK, bool BC> __device__ __forceinline__ float dpp_mov(float old, float src) {
    return __builtin_bit_cast(float, __builtin_amdgcn_update_dpp(__builtin_bit_cast(int, old), __builtin_bit_cast(int, src), CTRL, 0xF, BANK, BC)); }
__device__ __forceinline__ float xlane1(float t) { return dpp_mov<0xB1, 0xF, true>(0.f, t); }
__device__ __forceinline__ float xlane2(float t) { return dpp_mov<0x4E, 0xF, true>(0.f, t); }
__device__ __forceinline__ float xlane4(float t) { const float r = dpp_mov<0x104, 0x5, false>(t, t); return dpp_mov<0x114, 0xA, false>(r, t); }
__device__ __forceinline__ float xlane8(float t) { return dpp_mov<0x128, 0xF, true>(0.f, t); }
struct RotSigns { float s1, s2, s4, s8; };
__device__ __forceinline__ RotSigns rot_signs(int lane) { return RotSigns{(lane & 1) ? -1.f : 1.f, (lane & 2) ? -1.f : 1.f, (lane & 4) ? -1.f : 1.f, (lane & 8) ? -1.f : 1.f}; }
__device__ __forceinline__ f32x4 rot64(f32x4 t, const RotSigns sg) {
    { const float p0 = t.x + t.y, p1 = t.x - t.y, p2 = t.z + t.w, p3 = t.z - t.w; t = (f32x4){p0 + p2, p1 + p3, p0 - p2, p1 - p3}; }
    t = (f32x4){__builtin_fmaf(sg.s1, t.x, xlane1(t.x)), __builtin_fmaf(sg.s1, t.y, xlane1(t.y)), __builtin_fmaf(sg.s1, t.z, xlane1(t.z)), __builtin_fmaf(sg.s1, t.w, xlane1(t.w))};
    t = (f32x4){__builtin_fmaf(sg.s2, t.x, xlane2(t.x)), __builtin_fmaf(sg.s2, t.y, xlane2(t.y)), __builtin_fmaf(sg.s2, t.z, xlane2(t.z)), __builtin_fmaf(sg.s2, t.w, xlane2(t.w))};
    t = (f32x4){__builtin_fmaf(sg.s4, t.x, xlane4(t.x)), __builtin_fmaf(sg.s4, t.y, xlane4(t.y)), __builtin_fmaf(sg.s4, t.z, xlane4(t.z)), __builtin_fmaf(sg.s4, t.w, xlane4(t.w))};
    t = (f32x4){__builtin_fmaf(sg.s8, t.x, xlane8(t.x)), __builtin_fmaf(sg.s8, t.y, xlane8(t.y)), __builtin_fmaf(sg.s8, t.z, xlane8(t.z)), __builtin_fmaf(sg.s8, t.w, xlane8(t.w))};
    return t * 0.125f;
}
__device__ __forceinline__ unsigned pack_q8m(float a, float b, float c, float d, float inv) {
    const unsigned ua = __float_as_uint(__builtin_fmaf(a, inv, 12582912.0f)), ub = __float_as_uint(__builtin_fmaf(b, inv, 12582912.0f));
    const unsigned uc = __float_as_uint(__builtin_fmaf(c, inv, 12582912.0f)), ud = __float_as_uint(__builtin_fmaf(d, inv, 12582912.0f));
    return __builtin_amdgcn_perm(__builtin_amdgcn_perm(ud, uc, 0x0c0c0400u), __builtin_amdgcn_perm(ub, ua, 0x0c0c0400u), 0x05040100u);
}
__device__ __forceinline__ void rotq_row(f32x4 (&v)[16], unsigned* q8row, float* rsp, int lane) {
    float am = 0.f; const RotSigns sg = rot_signs(lane);
#pragma unroll
    for (int j = 0; j < 16; ++j) { v[j] = rot64(v[j], sg);
        am = fmaxf(fmaxf(am, fmaxf(fabsf(v[j].x), fabsf(v[j].y))), fmaxf(fabsf(v[j].z), fabsf(v[j].w))); }
#pragma unroll
    for (int o = 1; o < 64; o <<= 1) am = fmaxf(am, __shfl_xor(am, o));
    am = fmaxf(am, 1e-30f); const float qi = 127.0f / am;
#pragma unroll
    for (int j = 0; j < 16; ++j) q8row[lane + 64 * j] = pack_q8m(v[j].x, v[j].y, v[j].z, v[j].w, qi);
    if (lane == 0) *rsp = am * (1.0f / 127.0f);
}
__device__ __forceinline__ void transpose_item_rot(const float* W, int ld, bf16* WT, int ldk, int k0, int n0, int drow0, LAS float* scr, int lane, unsigned* cmax, int cidx0) {
#pragma unroll 8
    for (int i = 0; i < 32; ++i) { const int kk = 2 * i + (lane >> 5); scr[kk * 33 + (lane & 31)] = W[(size_t)(k0 + kk) * ld + n0 + (lane & 31)]; }
    LDS_WAIT(); asm volatile("" ::: "memory");
    const int nn = lane & 31, hf = lane >> 5;
#pragma unroll
    for (int b = 0; b < 6; ++b) {
#pragma unroll
        for (int i = 0; i < 16; ++i) { const int p = hf * 16 + i, lo = ((p >> b) << (b + 1)) | (p & ((1 << b) - 1)), hi = lo | (1 << b);
            const float xl = scr[lo * 33 + nn], xh = scr[hi * 33 + nn]; scr[lo * 33 + nn] = xl + xh; scr[hi * 33 + nn] = xl - xh; }
        LDS_WAIT(); asm volatile("" ::: "memory");
    }
    float am = 0.f;
#pragma unroll
    for (int i = 0; i < 32; ++i) am = fmaxf(am, fabsf(scr[(hf * 32 + i) * 33 + nn]));
    atomicMax(cmax + cidx0 + nn, __float_as_uint(am * 0.125f));
    const int c = lane & 7;
#pragma unroll
    for (int j = 0; j < 4; ++j) { const int n = (lane >> 3) + 8 * j; const LAS float* sp = scr + (8 * c) * 33 + n;
        v4u o; o.x = cvt_pk_bf16(sp[0 * 33] * 0.125f, sp[1 * 33] * 0.125f); o.y = cvt_pk_bf16(sp[2 * 33] * 0.125f, sp[3 * 33] * 0.125f);
        o.z = cvt_pk_bf16(sp[4 * 33] * 0.125f, sp[5 * 33] * 0.125f); o.w = cvt_pk_bf16(sp[6 * 33] * 0.125f, sp[7 * 33] * 0.125f);
        *(v4u*)(WT + (size_t)(drow0 + n) * ldk + k0 + 8 * c) = o; }
    LDS_WAIT(); asm volatile("" ::: "memory");
}

struct RotItem { int k0, n0, drow0; };
__device__ __forceinline__ void rot_load(float (&v)[32], const float* W, int ld, const RotItem r, int lane) {
    const float* wp = W + (size_t)(r.k0 + 32 * (lane >> 5)) * ld + r.n0 + (lane & 31);
#pragma unroll
    for (int i = 0; i < 32; ++i) v[i] = wp[(size_t)i * ld];
}
__device__ __forceinline__ void rot_finish(float (&v)[32], bf16* WT, int ldk, const RotItem r, LAS float* scr, int lane, unsigned* cmax) {
    const int nn = lane & 31, hf = lane >> 5;
#pragma unroll
    for (int b = 0; b < 5; ++b)
#pragma unroll
        for (int i = 0; i < 32; ++i) if (!(i & (1 << b))) { const float lo = v[i], hi = v[i | (1 << b)]; v[i] = lo + hi; v[i | (1 << b)] = lo - hi; }
    const float sg = hf ? -0.125f : 0.125f; float am = 0.f;
#pragma unroll
    for (int i = 0; i < 32; ++i) { const float pr = __shfl_xor(v[i], 32); v[i] = __builtin_fmaf(v[i], sg, pr * 0.125f); am = fmaxf(am, fabsf(v[i])); }
    am = fmaxf(am, __shfl_xor(am, 32));
    if (hf == 0) atomicMax(cmax + r.drow0 + nn, __float_as_uint(am));
#pragma unroll
    for (int i = 0; i < 32; ++i) scr[(32 * hf + i) * 33 + nn] = v[i];
    LDS_WAIT(); asm volatile("" ::: "memory");
    const int c = lane & 7;
#pragma unroll
    for (int j = 0; j < 4; ++j) { const int n = (lane >> 3) + 8 * j; const LAS float* sp = scr + (8 * c) * 33 + n;
        v4u o; o.x = cvt_pk_bf16(sp[0 * 33], sp[1 * 33]); o.y = cvt_pk_bf16(sp[2 * 33], sp[3 * 33]);
        o.z = cvt_pk_bf16(sp[4 * 33], sp[5 * 33]); o.w = cvt_pk_bf16(sp[6 * 33], sp[7 * 33]);
        *(v4u*)(WT + (size_t)(r.drow0 + n) * ldk + r.k0 + 8 * c) = o; }
    LDS_WAIT(); asm volatile("" ::: "memory");
}
template <class MapF>
__device__ __forceinline__ void rot_stream(const float* W, int ld, bf16* WT, int ldk, LAS float* scr, int lane, unsigned* cmax, int it, int nitems, int stride, const MapF map) {
    if (it >= nitems) return;
    float va[32], vb[32]; RotItem ra = map(it), rb = ra;
    rot_load(va, W, ld, ra, lane);
#pragma unroll 1
    while (true) {
        const int itb = it + stride; const bool hb = itb < nitems;
        if (hb) { rb = map(itb); rot_load(vb, W, ld, rb, lane); }
        rot_finish(va, WT, ldk, ra, scr, lane, cmax);
        if (!hb) break;
        it = itb + stride; const bool ha = it < nitems;
        if (ha) { ra = map(it); rot_load(va, W, ld, ra, lane); }
        rot_finish(vb, WT, ldk, rb, scr, lane, cmax);
        if (!ha) break;
    }
}
constexpr int QC0 = 2 * D, NQ = NIN - QC0;
struct MapGate { __device__ __forceinline__ RotItem operator()(int it) const { const int nblk = NQ / 32, kb = it / nblk, nb = it % nblk; return RotItem{64 * kb, 32 * nb, QC0 + 32 * nb}; } };
struct MapGU { __device__ __forceinline__ RotItem operator()(int it) const { const int nblk = NGU / 32, kb = it / nblk, nb = it % nblk, n0 = 32 * nb, isup = n0 >= DFF ? 1 : 0, j = n0 - isup * DFF;
    return RotItem{64 * kb, n0, (j >> 7) * 256 + isup * 128 + (j & 127)}; } };
struct MapDn { __device__ __forceinline__ RotItem operator()(int it) const { const int nblk = D / 32, kb = it / nblk, nb = it % nblk; return RotItem{64 * kb, 32 * nb, 32 * nb}; } };

template <class MapF>
__device__ __forceinline__ void strip_quant(const float* W, int ldw, unsigned char* W8o, float* cso, int nstrips, int s0, int sstride, LAS unsigned char* lds, int lane, int wave, const MapF map) {
    LAS unsigned char* sbuf = lds; LAS float* red = (LAS float*)(lds + RING_BYTES + 8192);
    const int nn = lane & 15, kh = lane >> 4;
    const float s16 = (kh & 1) ? -1.f : 1.f, s32 = (kh & 2) ? -0.125f : 0.125f;
    float va[16], vb[16];
    if (s0 >= nstrips) return;
    int n0, drow0; map(s0, n0, drow0);
    const float* wp = W + (size_t)(512 * wave + 16 * kh) * ldw + n0 + nn;
#pragma unroll
    for (int i = 0; i < 16; ++i) va[i] = wp[(size_t)i * ldw];
    for (int strip = s0; strip < nstrips; strip += sstride) {
        float cm = 0.f;
#define SQ_LOAD(v, blk) do { _Pragma("unroll") for (int i = 0; i < 16; ++i) v[i] = wp[(size_t)(64 * (blk) + i) * ldw]; } while (0)
#define SQ_FIN(v, blk) do { \
        _Pragma("unroll") for (int b = 0; b < 4; ++b) _Pragma("unroll") for (int i = 0; i < 16; ++i) if (!(i & (1 << b))) { const float lo_ = v[i], hi_ = v[i | (1 << b)]; v[i] = lo_ + hi_; v[i | (1 << b)] = lo_ - hi_; } \
        _Pragma("unroll") for (int i = 0; i < 16; ++i) { const float pr_ = __shfl_xor(v[i], 16); v[i] = __builtin_fmaf(v[i], s16, pr_); } \
        _Pragma("unroll") for (int i = 0; i < 16; ++i) { const float pr_ = __shfl_xor(v[i], 32); v[i] = __builtin_fmaf(v[i], s32, pr_ * 0.125f); cm = fmaxf(cm, fabsf(v[i])); } \
        v4u p0_, p1_; p0_.x = cvt_pk_bf16(v[0], v[1]); p0_.y = cvt_pk_bf16(v[2], v[3]); p0_.z = cvt_pk_bf16(v[4], v[5]); p0_.w = cvt_pk_bf16(v[6], v[7]); \
        p1_.x = cvt_pk_bf16(v[8], v[9]); p1_.y = cvt_pk_bf16(v[10], v[11]); p1_.z = cvt_pk_bf16(v[12], v[13]); p1_.w = cvt_pk_bf16(v[14], v[15]); \
        LAS v4u* d_ = (LAS v4u*)(sbuf + (size_t)(((32 * wave + 4 * (blk) + kh) * 16 + nn) * 32)); d_[0] = p0_; d_[1] = p1_; } while (0)
#pragma unroll 1
        for (int blk = 0; blk < 8; blk += 2) {
            SQ_LOAD(vb, blk + 1);
            SQ_FIN(va, blk);
            if (blk + 2 < 8) SQ_LOAD(va, blk + 2);
            SQ_FIN(vb, blk + 1);
        }
        cm = fmaxf(cm, __shfl_xor(cm, 16)); cm = fmaxf(cm, __shfl_xor(cm, 32));
        if (kh == 0) red[wave * 16 + nn] = cm;
        const int drow_cur = drow0;
        if (strip + sstride < nstrips) { map(strip + sstride, n0, drow0); wp = W + (size_t)(512 * wave + 16 * kh) * ldw + n0 + nn;
#pragma unroll
            for (int i = 0; i < 16; ++i) va[i] = wp[(size_t)i * ldw]; }
        __syncthreads();
        { const int c = lane & 15, kk = lane >> 4;
          float m = 0.f;
#pragma unroll
          for (int w = 0; w < 8; ++w) m = fmaxf(m, red[w * 16 + c]);
          m = fmaxf(m, 1e-30f); const float inv = 127.0f / m;
          unsigned char* orow = W8o + (size_t)(drow_cur + c) * D;
#pragma unroll
          for (int q = 0; q < 8; ++q) { const int k16 = 32 * wave + 4 * q + kk; const LAS v4u* sp = (const LAS v4u*)(sbuf + (size_t)((k16 * 16 + c) * 32)); const v4u a = sp[0], b = sp[1];
              v4u o; o.x = pack_q8m(bf_lo(a.x), bf_hi(a.x), bf_lo(a.y), bf_hi(a.y), inv); o.y = pack_q8m(bf_lo(a.z), bf_hi(a.z), bf_lo(a.w), bf_hi(a.w), inv);
              o.z = pack_q8m(bf_lo(b.x), bf_hi(b.x), bf_lo(b.y), bf_hi(b.y), inv); o.w = pack_q8m(bf_lo(b.z), bf_hi(b.z), bf_lo(b.w), bf_hi(b.w), inv);
              *(v4u*)(orow + 16 * k16) = o; }
          if (wave == 0 && kk == 0) cso[drow_cur + c] = m * (1.0f / 127.0f); }
        __syncthreads();
    }
#undef SQ_LOAD
#undef SQ_FIN
}
struct SMapGU { __device__ __forceinline__ void operator()(int strip, int& n0, int& drow0) const { n0 = 16 * strip; const int isup = n0 >= DFF ? 1 : 0, j0 = n0 - isup * DFF; drow0 = (j0 >> 7) * 256 + isup * 128 + (j0 & 127); } };
struct SMapIn { __device__ __forceinline__ void operator()(int strip, int& n0, int& drow0) const { drow0 = 16 * strip; n0 = drow0 < NQ ? QC0 + drow0 : drow0 - NQ; } };

struct Args { const float* in[23]; float* out; unsigned char* ws; int ph_lo, ph_hi, li, pad; };

__global__ void __launch_bounds__(NWAVES * 64, 2) fwd_kernel(Args args) {
    extern __shared__ __attribute__((aligned(16))) unsigned char lds_raw[];
    LAS unsigned char* lds = (LAS unsigned char*)lds_raw;
    volatile LAS unsigned* MISC = (volatile LAS unsigned*)(lds + MISC_OFF);
    const int tid = threadIdx.x, lane = tid & 63, wave = __builtin_amdgcn_readfirstlane(tid >> 6);
    const int G = gridDim.x; const int bx = blockIdx.x; const int vcu = (G % 8 == 0) ? (bx % 8) * (G / 8) + bx / 8 : bx;
    unsigned char* ws = args.ws;
    gu32* ctl = (gu32*)(ws + WS_CTL);
    const float* x = args.in[0]; const float* cvec = args.in[1]; const float* w_ada = args.in[2]; const float* b_ada = args.in[3];
    const float* g_mix_pre = args.in[4]; const float* g_mix_post = args.in[5]; const float* w_in = args.in[6]; const float* conv_w = args.in[7]; const float* conv_b = args.in[8];
    const float* w_rg_a = args.in[9]; const float* b_rg_a = args.in[10]; const float* w_rg_x = args.in[11]; const float* b_rg_x = args.in[12]; const float* lam = args.in[13];
    const float* pool_w = args.in[14]; const float* pool_scale = args.in[15]; const float* w_bl = args.in[16]; const float* w_bp = args.in[17]; const float* w_o = args.in[18];
    const float* g_ffn_pre = args.in[19]; const float* g_ffn_post = args.in[20]; const float* w_gu = args.in[21]; const float* w_dn = args.in[22];
    float* out = args.out;
    float* mod = (float*)(ws + WS_MOD); float* sp8 = (float*)(ws + WS_SP8);
    bf16* Wrg_t = (bf16*)(ws + WS_WRG); bf16* Wpool_t = (bf16*)(ws + WS_WPOOL); bf16* Wbl_t = (bf16*)(ws + WS_WBL); bf16* Wbp_t = (bf16*)(ws + WS_WBP); bf16* Wo_t = (bf16*)(ws + WS_WO);
    bf16* Win_t = (bf16*)(ws + WS_WIN); bf16* Wgu_t = (bf16*)(ws + WS_WGU); bf16* Wdn_t = (bf16*)(ws + WS_WDN);
    bf16* U = (bf16*)(ws + WS_U); bf16* PROJ = (bf16*)(ws + WS_PROJ); bf16* XC = (bf16*)(ws + WS_XC); bf16* POOLED = (bf16*)(ws + WS_POOLED);
    unsigned* AU = (unsigned*)(ws + WS_AU); float* SCP = (float*)(ws + WS_SCANC); float* SCH = SCP + BATCH * SCAN_NC * D;
    bf16* YL = (bf16*)(ws + WS_YL); bf16* YP = (bf16*)(ws + WS_YP); bf16* MERGED = (bf16*)(ws + WS_MERGED); bf16* Y = (bf16*)(ws + WS_Y); bf16* Y2 = (bf16*)(ws + WS_Y2); bf16* H = (bf16*)(ws + WS_H); bf16* X1B = (bf16*)(ws + WS_X1B);

    for (int u = tid; u < (LDS_BYTES - LDSCTL_OFF) / 4; u += NWAVES * 64) ((LAS unsigned*)(lds + LDSCTL_OFF))[u] = 0u;
    __syncthreads();
    XcdBarrier bar; bar.bar = (unsigned*)(ctl + CW_BAR) + args.li * XCD_BAR_WORDS; bar.x = 0; bar.st = nullptr;
    if (N_LAUNCHES != NPH) bar = xcd_barrier_post((unsigned*)(ctl + CW_BAR) + args.li * XCD_BAR_WORDS, MISC + 8);
#define GRID_BAR() do { if (N_LAUNCHES != NPH) xcd_barrier(bar); } while (0)
    const int lo = args.ph_lo, hi = args.ph_hi;
#ifndef PH_MASK
#define PH_MASK 0x1fff
#endif
#define IN(k) (((PH_MASK >> (k)) & 1) && lo <= (k) && (k) < hi)
#ifndef DUP_MASK
#define DUP_MASK 0


#endif
#define DUP(k) ((DUP_MASK >> (k)) & 1)
#define REP(k) _Pragma("unroll 1") for (int rep_ = 0; rep_ < DUP(k) + 1; ++rep_)
#define BOTH(k) (IN(k) && (k) + 1 < hi)
    const int gw = vcu * NWAVES + wave, NGW = G * NWAVES;
    unsigned char* PQ8 = ws + WS_AU; unsigned char* W8c = ws + WS_AU + 64 * MiB; float* pscale = (float*)(ws + WS_AU + 96 * MiB); float* wcscale = pscale + M;
    bf16* Wcomb_t = (bf16*)(ws + WS_YP);
    bf16* Wgu_rot = (bf16*)(ws + WS_WGU); unsigned char* W8gu = ws + WS_YP; unsigned* cmaxf = (unsigned*)(ws + 640 * 1024);
    unsigned char* U2Q8 = ws + WS_Y2; float* r2scale = (float*)(ws + WS_Y2 + 64 * MiB); float* cscalef = r2scale + M;
    unsigned char* UQ8 = ws + WS_AU; unsigned char* W8 = ws + WS_AU + 64 * MiB; float* rscale = (float*)(ws + WS_AU + 130 * MiB); float* cscale = rscale + M; unsigned* cmaxg = (unsigned*)(ws + 512 * 1024);

    if (IN(0)) REP(0) {
        {
            LAS float* cact = (LAS float*)lds; LAS float* red = (LAS float*)(lds + 32768);
            for (int i = tid; i < BATCH * D; i += NWAVES * 64) { const float v = cvec[i]; cact[i] = pg8::siluf_(v); }
            __syncthreads();
            const int cg = tid % 24, kg = tid / 24;
            for (int g = vcu; g < NMOD / 96; g += G) {
                if (kg < 21) {
                    f32x4 a0 = {0.f, 0.f, 0.f, 0.f}, a1 = {0.f, 0.f, 0.f, 0.f};
                    const float* wp = w_ada + (size_t)g * 96 + cg * 4;
#pragma unroll 8
                    for (int k = kg; k < D; k += 21) { const f32x4 w = *(const f32x4*)(wp + (size_t)k * NMOD); const float c0 = cact[k], c1 = cact[D + k]; a0 += w * c0; a1 += w * c1; }
                    LAS float* rp = red + (kg * 24 + cg) * 8;
                    rp[0] = a0.x; rp[1] = a0.y; rp[2] = a0.z; rp[3] = a0.w; rp[4] = a1.x; rp[5] = a1.y; rp[6] = a1.z; rp[7] = a1.w;
                }
                __syncthreads();
                if (tid < 192) { const int cgo = tid >> 3, r = tid & 7, b = r >> 2, j = r & 3; float s = 0.f;
#pragma unroll
                    for (int q = 0; q < 21; ++q) s += red[(q * 24 + cgo) * 8 + r];
                    const int n = g * 96 + cgo * 4 + j; mod[b * NMOD + n] = s + b_ada[n]; }
                __syncthreads();
            }
        }
        for (int i = bx * NWAVES * 64 + tid; i < D; i += G * NWAVES * 64) { const float l = lam[i]; sp8[i] = -8.0f * log1pf(expf(-l)); }
        {
            LAS float* scr = (LAS float*)(lds + wave * 16384);
            int itbase = 0;
            transpose_matrix<0>(w_in + D, D, NIN, Win_t, D, D, scr, lane, gw, NGW, itbase, D);
            for (int h = 0; h < HEADS; ++h) {
                const int nblk = HD / 32, nitems = (HD / 64) * nblk * 2;
                int it = gw - (itbase % NGW); if (it < 0) it += NGW;
                for (; it < nitems; it += NGW) { const int which = it / ((HD / 64) * nblk), r = it % ((HD / 64) * nblk), kb = r / nblk, nb = r % nblk, n0 = 32 * nb;
                    const float* W = (which ? w_rg_x : w_rg_a) + (size_t)h * HD * HD;
                    transpose_item(W, HD, Wrg_t, HD, 64 * kb, n0, h * 512 + (n0 >> 7) * 256 + which * 128 + (n0 & 127), scr, lane); }
                itbase += nitems;
            }
            for (int e = (bx * NWAVES * 64 + tid) * 4; e < PGRP * PGD * PGD; e += G * NWAVES * 64 * 4) {
                const int j = e % PGD, gi = e / (PGD * PGD); const f32x4 w = *(const f32x4*)(pool_w + e), sc = *(const f32x4*)(pool_scale + gi * PGD + j);
                v2u o; o.x = cvt_pk_bf16(w.x * sc.x, w.y * sc.y); o.y = cvt_pk_bf16(w.z * sc.z, w.w * sc.w); *(v2u*)(Wpool_t + e) = o; }
            transpose_matrix<0>(w_bl, D, D, Wbl_t, D, 0, scr, lane, gw, NGW, itbase);
            transpose_matrix<0>(w_bp, D, D, Wbp_t, D, 0, scr, lane, gw, NGW, itbase);
            transpose_matrix<0>(w_o, D, D, Wo_t, D, 0, scr, lane, gw, NGW, itbase);
            __syncthreads();
            strip_quant(w_in, NIN, W8, cscale, (NQ + D) / 16, vcu, G, lds, lane, wave, SMapIn{});
        }
        if (BOTH(0)) GRID_BAR();
    }

    if (IN(1)) REP(1) {
        { LAS float* scr = (LAS float*)(lds + wave * 16384);
          (void)scr;
          }
        __syncthreads();
        LAS float* cA = (LAS float*)lds; LAS float* cB = cA + D;
        int cur_b = -1;
        for (int slot = vcu; slot < M / 8; slot += G) {
            const int b = slot / (SEQ / 8);
            if (b != cur_b) { __syncthreads();
                for (int i = tid; i < D; i += NWAVES * 64) { cA[i] = g_mix_pre[i] * (1.0f + mod[b * NMOD + 1 * D + i]); cB[i] = mod[b * NMOD + 0 * D + i]; }
                __syncthreads(); cur_b = b; }
            { const size_t row = (size_t)slot * 8 + wave;
                const f32x4* xr = (const f32x4*)(x + row * D) + lane;
                f32x4 v[16]; float s = 0.f;
#pragma unroll
                for (int j = 0; j < 16; ++j) { v[j] = xr[64 * j]; s += dot4(v[j]); }
                const float rstd = 1.0f / sqrtf(wave_sum(s) * (1.0f / D) + RMS_EPS);
                v2u* o8 = (v2u*)(U + row * D) + lane;
#pragma unroll
                for (int j = 0; j < 16; ++j) { const f32x4 a = ((const LAS f32x4*)cA)[lane + 64 * j], bb = ((const LAS f32x4*)cB)[lane + 64 * j]; v[j] = v[j] * rstd * a + bb;
                    v2u w; w.x = cvt_pk_bf16(v[j].x, v[j].y); w.y = cvt_pk_bf16(v[j].z, v[j].w); o8[64 * j] = w; }
                rotq_row(v, (unsigned*)(UQ8 + row * D), rscale + row, lane);
            }
        }
        if (BOTH(1)) GRID_BAR();
    }

    if (IN(2)) {
#define P2_BODY do { { pg8::Gemm g{U, Win_t + (size_t)D * D, M, D, D, D, D, 30}; pg8::StaticOrder S; S.init(M, D, G, bx); \
        pg8::EpiPlain E{PROJ + D, NIN}; \
        pg8::gemm_phase<pg8::EpiPlain, pg8::StaticOrder, true, true>(lds + RING_OFF, g, S, E); } \
        { pg8::Gemm g{(const bf16*)UQ8, (const bf16*)W8, M, NQ, D / 2, D / 2, D / 2, 30}; pg8::StaticOrder S; S.init(M, NQ, G, bx);     \
        pg8::EpiI8 E{PROJ + QC0, NIN, rscale, cscale}; \
        pg8::gemm_phase<pg8::EpiI8, pg8::StaticOrder, true, true>(lds + RING_OFF, g, S, E); } \
        { pg8::Gemm g{(const bf16*)UQ8, (const bf16*)(W8 + (size_t)NQ * D), M, D, D / 2, D / 2, D / 2, 30}; pg8::StaticOrder S; S.init(M, D, G, bx);     \
        pg8::EpiI8 E{PROJ, NIN, rscale, cscale + NQ}; \
        pg8::gemm_phase<pg8::EpiI8, pg8::StaticOrder, true, true>(lds + RING_OFF, g, S, E); } } while (0)
        P2_BODY; if (DUP(2)) { P2_BODY; }
        if (BOTH(2)) GRID_BAR();
    }

    if (IN(3)) REP(3) {
        for (int id = gw; id < (M / 64) * 16; id += NGW) { const int chunk = id >> 4, cgp = id & 15, ch0 = cgp * 256 + lane * 4;
            switch (cgp >> 2) {
                case 0: conv_pool_chunk<2>(PROJ, XC, POOLED, conv_w, conv_b, chunk, ch0); break;
                case 1: conv_pool_chunk<4>(PROJ, XC, POOLED, conv_w, conv_b, chunk, ch0); break;
                case 2: conv_pool_chunk<8>(PROJ, XC, POOLED, conv_w, conv_b, chunk, ch0); break;
                default: conv_pool_chunk<16>(PROJ, XC, POOLED, conv_w, conv_b, chunk, ch0); break;
            }
        }
    }
    if (IN(3)) {
        { pg8::Gemm g{Wbp_t, Wpool_t, D, D, PGD, D, PGD, 2}; pg8::StaticOrder S; S.init(D, D, G, bx);
          pg8::EpiPlain E{Wcomb_t, D};
          pg8::gemm_phase<pg8::EpiPlain, pg8::StaticOrder, true, true>(lds + RING_OFF, g, S, E); }
        if (BOTH(3)) GRID_BAR();
    }

    if (IN(4)) {
#define P4_BODY do { \
        lru_fused(XC, Wrg_t, PROJ, YL, b_rg_a, b_rg_x, sp8, lds, tid, lane, wave, vcu, G); } while (0)
        P4_BODY; if (DUP(4)) { P4_BODY; }
        for (int slot = vcu; slot < (M + D) / 8; slot += G) { const int row = slot * 8 + wave; const bool isw = row >= M;
            const bf16* src = isw ? Wcomb_t + (size_t)(row - M) * D : POOLED + (size_t)row * D; const v2u* sp = (const v2u*)src + lane;
            f32x4 v[16];
#pragma unroll
            for (int j = 0; j < 16; ++j) { const v2u q = sp[64 * j]; v[j] = (f32x4){bf_lo(q.x), bf_hi(q.x), bf_lo(q.y), bf_hi(q.y)}; }
            rotq_row(v, (unsigned*)(isw ? W8c + (size_t)(row - M) * D : PQ8 + (size_t)row * D), isw ? wcscale + (row - M) : pscale + row, lane); }
        if (BOTH(4)) GRID_BAR();
    }

    if (IN(7)) {
#define P7_BODY do { \
        { pg8::Gemm g{(const bf16*)PQ8, (const bf16*)W8c, M, D, D / 2, D / 2, D / 2, 30}; pg8::StaticOrder S; S.init(M, D, G, bx);     \
          pg8::EpiGateI8 E{MERGED, D, PROJ + 4 * D, NIN, pscale, wcscale}; \
          pg8::gemm_phase<pg8::EpiGateI8, pg8::StaticOrder, true, true>(lds + RING_OFF, g, S, E); } \
        { pg8::Gemm g{YL, Wbl_t, M, D, D, D, D, 30}; pg8::StaticOrder S; S.init(M, D, G, bx); \
          pg8::EpiGate<true> E{MERGED, D, PROJ + 3 * D, NIN}; \
          pg8::gemm_phase<pg8::EpiGate<true>, pg8::StaticOrder, true, true>(lds + RING_OFF, g, S, E); } } while (0)
        P7_BODY; if (DUP(7)) { P7_BODY; }
        if (BOTH(7)) GRID_BAR();
    }

    if (IN(8)) {
#define P8_BODY do { pg8::Gemm g{MERGED, Wo_t, M, D, D, D, D, 30}; pg8::StaticOrder S; S.init(M, D, G, bx); \
        pg8::EpiPlain E{Y, D}; \
        pg8::gemm_phase<pg8::EpiPlain, pg8::StaticOrder, true, true>(lds + RING_OFF, g, S, E); } while (0)
        P8_BODY; if (DUP(8)) { P8_BODY; }
        if (BOTH(8)) GRID_BAR();
    }

    if (IN(9)) REP(9) {
        {
            LAS float* scr = (LAS float*)(lds + wave * 16384);
            int itbase = 0;
            (void)itbase;
            strip_quant(w_gu, NGU, W8gu, cscalef, NGU / 16, vcu, G, lds, lane, wave, SMapGU{});
            __syncthreads();
            if (((M / 256) * (NGU / 256)) % G == 0) transpose_matrix<0>(w_dn, DFF, D, Wdn_t, DFF, 0, scr, lane, gw, NGW, itbase);
        }
        __syncthreads();
        {
            LAS float* cG = (LAS float*)lds; LAS float* cA = cG + D; LAS float* cB = cA + D;
            int cur_b = -1;
            for (int slot = vcu; slot < M / 8; slot += G) {
                const int b = slot / (SEQ / 8);
                if (b != cur_b) { __syncthreads();
                    for (int i = tid; i < D; i += NWAVES * 64) { cG[i] = mod[b * NMOD + 2 * D + i] * g_mix_post[i]; cA[i] = g_ffn_pre[i] * (1.0f + mod[b * NMOD + 4 * D + i]); cB[i] = mod[b * NMOD + 3 * D + i]; }
                    __syncthreads(); cur_b = b; }
                { const size_t row = (size_t)slot * 8 + wave;
                    const f32x4* xr = (const f32x4*)(x + row * D) + lane; const v2u* yr = (const v2u*)(Y + row * D) + lane;
                    f32x4 v[16]; v2u yv[16]; float sy = 0.f;
#pragma unroll
                    for (int j = 0; j < 16; ++j) { v[j] = xr[64 * j]; yv[j] = yr[64 * j]; }
#pragma unroll
                    for (int j = 0; j < 16; ++j) { const f32x4 y = {bf_lo(yv[j].x), bf_hi(yv[j].x), bf_lo(yv[j].y), bf_hi(yv[j].y)}; sy += dot4(y); }
                    const float rstdy = 1.0f / sqrtf(wave_sum(sy) * (1.0f / D) + RMS_EPS);
                    float s1 = 0.f; v2u* orow = (v2u*)(X1B + row * D) + lane;
#pragma unroll
                    for (int j = 0; j < 16; ++j) { const f32x4 y = {bf_lo(yv[j].x), bf_hi(yv[j].x), bf_lo(yv[j].y), bf_hi(yv[j].y)}; const f32x4 gq = ((const LAS f32x4*)cG)[lane + 64 * j];
                        v[j] = v[j] + gq * (y * rstdy); s1 += dot4(v[j]); v2u w; w.x = cvt_pk_bf16(v[j].x, v[j].y); w.y = cvt_pk_bf16(v[j].z, v[j].w); orow[64 * j] = w; }
                    const float rstd1 = 1.0f / sqrtf(wave_sum(s1) * (1.0f / D) + RMS_EPS);
#pragma unroll
                    for (int j = 0; j < 16; ++j) { const f32x4 a = ((const LAS f32x4*)cA)[lane + 64 * j], bb = ((const LAS f32x4*)cB)[lane + 64 * j]; v[j] = v[j] * rstd1 * a + bb; }
                    rotq_row(v, (unsigned*)(U2Q8 + row * D), r2scale + row, lane);
                }
            }
        }
        if (BOTH(9)) GRID_BAR();
    }

    if (IN(10)) {
        { pg8::Gemm g{(const bf16*)U2Q8, (const bf16*)W8gu, M, NGU, D / 2, D / 2, D / 2, 30}; pg8::StaticOrder S; S.init(M, NGU, G, bx);
          pg8::EpiI8Swiglu E{H, DFF, r2scale, cscalef};
          pg8::gemm_phase<pg8::EpiI8Swiglu, pg8::StaticOrder, true, true>(lds + RING_OFF, g, S, E); }
        { const int rem10 = ((M / 256) * (NGU / 256)) % G;
          if (rem10 != 0 && bx >= rem10) { LAS float* scr = (LAS float*)(lds + wave * 16384); int itbase = 0;
              transpose_matrix<0>(w_dn, DFF, D, Wdn_t, DFF, 0, scr, lane, (bx - rem10) * NWAVES + wave, (G - rem10) * NWAVES, itbase); } }
        if (BOTH(10)) GRID_BAR();
    }

    if (IN(11)) {
#define P11_BODY do { pg8::Gemm g{H, Wdn_t, M, D, DFF, DFF, DFF, 30}; pg8::EpiPlain E{Y2, D}; \
        if (G == 256) { pg8::Grid16Order S; S.init(M, D, G, bx); pg8::gemm_phase<pg8::EpiPlain, pg8::Grid16Order, true, true>(lds + RING_OFF, g, S, E); } \
        else { pg8::StaticOrder S; S.init(M, D, G, bx); pg8::gemm_phase<pg8::EpiPlain, pg8::StaticOrder, true, true>(lds + RING_OFF, g, S, E); } } while (0)
        P11_BODY; if (DUP(11)) { P11_BODY; }
        if (BOTH(11)) GRID_BAR();
    }

    if (IN(12)) {
        LAS float* cG = (LAS float*)lds;
        int cur_b = -1;
        for (int slot = vcu; slot < M / 8; slot += G) {
            const int b = slot / (SEQ / 8);
            if (b != cur_b) { __syncthreads();
                for (int i = tid; i < D; i += NWAVES * 64) cG[i] = mod[b * NMOD + 5 * D + i] * g_ffn_post[i];
                __syncthreads(); cur_b = b; }
            { const size_t row = (size_t)slot * 8 + wave;
                f32x4* xr = (f32x4*)(out + row * D) + lane; const v2u* yr = (const v2u*)(Y2 + row * D) + lane; const v2u* x1r = (const v2u*)(X1B + row * D) + lane;
                f32x4 v[16]; v2u yv[16]; float sy = 0.f;
#pragma unroll
                for (int j = 0; j < 16; ++j) { const v2u q = x1r[64 * j]; v[j] = (f32x4){bf_lo(q.x), bf_hi(q.x), bf_lo(q.y), bf_hi(q.y)}; yv[j] = yr[64 * j]; }
#pragma unroll
                for (int j = 0; j < 16; ++j) { const f32x4 y = {bf_lo(yv[j].x), bf_hi(yv[j].x), bf_lo(yv[j].y), bf_hi(yv[j].y)}; sy += dot4(y); }
                const float rstdy = 1.0f / sqrtf(wave_sum(sy) * (1.0f / D) + RMS_EPS);
#pragma unroll
                for (int j = 0; j < 16; ++j) { const f32x4 y = {bf_lo(yv[j].x), bf_hi(yv[j].x), bf_lo(yv[j].y), bf_hi(yv[j].y)}; const f32x4 gq = ((const LAS f32x4*)cG)[lane + 64 * j];
                    xr[64 * j] = v[j] + gq * (y * rstdy); }
            }
        }
    }
#undef IN
#undef BOTH
#undef GRID_BAR
}

extern "C" void kernel_launch(void* const* d_in, const int* in_sizes, int n_in, void* d_out, int out_size, void* d_ws, size_t ws_size, hipStream_t stream) {
    static int grid = 0;
    if (grid == 0) {
        if (n_in != 23 || in_sizes[0] != M * D || out_size != M * D || ws_size < WS_END) {
            fprintf(stderr, "kernel_launch: built for 23 inputs, x/out of %d floats, >= %zu bytes of workspace; got n_in %d, in0 %d, out %d, ws %zu; nothing launched\n", M * D, (size_t)WS_END, n_in, n_in > 0 ? in_sizes[0] : -1, out_size, ws_size);
            grid = -1; return; }
        int dev = 0, cus = 0, per_cu = 0;
        if (hipGetDevice(&dev) != hipSuccess || hipDeviceGetAttribute(&cus, hipDeviceAttributeMultiprocessorCount, dev) != hipSuccess) { fprintf(stderr, "kernel_launch: device query failed\n"); grid = -1; return; }
        if (hipFuncSetAttribute((const void*)fwd_kernel, hipFuncAttributeMaxDynamicSharedMemorySize, LDS_BYTES) != hipSuccess) { fprintf(stderr, "kernel_launch: hipFuncSetAttribute failed\n"); grid = -1; return; }
        if (hipOccupancyMaxActiveBlocksPerMultiprocessor(&per_cu, (const void*)fwd_kernel, NWAVES * 64, LDS_BYTES) != hipSuccess || per_cu < 1)
            fprintf(stderr, "kernel_launch: note: occupancy query reports %d workgroups per CU\n", per_cu);
        (void)hipGetLastError();
        grid = cus;
    }
    if (grid < 0) return;
    if (hipMemsetAsync((char*)d_ws + WS_CTL, 0, CTL_ZERO_BYTES, stream) != hipSuccess) { fprintf(stderr, "kernel_launch: memset failed\n"); return; }
    Args a{};
    for (int i = 0; i < 23; ++i) a.in[i] = (const float*)d_in[i];
    a.out = (float*)d_out; a.ws = (unsigned char*)d_ws; a.pad = 0;
    for (int li = 0; li < N_LAUNCHES; ++li) {
        a.ph_lo = (N_LAUNCHES == NPH) ? li : (li * NPH) / N_LAUNCHES; a.ph_hi = (N_LAUNCHES == NPH) ? li + 1 : ((li + 1) * NPH) / N_LAUNCHES; a.li = li;
        hipLaunchKernelGGL(fwd_kernel, dim3(grid), dim3(NWAVES * 64), LDS_BYTES, stream, a);
        const hipError_t le = hipPeekAtLastError();
        if (le != hipSuccess) { fprintf(stderr, "kernel_launch: launch %d failed: %s\n", li, hipGetErrorName(le)); break; }
    }
}
```

```cpp
#include <hip/hip_runtime.h>
#include <cstdio>
#include <cstdint>

#ifndef MK_N_LAUNCHES
#define MK_N_LAUNCHES 1
#endif

namespace pg8 {
#define PG8_LAS __attribute__((address_space(3)))
typedef unsigned short bf16_t;
typedef short bf16x8 __attribute__((ext_vector_type(8)));
typedef float f32x4 __attribute__((ext_vector_type(4)));
typedef unsigned u32x4 __attribute__((ext_vector_type(4)));
typedef unsigned u32x2 __attribute__((ext_vector_type(2)));
typedef int i32x4 __attribute__((ext_vector_type(4)));
template <bool C, class A, class B> struct sel_t { typedef A type; };
template <class A, class B> struct sel_t<false, A, B> { typedef B type; };
constexpr int BM = 256, BK = 64, HALF = 128, HTB = HALF * BK * 2  , STAGE_BYTES = 8 * HTB, NXCD = 8, WGM = 8;

__host__ __device__ __forceinline__ int lds_byte(int r, int c) { const int st = (r >> 4) * 2 + (c >> 5), rr = r & 15, cc = c & 31, ob = rr * 64 + cc * 2; return st * 1024 + (ob ^ (((ob >> 9) & 1) << 5)); }
__host__ __device__ __forceinline__ void stage_rc(int b, int& R, int& C) { const int st = b / 1024, sb = b % 1024, swz = sb ^ (((sb >> 9) & 1) << 5); R = (st >> 1) * 16 + swz / 64; C = (st & 1) * 32 + (swz % 64) / 2; }
__host__ __device__ __forceinline__ int perm32(int rho) { const int n = rho >> 4, i = rho & 15; return 8 * (i >> 2) + 4 * n + (i & 3); }

struct Unit { int pm, pn; };
struct Gemm { const bf16_t* A; const bf16_t* Bt; int M, N, K, lda, ldb, agshift; };

struct StaticOrder {
    int nM, nN, nwg, G, c;
    __host__ __device__ void init(int M, int N, int G_, int c_) { nM = M / BM; nN = N / BM; nwg = nM * nN; G = G_; c = c_; }
    __host__ __device__ bool next(int i, Unit& u) const {
        const long L = (long)i * G + c; if (L >= nwg) return false;
        int wgid = (int)L; { const int q = nwg / NXCD, r = nwg % NXCD, xcd = wgid % NXCD, off = wgid / NXCD; wgid = (xcd < r ? xcd * (q + 1) : r * (q + 1) + (xcd - r) * q) + off; }
        const int nig = WGM * nN, gid = wgid / nig, fm = gid * WGM, gsz = (nM - fm) < WGM ? (nM - fm) : WGM;
        u.pm = fm + ((wgid % nig) % gsz); u.pn = (wgid % nig) / gsz; return true;
    }
    __device__ __forceinline__ void a_ready(const Unit&) const {}
    __device__ __forceinline__ void done(const Unit&) const {}
};
struct Grid16Order {
    int nM, nN, nwg, G, c;
    __host__ __device__ void init(int M, int N, int G_, int c_) { nM = M / BM; nN = N / BM; nwg = nM * nN; G = G_; c = c_; }
    __host__ __device__ bool next(int i, Unit& u) const {
        const int ncg = nN / 16; if (i >= (nM / 16) * ncg) return false;
        const int rg = i / ncg, cg = i % ncg, xcd = c % NXCD, j = c / NXCD;
        u.pm = rg * 16 + (xcd >> 2) * 8 + (j & 7); u.pn = cg * 16 + (xcd & 3) * 4 + (j >> 3); return true;
    }
    __device__ __forceinline__ void a_ready(const Unit&) const {}
    __device__ __forceinline__ void done(const Unit&) const {}
};

__device__ __forceinline__ unsigned cvt_pk_bf16(float lo, float hi) { unsigned r; asm volatile("v_cvt_pk_bf16_f32 %0, %1, %2" : "=v"(r) : "v"(lo), "v"(hi)); return r; }
__device__ __forceinline__ float bf_lo(unsigned w) { return __uint_as_float(w << 16); }
__device__ __forceinline__ float bf_hi(unsigned w) { return __uint_as_float(w & 0xffff0000u); }
__device__ __forceinline__ float fast_rcp(float x) { return __builtin_amdgcn_rcpf(x); }
__device__ __forceinline__ float fast_exp(float x) { return __builtin_amdgcn_exp2f(x * 1.44269504088896f); }
__device__ __forceinline__ float sigmoidf_(float x) { return fast_rcp(1.0f + fast_exp(-x)); }
__device__ __forceinline__ float siluf_(float x) { return x * sigmoidf_(x); }
__device__ __forceinline__ float gelu_tanh_(float x) { const float z = 1.5957691216057308f * (x + 0.044715f * x * x * x); return x * sigmoidf_(z); }

struct EpiPlain {
    static constexpr bool PERM = true, I8 = false;
    bf16_t* O; int ldc;
    __device__ __forceinline__ void operator()(const f32x4 (&acc)[2][2][4][2], const Unit& u, int wr, int wc, int fr, int fq) const {
        const int row0 = u.pm * BM + wr * 64 + fr, col0 = u.pn * BM + wc * 32 + 8 * fq;
#pragma unroll
        for (int ai = 0; ai < 2; ++ai)
#pragma unroll
            for (int m = 0; m < 4; ++m) { bf16_t* rowp = O + (size_t)(row0 + ai * HALF + m * 16) * ldc + col0;
#pragma unroll
                for (int bj = 0; bj < 2; ++bj) { const f32x4 v0 = acc[ai][bj][m][0], v1 = acc[ai][bj][m][1];
                    u32x4 w; w.x = cvt_pk_bf16(v0[0], v0[1]); w.y = cvt_pk_bf16(v0[2], v0[3]); w.z = cvt_pk_bf16(v1[0], v1[1]); w.w = cvt_pk_bf16(v1[2], v1[3]);
                    *(u32x4*)(rowp + bj * HALF) = w; } }
    }
};
struct EpiI8 {
    static constexpr bool PERM = true, I8 = true;
    bf16_t* O; int ldc; const float* rs; const float* cs;
    __device__ __forceinline__ void operator()(const i32x4 (&acc)[2][2][4][2], const Unit& u, int wr, int wc, int fr, int fq, const PG8_LAS float* sb) const {
        const int row0 = u.pm * BM + wr * 64 + fr, col0 = u.pn * BM + wc * 32 + 8 * fq;
        f32x4 sv[2][2];
#pragma unroll
        for (int bj = 0; bj < 2; ++bj)
#pragma unroll
            for (int n = 0; n < 2; ++n) sv[bj][n] = *(const PG8_LAS f32x4*)(sb + wc * 32 + 8 * fq + bj * HALF + 4 * n);
#pragma unroll
        for (int ai = 0; ai < 2; ++ai)
#pragma unroll
            for (int m = 0; m < 4; ++m) { const int row = row0 + ai * HALF + m * 16; const float r = sb[256 + wr * 64 + fr + ai * HALF + m * 16]; bf16_t* rowp = O + (size_t)row * ldc + col0;
#pragma unroll
                for (int bj = 0; bj < 2; ++bj) { const f32x4 v0 = __builtin_convertvector(acc[ai][bj][m][0], f32x4) * sv[bj][0] * r, v1 = __builtin_convertvector(acc[ai][bj][m][1], f32x4) * sv[bj][1] * r;
                    u32x4 w; w.x = cvt_pk_bf16(v0[0], v0[1]); w.y = cvt_pk_bf16(v0[2], v0[3]); w.z = cvt_pk_bf16(v1[0], v1[1]); w.w = cvt_pk_bf16(v1[2], v1[3]);
                    *(u32x4*)(rowp + bj * HALF) = w; } }
    }
};
struct EpiI8Silu {
    static constexpr bool PERM = true, I8 = true;
    bf16_t* O; int ldc; const float* rs; const float* cs;
    __device__ __forceinline__ void operator()(const i32x4 (&acc)[2][2][4][2], const Unit& u, int wr, int wc, int fr, int fq) const {
        const int row0 = u.pm * BM + wr * 64 + fr, col0 = u.pn * BM + wc * 32 + 8 * fq;
        f32x4 sv[2][2];
#pragma unroll
        for (int bj = 0; bj < 2; ++bj)
#pragma unroll
            for (int n = 0; n < 2; ++n) sv[bj][n] = *(const f32x4*)(cs + col0 + bj * HALF + 4 * n);
#pragma unroll
        for (int ai = 0; ai < 2; ++ai)
#pragma unroll
            for (int m = 0; m < 4; ++m) { const int row = row0 + ai * HALF + m * 16; const float r = rs[row]; bf16_t* rowp = O + (size_t)row * ldc + col0;
#pragma unroll
                for (int bj = 0; bj < 2; ++bj) { const f32x4 v0 = __builtin_convertvector(acc[ai][bj][m][0], f32x4) * sv[bj][0] * r, v1 = __builtin_convertvector(acc[ai][bj][m][1], f32x4) * sv[bj][1] * r;
                    u32x4 w; w.x = cvt_pk_bf16(siluf_(v0[0]), siluf_(v0[1])); w.y = cvt_pk_bf16(siluf_(v0[2]), siluf_(v0[3])); w.z = cvt_pk_bf16(siluf_(v1[0]), siluf_(v1[1])); w.w = cvt_pk_bf16(siluf_(v1[2]), siluf_(v1[3]));
                    *(u32x4*)(rowp + bj * HALF) = w; } }
    }
};
struct EpiI8Swiglu {
    static constexpr bool PERM = true, I8 = true;
    bf16_t* O; int ldc; const float* rs; const float* cs;
    __device__ __forceinline__ void operator()(const i32x4 (&acc)[2][2][4][2], const Unit& u, int wr, int wc, int fr, int fq, const PG8_LAS float* sb) const {
        const int row0 = u.pm * BM + wr * 64 + fr, col0 = u.pn * HALF + wc * 32 + 8 * fq, ccol0 = u.pn * BM + wc * 32 + 8 * fq;
        f32x4 sv[2][2];
#pragma unroll
        for (int bj = 0; bj < 2; ++bj)
#pragma unroll
            for (int n = 0; n < 2; ++n) sv[bj][n] = *(const PG8_LAS f32x4*)(sb + wc * 32 + 8 * fq + bj * HALF + 4 * n);
#pragma unroll
        for (int ai = 0; ai < 2; ++ai)
#pragma unroll
            for (int m = 0; m < 4; ++m) { const int row = row0 + ai * HALF + m * 16; const float r = sb[256 + wr * 64 + fr + ai * HALF + m * 16]; bf16_t* rowp = O + (size_t)row * ldc + col0;
                const f32x4 g0 = __builtin_convertvector(acc[ai][0][m][0], f32x4) * sv[0][0] * r, g1 = __builtin_convertvector(acc[ai][0][m][1], f32x4) * sv[0][1] * r;
                const f32x4 u0 = __builtin_convertvector(acc[ai][1][m][0], f32x4) * sv[1][0] * r, u1 = __builtin_convertvector(acc[ai][1][m][1], f32x4) * sv[1][1] * r;
                u32x4 w; w.x = cvt_pk_bf16(siluf_(g0[0]) * u0[0], siluf_(g0[1]) * u0[1]); w.y = cvt_pk_bf16(siluf_(g0[2]) * u0[2], siluf_(g0[3]) * u0[3]);
                w.z = cvt_pk_bf16(siluf_(g1[0]) * u1[0], siluf_(g1[1]) * u1[1]); w.w = cvt_pk_bf16(siluf_(g1[2]) * u1[2], siluf_(g1[3]) * u1[3]);
                *(u32x4*)rowp = w; }
    }
};
struct EpiMulPrev {
    static constexpr bool PERM = true, I8 = false;
    bf16_t* O; int ldc;
    __device__ __forceinline__ void operator()(const f32x4 (&acc)[2][2][4][2], const Unit& u, int wr, int wc, int fr, int fq) const {
        const int row0 = u.pm * BM + wr * 64 + fr, col0 = u.pn * BM + wc * 32 + 8 * fq;
#pragma unroll
        for (int ai = 0; ai < 2; ++ai) {
            u32x4 p[4][2];
#pragma unroll
            for (int m = 0; m < 4; ++m)
#pragma unroll
                for (int bj = 0; bj < 2; ++bj) p[m][bj] = *(const u32x4*)(O + (size_t)(row0 + ai * HALF + m * 16) * ldc + col0 + bj * HALF);
            asm volatile("" ::: "memory");
#pragma unroll
            for (int m = 0; m < 4; ++m) { bf16_t* rowp = O + (size_t)(row0 + ai * HALF + m * 16) * ldc + col0;
#pragma unroll
                for (int bj = 0; bj < 2; ++bj) { const u32x4 pp = p[m][bj]; const f32x4 v0 = acc[ai][bj][m][0], v1 = acc[ai][bj][m][1];
                    u32x4 w; w.x = cvt_pk_bf16(bf_lo(pp.x) * v0[0], bf_hi(pp.x) * v0[1]); w.y = cvt_pk_bf16(bf_lo(pp.y) * v0[2], bf_hi(pp.y) * v0[3]);
                    w.z = cvt_pk_bf16(bf_lo(pp.z) * v1[0], bf_hi(pp.z) * v1[1]); w.w = cvt_pk_bf16(bf_lo(pp.w) * v1[2], bf_hi(pp.w) * v1[3]);
                    *(u32x4*)(rowp + bj * HALF) = w; } }
            asm volatile("" ::: "memory");
        }
    }
};
struct EpiScale {
    static constexpr bool PERM = true, I8 = false;
    bf16_t* O; int ldc; const float* scale;
    __device__ __forceinline__ void operator()(const f32x4 (&acc)[2][2][4][2], const Unit& u, int wr, int wc, int fr, int fq) const {
        const int row0 = u.pm * BM + wr * 64 + fr, col0 = u.pn * BM + wc * 32 + 8 * fq;
        f32x4 sv[2][2];
#pragma unroll
        for (int bj = 0; bj < 2; ++bj)
#pragma unroll
            for (int n = 0; n < 2; ++n) sv[bj][n] = *(const f32x4*)(scale + col0 + bj * HALF + 4 * n);
#pragma unroll
        for (int ai = 0; ai < 2; ++ai)
#pragma unroll
            for (int m = 0; m < 4; ++m) { bf16_t* rowp = O + (size_t)(row0 + ai * HALF + m * 16) * ldc + col0;
#pragma unroll
                for (int bj = 0; bj < 2; ++bj) { const f32x4 v0 = acc[ai][bj][m][0] * sv[bj][0], v1 = acc[ai][bj][m][1] * sv[bj][1];
                    u32x4 w; w.x = cvt_pk_bf16(v0[0], v0[1]); w.y = cvt_pk_bf16(v0[2], v0[3]); w.z = cvt_pk_bf16(v1[0], v1[1]); w.w = cvt_pk_bf16(v1[2], v1[3]);
                    *(u32x4*)(rowp + bj * HALF) = w; } }
    }
};
struct EpiGateI8 {
    static constexpr bool PERM = true, I8 = true;
    bf16_t* O; int ldc; const bf16_t* Gt; int ldg; const float* rs; const float* cs;
    __device__ __forceinline__ void operator()(const i32x4 (&acc)[2][2][4][2], const Unit& u, int wr, int wc, int fr, int fq, const PG8_LAS float* sb) const {
        const int row0 = u.pm * BM + wr * 64 + fr, col0 = u.pn * BM + wc * 32 + 8 * fq;
        f32x4 sv[2][2];
#pragma unroll
        for (int bj = 0; bj < 2; ++bj)
#pragma unroll
            for (int n = 0; n < 2; ++n) sv[bj][n] = *(const PG8_LAS f32x4*)(sb + wc * 32 + 8 * fq + bj * HALF + 4 * n);
#pragma unroll
        for (int ai = 0; ai < 2; ++ai) {
            u32x4 g[4][2];
#pragma unroll
            for (int m = 0; m < 4; ++m) { const size_t row = (size_t)(row0 + ai * HALF + m * 16);
#pragma unroll
                for (int bj = 0; bj < 2; ++bj) g[m][bj] = *(const u32x4*)(Gt + row * ldg + col0 + bj * HALF); }
            asm volatile("" ::: "memory");
#pragma unroll
            for (int m = 0; m < 4; ++m) { const size_t row = (size_t)(row0 + ai * HALF + m * 16); bf16_t* rowp = O + row * ldc + col0; const float r = sb[256 + wr * 64 + fr + ai * HALF + m * 16];
#pragma unroll
                for (int bj = 0; bj < 2; ++bj) { const u32x4 gg = g[m][bj];
                    const f32x4 v0 = __builtin_convertvector(acc[ai][bj][m][0], f32x4) * sv[bj][0] * r, v1 = __builtin_convertvector(acc[ai][bj][m][1], f32x4) * sv[bj][1] * r;
                    float o[8];
                    o[0] = sigmoidf_(bf_lo(gg.x)) * v0[0]; o[1] = sigmoidf_(bf_hi(gg.x)) * v0[1]; o[2] = sigmoidf_(bf_lo(gg.y)) * v0[2]; o[3] = sigmoidf_(bf_hi(gg.y)) * v0[3];
                    o[4] = sigmoidf_(bf_lo(gg.z)) * v1[0]; o[5] = sigmoidf_(bf_hi(gg.z)) * v1[1]; o[6] = sigmoidf_(bf_lo(gg.w)) * v1[2]; o[7] = sigmoidf_(bf_hi(gg.w)) * v1[3];
                    u32x4 w; w.x = cvt_pk_bf16(o[0], o[1]); w.y = cvt_pk_bf16(o[2], o[3]); w.z = cvt_pk_bf16(o[4], o[5]); w.w = cvt_pk_bf16(o[6], o[7]);
                    *(u32x4*)(rowp + bj * HALF) = w; } }
            asm volatile("" ::: "memory");
        }
    }
};
template <bool ADD> struct EpiGate {
    static constexpr bool PERM = true, I8 = false;
    bf16_t* O; int ldc; const bf16_t* Gt; int ldg;
    __device__ __forceinline__ void operator()(const f32x4 (&acc)[2][2][4][2], const Unit& u, int wr, int wc, int fr, int fq) const {
        const int row0 = u.pm * BM + wr * 64 + fr, col0 = u.pn * BM + wc * 32 + 8 * fq;
#pragma unroll
        for (int ai = 0; ai < 2; ++ai) {
            u32x4 g[4][2], p[4][2];
#pragma unroll
            for (int m = 0; m < 4; ++m) { const size_t row = (size_t)(row0 + ai * HALF + m * 16);
#pragma unroll
                for (int bj = 0; bj < 2; ++bj) { g[m][bj] = *(const u32x4*)(Gt + row * ldg + col0 + bj * HALF); if (ADD) p[m][bj] = *(const u32x4*)(O + row * ldc + col0 + bj * HALF); } }
            asm volatile("" ::: "memory");
#pragma unroll
            for (int m = 0; m < 4; ++m) { const size_t row = (size_t)(row0 + ai * HALF + m * 16); bf16_t* rowp = O + row * ldc + col0;
#pragma unroll
                for (int bj = 0; bj < 2; ++bj) { const u32x4 gg = g[m][bj]; const f32x4 v0 = acc[ai][bj][m][0], v1 = acc[ai][bj][m][1];
                    float o[8];
                    o[0] = sigmoidf_(bf_lo(gg.x)) * v0[0]; o[1] = sigmoidf_(bf_hi(gg.x)) * v0[1]; o[2] = sigmoidf_(bf_lo(gg.y)) * v0[2]; o[3] = sigmoidf_(bf_hi(gg.y)) * v0[3];
                    o[4] = sigmoidf_(bf_lo(gg.z)) * v1[0]; o[5] = sigmoidf_(bf_hi(gg.z)) * v1[1]; o[6] = sigmoidf_(bf_lo(gg.w)) * v1[2]; o[7] = sigmoidf_(bf_hi(gg.w)) * v1[3];
                    if (ADD) { const u32x4 pp = p[m][bj];
                        o[0] += bf_lo(pp.x); o[1] += bf_hi(pp.x); o[2] += bf_lo(pp.y); o[3] += bf_hi(pp.y); o[4] += bf_lo(pp.z); o[5] += bf_hi(pp.z); o[6] += bf_lo(pp.w); o[7] += bf_hi(pp.w); }
                    u32x4 w; w.x = cvt_pk_bf16(o[0], o[1]); w.y = cvt_pk_bf16(o[2], o[3]); w.z = cvt_pk_bf16(o[4], o[5]); w.w = cvt_pk_bf16(o[6], o[7]);
                    *(u32x4*)(rowp + bj * HALF) = w; } }
            asm volatile("" ::: "memory");
        }
    }
};
struct EpiSwiglu {
    static constexpr bool PERM = true, I8 = false;
    bf16_t* O; int ldc;
    __device__ __forceinline__ void operator()(const f32x4 (&acc)[2][2][4][2], const Unit& u, int wr, int wc, int fr, int fq) const {
        const int row0 = u.pm * BM + wr * 64 + fr, col0 = u.pn * HALF + wc * 32 + 8 * fq;
#pragma unroll
        for (int ai = 0; ai < 2; ++ai)
#pragma unroll
            for (int m = 0; m < 4; ++m) { bf16_t* rowp = O + (size_t)(row0 + ai * HALF + m * 16) * ldc + col0;
                const f32x4 g0 = acc[ai][0][m][0], g1 = acc[ai][0][m][1], u0 = acc[ai][1][m][0], u1 = acc[ai][1][m][1];
                u32x4 w; w.x = cvt_pk_bf16(siluf_(g0[0]) * u0[0], siluf_(g0[1]) * u0[1]); w.y = cvt_pk_bf16(siluf_(g0[2]) * u0[2], siluf_(g0[3]) * u0[3]);
                w.z = cvt_pk_bf16(siluf_(g1[0]) * u1[0], siluf_(g1[1]) * u1[1]); w.w = cvt_pk_bf16(siluf_(g1[2]) * u1[2], siluf_(g1[3]) * u1[3]);
                *(u32x4*)rowp = w; }
    }
};
__device__ __forceinline__ f32x4 mma16(const bf16x8 a, const bf16x8 b, const f32x4 c) { return __builtin_amdgcn_mfma_f32_16x16x32_bf16(a, b, c, 0, 0, 0); }
__device__ __forceinline__ i32x4 mma16(const bf16x8 a, const bf16x8 b, const i32x4 c) { return __builtin_amdgcn_mfma_i32_16x16x64_i8(__builtin_bit_cast(i32x4, a), __builtin_bit_cast(i32x4, b), c, 0, 0, 0); }
constexpr int SCB_OFF = STAGE_BYTES + 1024;
__device__ __forceinline__ void stage_scales(PG8_LAS unsigned char* sb, const float* cs_tile, const float* rs_tile, int tid, int wid) {
    const float* src = (tid < 256) ? cs_tile + tid : rs_tile + (tid - 256);
    __builtin_amdgcn_global_load_lds((const unsigned*)src, (PG8_LAS unsigned*)(sb + wid * 256), 4, 0, 0);
}
template <class Epi, class Sched, bool ALIGN_EPI = false, bool SP2 = false>
__device__ __forceinline__ void gemm_phase(PG8_LAS unsigned char* lds, const Gemm g, const Sched& S, const Epi& E) {
    const int tid = threadIdx.x, wid = __builtin_amdgcn_readfirstlane(tid >> 6), lane = tid & 63, wr = wid >> 2, wc = wid & 3, fr = lane & 15, fq = lane >> 4;
    const int K = g.K, nt = K / BK;
    unsigned voffA[2], voffB[2];
#pragma unroll
    for (int i = 0; i < 2; ++i) { int R, C; stage_rc(tid * 16 + i * 8192, R, C); const int Rb = Epi::PERM ? ((R & ~31) + perm32(R & 31)) : R;
        voffA[i] = (unsigned)(R * g.lda + C) * 2u; voffB[i] = (unsigned)(Rb * g.ldb + C) * 2u; }
    const size_t kstep = (size_t)(BK * 2);
    const size_t hstepA = (size_t)HALF * g.lda * 2, hstepB = (size_t)HALF * g.ldb * 2;
    const size_t tstepA = 2 * hstepA, tstepB = 2 * hstepB;
    const unsigned ldsw = (unsigned)wid * 1024u;
    const int aoff = lds_byte(wr * 64 + fr, fq * 8), boff = lds_byte(wc * 32 + fr, fq * 8);
#define PG8_SA(b, h) (((b) * 2 + (h)) * HTB)
#define PG8_SB(b, h) ((4 + (b) * 2 + (h)) * HTB)
#define PG8_STAGE(bufoff, gbase, voff) do { _Pragma("unroll") for (int _i = 0; _i < 2; ++_i) \
        __builtin_amdgcn_global_load_lds((const unsigned*)((const char*)(gbase) + (voff)[_i]), (PG8_LAS unsigned*)(lds + (bufoff) + ldsw + _i * 8192), 16, 0, 0); } while (0)
#define PG8_LDA(dst, b, h) do { _Pragma("unroll") for (int m = 0; m < 4; ++m) _Pragma("unroll") for (int k = 0; k < 2; ++k) dst[m][k] = *(const PG8_LAS bf16x8*)(lds + PG8_SA(b, h) + aoff + m * 2048 + k * 1024); } while (0)
#define PG8_LDB(dst, b, h) do { _Pragma("unroll") for (int n = 0; n < 2; ++n) _Pragma("unroll") for (int k = 0; k < 2; ++k) dst[n][k] = *(const PG8_LAS bf16x8*)(lds + PG8_SB(b, h) + boff + n * 2048 + k * 1024); } while (0)
#define PG8_MMA(ai, bj, At, Bt) do { __builtin_amdgcn_s_setprio(1); _Pragma("unroll") for (int m = 0; m < 4; ++m) _Pragma("unroll") for (int n = 0; n < 2; ++n) _Pragma("unroll") for (int k = 0; k < 2; ++k) \
        acc[ai][bj][m][n] = mma16(Bt[n][k], At[m][k], acc[ai][bj][m][n]); __builtin_amdgcn_s_setprio(0); } while (0)
#define PG8_WAIT_V(n) asm volatile("s_waitcnt vmcnt(" #n ")" ::: "memory")
#define PG8_WAIT_L(n) asm volatile("s_waitcnt lgkmcnt(" #n ")" ::: "memory")
#define PG8_BAR __builtin_amdgcn_s_barrier()
#define PG8_SCHED __builtin_amdgcn_sched_barrier(0)
#define PG8_ABASE(u) ((const char*)g.A + (size_t)(u).pm * tstepA + (size_t)((u).pn >> g.agshift) * (size_t)K * 2)
#define PG8_BBASE(u) ((const char*)g.Bt + (size_t)(u).pn * tstepB)
    Unit cur, nxt; int ui = 0;
    if (!S.next(0, cur)) return;
    typedef typename sel_t<Epi::I8, i32x4, f32x4>::type acc_t;
    acc_t acc[2][2][4][2];
#pragma unroll
    for (int a = 0; a < 2; ++a)
#pragma unroll
        for (int b = 0; b < 2; ++b)
#pragma unroll
            for (int m = 0; m < 4; ++m)
#pragma unroll
                for (int n = 0; n < 2; ++n) acc[a][b][m][n] = acc_t{};
    bf16x8 At[4][2], B0[2][2], B1[2][2];
    const char* cA = PG8_ABASE(cur); const char* cB = PG8_BBASE(cur);
    S.a_ready(cur);
    if constexpr (Epi::I8) stage_scales(lds + SCB_OFF, E.cs + (size_t)cur.pn * BM, E.rs + (size_t)cur.pm * BM, tid, wid);
    if constexpr (SP2) {
        PG8_STAGE(PG8_SB(0, 0), cB, voffB); PG8_STAGE(PG8_SB(0, 1), cB + hstepB, voffB); PG8_STAGE(PG8_SA(0, 0), cA, voffA); PG8_STAGE(PG8_SA(0, 1), cA + hstepA, voffA);
        if (wr == 1) PG8_BAR;
        PG8_WAIT_V(2); PG8_BAR;
        PG8_STAGE(PG8_SB(1, 0), cB + kstep, voffB); PG8_STAGE(PG8_SA(1, 0), cA + kstep, voffA); PG8_STAGE(PG8_SB(1, 1), cB + hstepB + kstep, voffB);
        PG8_WAIT_V(6); PG8_BAR;
    } else {
        PG8_STAGE(PG8_SB(0, 0), cB, voffB); PG8_STAGE(PG8_SA(0, 0), cA, voffA); PG8_STAGE(PG8_SB(0, 1), cB + hstepB, voffB); PG8_STAGE(PG8_SA(0, 1), cA + hstepA, voffA);
        if (wr == 1) PG8_BAR;
        PG8_WAIT_V(4); PG8_BAR;
        PG8_STAGE(PG8_SB(1, 0), cB + kstep, voffB); PG8_STAGE(PG8_SA(1, 0), cA + kstep, voffA); PG8_STAGE(PG8_SB(1, 1), cB + hstepB + kstep, voffB);
        PG8_WAIT_V(6); PG8_BAR;
    }
    for (;;) {
        const bool has_next = S.next(ui + 1, nxt);
        const char* nA = has_next ? PG8_ABASE(nxt) : cA; const char* nB = has_next ? PG8_BBASE(nxt) : cB;
#pragma unroll 1
        for (int t = 0; t < nt; t += 2) {
            const bool last = (t == nt - 2);
            const char* a1 = cA + (size_t)(t + 1) * kstep;
            const char* a2 = last ? nA : cA + (size_t)(t + 2) * kstep; const char* b2 = last ? nB : cB + (size_t)(t + 2) * kstep;
            const char* a3 = a2 + kstep; const char* b3 = b2 + kstep;
            if (last && has_next) S.a_ready(nxt);
            if constexpr (SP2) {
            PG8_LDB(B0, 0, 0); PG8_LDB(B1, 0, 1); PG8_SCHED; PG8_LDA(At, 0, 0); PG8_STAGE(PG8_SA(1, 1), a1 + hstepA, voffA);
            PG8_WAIT_V(8); PG8_WAIT_L(0); PG8_BAR; PG8_MMA(0, 0, At, B0); PG8_MMA(0, 1, At, B1); PG8_BAR; PG8_SCHED;
            PG8_LDA(At, 0, 1); PG8_STAGE(PG8_SB(0, 0), b2, voffB); PG8_STAGE(PG8_SB(0, 1), b2 + hstepB, voffB); PG8_STAGE(PG8_SA(0, 0), a2, voffA);
            PG8_WAIT_V(8); PG8_WAIT_L(0); PG8_BAR; PG8_MMA(1, 0, At, B0); PG8_MMA(1, 1, At, B1); PG8_BAR; PG8_SCHED;
            PG8_LDB(B0, 1, 0); PG8_LDB(B1, 1, 1); PG8_SCHED; PG8_LDA(At, 1, 0); PG8_STAGE(PG8_SA(0, 1), a2 + hstepA, voffA);
            PG8_WAIT_V(8); PG8_WAIT_L(0); PG8_BAR; PG8_MMA(0, 0, At, B0); PG8_MMA(0, 1, At, B1); PG8_BAR; PG8_SCHED;
            PG8_LDA(At, 1, 1); PG8_STAGE(PG8_SB(1, 0), b3, voffB); PG8_STAGE(PG8_SB(1, 1), b3 + hstepB, voffB); PG8_STAGE(PG8_SA(1, 0), a3, voffA);
            PG8_WAIT_V(8); PG8_WAIT_L(0); PG8_BAR; PG8_MMA(1, 0, At, B0); PG8_MMA(1, 1, At, B1); PG8_BAR; PG8_SCHED;
            } else {
            PG8_LDB(B0, 0, 0); PG8_SCHED; PG8_LDA(At, 0, 0); PG8_STAGE(PG8_SA(1, 1), a1 + hstepA, voffA);
            PG8_WAIT_L(8); PG8_BAR; PG8_WAIT_L(0); PG8_MMA(0, 0, At, B0); PG8_BAR; PG8_SCHED;
            PG8_LDB(B1, 0, 1); PG8_STAGE(PG8_SB(0, 0), b2, voffB);
            PG8_BAR; PG8_WAIT_L(0); PG8_MMA(0, 1, At, B1); PG8_BAR;
            PG8_LDA(At, 0, 1); PG8_STAGE(PG8_SA(0, 0), a2, voffA);
            PG8_BAR; PG8_WAIT_L(0); PG8_MMA(1, 0, At, B0); PG8_BAR; PG8_SCHED;
            PG8_STAGE(PG8_SB(0, 1), b2 + hstepB, voffB);
            PG8_WAIT_V(6); PG8_BAR; PG8_MMA(1, 1, At, B1); PG8_BAR;
            PG8_LDB(B0, 1, 0); PG8_SCHED; PG8_LDA(At, 1, 0); PG8_STAGE(PG8_SA(0, 1), a2 + hstepA, voffA);
            PG8_WAIT_L(8); PG8_BAR; PG8_WAIT_L(0); PG8_MMA(0, 0, At, B0); PG8_BAR; PG8_SCHED;
            PG8_LDB(B1, 1, 1); PG8_STAGE(PG8_SB(1, 0), b3, voffB);
            PG8_BAR; PG8_WAIT_L(0); PG8_MMA(0, 1, At, B1); PG8_BAR;
            PG8_LDA(At, 1, 1); PG8_STAGE(PG8_SA(1, 0), a3, voffA);
            PG8_BAR; PG8_WAIT_L(0); PG8_MMA(1, 0, At, B0); PG8_BAR; PG8_SCHED;
            PG8_STAGE(PG8_SB(1, 1), b3 + hstepB, voffB);
            PG8_WAIT_V(6); PG8_BAR; PG8_MMA(1, 1, At, B1); PG8_BAR;
            }
        }
        if constexpr (ALIGN_EPI) { if (wr == 0) PG8_BAR; }
        if constexpr (Epi::I8) E(acc, cur, wr, wc, fr, fq, (const PG8_LAS float*)(lds + SCB_OFF + (ui & 1) * 2048)); else E(acc, cur, wr, wc, fr, fq);
        S.done(cur);
        if (!has_next) break;
#pragma unroll
        for (int a = 0; a < 2; ++a)
#pragma unroll
            for (int b = 0; b < 2; ++b)
#pragma unroll
                for (int m = 0; m < 4; ++m)
#pragma unroll
                    for (int n = 0; n < 2; ++n) acc[a][b][m][n] = acc_t{};
        cur = nxt; cA = nA; cB = nB; ++ui;
        if constexpr (Epi::I8) stage_scales(lds + SCB_OFF + (ui & 1) * 2048, E.cs + (size_t)cur.pn * BM, E.rs + (size_t)cur.pm * BM, tid, wid);
        if constexpr (ALIGN_EPI) { if (wr == 1) PG8_BAR; }
    }
    PG8_WAIT_V(0);
    if constexpr (!ALIGN_EPI) { if (wr == 0) PG8_BAR; }
    PG8_BAR;
#undef PG8_SA
#undef PG8_SB
#undef PG8_STAGE
#undef PG8_LDA
#undef PG8_LDB
#undef PG8_MMA
#undef PG8_WAIT_V
#undef PG8_WAIT_L
#undef PG8_BAR
#undef PG8_SCHED
#undef PG8_ABASE
#undef PG8_BBASE
}
}

constexpr int NWAVES = 8;
constexpr int N_LAUNCHES = MK_N_LAUNCHES;
constexpr int NPH = 13;
constexpr int BATCH = 2, SEQ = 8192, D = 4096, M = BATCH * SEQ;
constexpr int NIN = 5 * D;
constexpr int DFF = 11008, NGU = 2 * DFF;
constexpr int NMOD = 6 * D;
constexpr int HEADS = 16, HD = 256, PGRP = 4, PGD = 1024;
constexpr float RMS_EPS = 1e-6f;
constexpr int SCAN_T = 128, SCAN_NC = SEQ / SCAN_T;

constexpr size_t MiB = 1u << 20;
constexpr size_t WS_CTL = 0, CTL_ZERO_BYTES = 1 * MiB;
constexpr size_t WS_MOD = 1 * MiB;
constexpr size_t WS_SP8 = WS_MOD + 256 * 1024;
constexpr size_t WS_CP = WS_MOD + 512 * 1024;
constexpr size_t WS_WRG = 2 * MiB;
constexpr size_t WS_WPOOL = 6 * MiB;
constexpr size_t WS_WBL = 14 * MiB;
constexpr size_t WS_WBP = 46 * MiB;
constexpr size_t WS_WO = 78 * MiB;
constexpr size_t WS_WIN = 110 * MiB;
constexpr size_t WS_XC = 110 * MiB;
constexpr size_t WS_MERGED = 110 * MiB;
constexpr size_t WS_SCANC = 240 * MiB;
constexpr size_t WS_U = 270 * MiB;
constexpr size_t WS_POOLED = 270 * MiB;
constexpr size_t WS_PROJ = 398 * MiB;
constexpr size_t WS_WGU = 398 * MiB;
constexpr size_t WS_WDN = 570 * MiB;
constexpr size_t WS_H = 656 * MiB;
constexpr size_t WS_AU = 1038 * MiB;
constexpr size_t WS_Y = 1038 * MiB;
constexpr size_t WS_Y2 = 1166 * MiB;
constexpr size_t WS_YL = 1294 * MiB;
constexpr size_t WS_X1B = 1294 * MiB;
constexpr size_t WS_YP = 1422 * MiB;
constexpr size_t WS_END = 1550 * MiB;
static_assert(WS_WIN + (size_t)NIN * D * 2 <= WS_U && WS_SCANC + 4 * MiB <= WS_U && WS_XC + (size_t)M * D * 2 <= WS_SCANC, "ws map 1");
static_assert(WS_U + (size_t)M * D * 2 <= WS_PROJ && WS_PROJ + (size_t)M * NIN * 2 <= WS_AU, "ws map 2");
static_assert(WS_WGU + (size_t)NGU * D * 2 <= WS_WDN && WS_WDN + (size_t)D * DFF * 2 <= WS_H && WS_H + (size_t)M * DFF * 2 <= WS_AU, "ws map 3");
static_assert(WS_AU + (size_t)M * D * 4 <= WS_YL && WS_Y2 + (size_t)M * D * 2 <= WS_YL && WS_YP + (size_t)M * D * 2 <= WS_END, "ws map 4");
constexpr int CW_TMO = 0;
constexpr int CW_BAR = 4096;

constexpr int RING_OFF = 0, RING_BYTES = 131072;
constexpr int LDSCTL_OFF = RING_BYTES, MISC_OFF = LDSCTL_OFF + 320;
constexpr int LDS_BYTES = 147456;
static_assert(MISC_OFF + 128 <= LDS_BYTES, "LDS map");

#define GAS __attribute__((address_space(1)))
#define LAS __attribute__((address_space(3)))
typedef unsigned short bf16;
typedef unsigned v4u __attribute__((ext_vector_type(4)));
typedef unsigned v2u __attribute__((ext_vector_type(2)));
typedef float f32x4 __attribute__((ext_vector_type(4)));
typedef float f32x2 __attribute__((ext_vector_type(2)));
typedef GAS unsigned gu32;
#define RLX_AGENT __ATOMIC_RELAXED, __HIP_MEMORY_SCOPE_AGENT
#define LDS_WAIT() asm volatile("s_waitcnt lgkmcnt(0)" ::: "memory")
#define VM_WAIT() asm volatile("s_waitcnt vmcnt(0)" ::: "memory")
using pg8::cvt_pk_bf16; using pg8::bf_lo; using pg8::bf_hi;

#define XB_TMO      128
#define XB_XCNT(j)  (256  + 64 * (j))
#define XB_XSUB(j)  (1280 + 64 * (j))
#define XB_XGEN(j)  (2304 + 64 * (j))
#define XB_TOP      3328
#define XB_TOPGEN   3392
#define XCD_BAR_WORDS 3456
#define XB_SPIN_CAP (1u << 18)

__device__ __forceinline__ unsigned xb_ld(unsigned* p)              { return __hip_atomic_load(p, __ATOMIC_RELAXED, __HIP_MEMORY_SCOPE_AGENT); }
__device__ __forceinline__ unsigned xb_add(unsigned* p, unsigned v) { return __hip_atomic_fetch_add(p, v, __ATOMIC_RELAXED, __HIP_MEMORY_SCOPE_AGENT); }
__device__ __forceinline__ unsigned xb_xcc_id() { return (unsigned)__builtin_amdgcn_s_getreg((3 << 11) | 20) & 0xFu; }
#define XB_SPIN(cond, bar) do { unsigned _sp = 0; while (cond) { __builtin_amdgcn_s_sleep(1); \
    if ((++_sp & 255u) == 0u) { if (xb_ld(&(bar)[XB_TMO])) break; if (_sp > XB_SPIN_CAP) { atomicAdd(&(bar)[XB_TMO], 1u); break; } } } } while (0)

struct XcdBarrier {
    unsigned* bar; unsigned x;
    volatile LAS unsigned* st;
};
__device__ __forceinline__ XcdBarrier xcd_barrier_post(unsigned* bar, volatile LAS unsigned* st) {
    XcdBarrier b; b.bar = bar; b.x = xb_xcc_id(); b.st = st;
    if (threadIdx.x == 0) (void)xb_add(&bar[XB_XCNT(b.x)], 1u);
    return b;
}
__device__ __forceinline__ void xcd_barrier_complete(unsigned* bar, unsigned x, unsigned& nloc, unsigned& nx) {
    const unsigned G = gridDim.x * gridDim.y * gridDim.z;
    unsigned sum, cnt, mine, sp = 0u;
    for (;;) {
        sum = 0u; cnt = 0u; mine = 0u;
#pragma unroll
        for (unsigned j = 0; j < 16; ++j) { const unsigned c = xb_ld(&bar[XB_XCNT(j)]); sum += c; cnt += (c > 0u) ? 1u : 0u; mine = (j == x) ? c : mine; }
        if (sum == G) break;
        __builtin_amdgcn_s_sleep(1);
        if ((++sp & 255u) == 0u) { if (xb_ld(&bar[XB_TMO])) break; if (sp > XB_SPIN_CAP) { atomicAdd(&bar[XB_TMO], 1u); break; } }
    }
    nloc = mine > 0u ? mine : 1u; nx = cnt > 0u ? cnt : 1u;
}
__device__ __forceinline__ void xcd_barrier(const XcdBarrier& b) {
    asm volatile("s_waitcnt vmcnt(0)" ::: "memory");
    __syncthreads();
    if (threadIdx.x == 0) {
        unsigned* bar = b.bar;
        __builtin_amdgcn_s_waitcnt(0);
        unsigned nloc = b.st[0], nx = b.st[1];
        if (nloc == 0u) { xcd_barrier_complete(bar, b.x, nloc, nx); b.st[0] = nloc; b.st[1] = nx; }
        const unsigned old = xb_add(&bar[XB_XSUB(b.x)], 1u);
        const unsigned gen = old / nloc;
        if (old + 1u == (gen + 1u) * nloc) {
            __builtin_amdgcn_fence(__ATOMIC_RELEASE, "agent");
            asm volatile("s_waitcnt vmcnt(0)" ::: "memory");
            const unsigned og = xb_add(&bar[XB_TOP], 1u);
            const unsigned tg = og / nx;
            if (og + 1u == (tg + 1u) * nx) xb_add(&bar[XB_TOPGEN], 1u);
            else XB_SPIN(xb_ld(&bar[XB_TOPGEN]) == tg, bar);
            __builtin_amdgcn_fence(__ATOMIC_ACQUIRE, "agent");
            xb_add(&bar[XB_XGEN(b.x)], 1u);
            asm volatile("s_waitcnt vmcnt(0)" ::: "memory");
        } else {
            XB_SPIN(xb_ld(&bar[XB_XGEN(b.x)]) == gen, bar);
            __builtin_amdgcn_fence(__ATOMIC_ACQUIRE, "agent");
            asm volatile("s_waitcnt vmcnt(0)" ::: "memory");
        }
    }
    __syncthreads();
}

__device__ __forceinline__ float wave_sum(float v) {
#pragma unroll
    for (int o = 1; o < 64; o <<= 1) v += __shfl_xor(v, o);
    return v;
}
__device__ __forceinline__ float dot4(f32x4 a) { return (a.x * a.x + a.y * a.y) + (a.z * a.z + a.w * a.w); }

__device__ __forceinline__ void transpose_item(const float* W, int N, bf16* WT, int ldk, int k0, int n0, int drow0, LAS float* scr, int lane) {
#pragma unroll 8
    for (int i = 0; i < 32; ++i) { const int kk = 2 * i + (lane >> 5); scr[kk * 33 + (lane & 31)] = W[(size_t)(k0 + kk) * N + n0 + (lane & 31)]; }
    LDS_WAIT(); asm volatile("" ::: "memory");
    const int c = lane & 7;
#pragma unroll
    for (int j = 0; j < 4; ++j) { const int n = (lane >> 3) + 8 * j; const LAS float* s = scr + (8 * c) * 33 + n;
        v4u o;
        { o.x = cvt_pk_bf16(s[0 * 33], s[1 * 33]); o.y = cvt_pk_bf16(s[2 * 33], s[3 * 33]); o.z = cvt_pk_bf16(s[4 * 33], s[5 * 33]); o.w = cvt_pk_bf16(s[6 * 33], s[7 * 33]); }
        *(v4u*)(WT + (size_t)(drow0 + n) * ldk + k0 + 8 * c) = o; }
    LDS_WAIT(); asm volatile("" ::: "memory");
}
__device__ __forceinline__ void tr_load(float (&v)[32], const float* W, int N, int k0, int n0, int lane) {
    const float* wp = W + (size_t)(k0 + (lane >> 5)) * N + n0 + (lane & 31);
#pragma unroll
    for (int i = 0; i < 32; ++i) v[i] = wp[(size_t)(2 * i) * N];
}
__device__ __forceinline__ void tr_finish(const float (&v)[32], bf16* WT, int ldk, int k0, int drow0, LAS float* scr, int lane) {
#pragma unroll
    for (int i = 0; i < 32; ++i) scr[(2 * i + (lane >> 5)) * 33 + (lane & 31)] = v[i];
    LDS_WAIT(); asm volatile("" ::: "memory");
    const int c = lane & 7;
#pragma unroll
    for (int j = 0; j < 4; ++j) { const int n = (lane >> 3) + 8 * j; const LAS float* s = scr + (8 * c) * 33 + n;
        v4u o;
        { o.x = cvt_pk_bf16(s[0 * 33], s[1 * 33]); o.y = cvt_pk_bf16(s[2 * 33], s[3 * 33]); o.z = cvt_pk_bf16(s[4 * 33], s[5 * 33]); o.w = cvt_pk_bf16(s[6 * 33], s[7 * 33]); }
        *(v4u*)(WT + (size_t)(drow0 + n) * ldk + k0 + 8 * c) = o; }
    LDS_WAIT(); asm volatile("" ::: "memory");
}
template <int DMAP>
__device__ __forceinline__ void transpose_matrix(const float* W, int K, int N, bf16* WT, int ldk, int drow_off, LAS float* scr, int lane, int gw, int NGW, int& itbase, int ncols = 0) {
    const int nblk = (ncols ? ncols : N) / 32, nitems = (K / 64) * nblk;
    int it = gw - (itbase % NGW); if (it < 0) it += NGW;
    itbase += nitems;
    if (it >= nitems) return;
#define TR_MAP(it_, k0_, n0_, dr_) do { const int kb_ = (it_) / nblk, nb_ = (it_) % nblk; k0_ = 64 * kb_; n0_ = 32 * nb_; \
        if (DMAP == 1) { const int isup_ = n0_ >= DFF ? 1 : 0, j_ = n0_ - isup_ * DFF; dr_ = drow_off + (j_ >> 7) * 256 + isup_ * 128 + (j_ & 127); } else dr_ = drow_off + n0_; } while (0)
    float va[32], vb[32]; int ka, na, da, kb2 = 0, nb2 = 0, db = 0;
    TR_MAP(it, ka, na, da); tr_load(va, W, N, ka, na, lane);
#pragma unroll 1
    while (true) {
        const int itb = it + NGW; const bool hb = itb < nitems;
        if (hb) { TR_MAP(itb, kb2, nb2, db); tr_load(vb, W, N, kb2, nb2, lane); }
        tr_finish(va, WT, ldk, ka, da, scr, lane);
        if (!hb) break;
        it = itb + NGW; const bool ha = it < nitems;
        if (ha) { TR_MAP(it, ka, na, da); tr_load(va, W, N, ka, na, lane); }
        tr_finish(vb, WT, ldk, kb2, db, scr, lane);
        if (!ha) break;
    }
#undef TR_MAP
}

__device__ __forceinline__ void unpack4(const v2u q, float (&f)[4]) { f[0] = bf_lo(q.x); f[1] = bf_hi(q.x); f[2] = bf_lo(q.y); f[3] = bf_hi(q.y); }
template <int W>
__device__ __forceinline__ void conv_pool_chunk(const bf16* PROJ, bf16* XC, bf16* POOLED, const float* conv_w, const float* conv_b, int chunk, int ch0) {
    float cw[4][4], cb[4];
#pragma unroll
    for (int k = 0; k < 4; ++k) { const f32x4 a = *(const f32x4*)(conv_w + k * D + ch0); cw[k][0] = a.x; cw[k][1] = a.y; cw[k][2] = a.z; cw[k][3] = a.w; }
    { const f32x4 a = *(const f32x4*)(conv_b + ch0); cb[0] = a.x; cb[1] = a.y; cb[2] = a.z; cb[3] = a.w; }
    const size_t row0 = (size_t)chunk * 64; const int t0 = (int)(row0 % SEQ);
    const bf16* pr = PROJ + row0 * NIN + ch0;
    float cx[4][4];
    v2u ph[W];
    float s[4];
#pragma unroll
    for (int j = 0; j < 4; ++j) s[j] = 0.f;
#pragma unroll
    for (int q = 0; q < 4; ++q)
#pragma unroll
        for (int j = 0; j < 4; ++j) cx[q][j] = 0.f;
#pragma unroll
    for (int q = 0; q < W; ++q) ph[q] = (v2u){0u, 0u};
    if (t0 > 0) {
#pragma unroll
        for (int q = 1; q <= 3; ++q) { const v2u x = *(const v2u*)(pr - (ptrdiff_t)q * NIN); unpack4(x, cx[(64 - q) & 3]); }
#pragma unroll
        for (int q = 1; q < W; ++q) { const v2u x = *(const v2u*)(pr + 2 * D - (ptrdiff_t)q * NIN); ph[(64 - q) & (W - 1)] = x; float f[4]; unpack4(x, f);
#pragma unroll
            for (int j = 0; j < 4; ++j) s[j] += f[j]; }
    }
    const bf16* p = pr; bf16* xo = XC + row0 * D + ch0; bf16* po = POOLED + row0 * D + ch0;
#pragma unroll 1
    for (int rb = 0; rb < 4; ++rb) {
#pragma unroll
        for (int h8 = 0; h8 < 2; ++h8) {
            v2u xnb[8], pnb[8];
#pragma unroll
            for (int q = 0; q < 8; ++q) { xnb[q] = *(const v2u*)(p + (size_t)q * NIN); pnb[q] = *(const v2u*)(p + (size_t)q * NIN + 2 * D); }
#pragma unroll
            for (int q = 0; q < 8; ++q) { const int rr = h8 * 8 + q; const int r = rb * 16 + rr;
                const v2u xn = xnb[q], pn = pnb[q];
                float xf[4]; unpack4(xn, xf);
                float a[4];
#pragma unroll
                for (int j = 0; j < 4; ++j) a[j] = cb[j] + cw[0][j] * cx[(rr + 1) & 3][j] + cw[1][j] * cx[(rr + 2) & 3][j] + cw[2][j] * cx[(rr + 3) & 3][j] + cw[3][j] * xf[j];
#pragma unroll
                for (int j = 0; j < 4; ++j) cx[rr & 3][j] = xf[j];
                { v2u o; o.x = cvt_pk_bf16(a[0], a[1]); o.y = cvt_pk_bf16(a[2], a[3]); *(v2u*)(xo + (size_t)q * D) = o; }
                float pf[4], of[4]; unpack4(pn, pf); unpack4(ph[rr & (W - 1)], of);
                ph[rr & (W - 1)] = pn;
                const int t = t0 + r; const int cnt = (t + 1 < W) ? (t + 1) : W; const float inv = 1.0f / (float)cnt;
#pragma unroll
                for (int j = 0; j < 4; ++j) { s[j] += pf[j] - of[j]; a[j] = s[j] * inv - pf[j]; }
                { v2u o; o.x = cvt_pk_bf16(a[0], a[1]); o.y = cvt_pk_bf16(a[2], a[3]); *(v2u*)(po + (size_t)q * D) = o; }
            }
            p += 8 * NIN; xo += 8 * D; po += 8 * D;
            asm volatile("" ::: "memory");
        }
    }
}

constexpr int RG_PITCH = 544;
template <int CTRL> __device__ __forceinline__ float dpp_row(float identity, float v) {
    return __int_as_float(__builtin_amdgcn_update_dpp(__float_as_int(identity), __float_as_int(v), CTRL, 0xf, 0xf, false)); }
constexpr int LRU_XOFF = 36864;
__device__ __forceinline__ void lru_fused(const bf16* XC, const bf16* Wrg_t, const bf16* PROJ, bf16* YL, const float* b_a, const float* b_x, const float* sp8,
                                          LAS unsigned char* lds, int tid, int lane, int wave, int vcu, int G) {
    typedef pg8::bf16x8 bf16x8;
    const int fr = lane & 15, fq = lane >> 4;
    for (int vq = vcu; vq < 256; vq += G) {
        const int h = vq >> 4, s = (vq >> 1) & 7, bsel = vq & 1;
        __syncthreads();
        { const int n = tid >> 3, p = tid & 7, chl = s * 32 + (n & 31), srow = h * 512 + (chl >> 7) * 256 + (n >> 5) * 128 + (chl & 127);
          const v4u* src = (const v4u*)(Wrg_t + (size_t)srow * HD + p * 32); LAS v4u* dst = (LAS v4u*)(lds + n * RG_PITCH + p * 64);
#pragma unroll
          for (int q = 0; q < 4; ++q) dst[q] = src[q]; }
        __syncthreads();
        const int c0 = h * HD + s * 32;
        f32x4 ba[2], bx[2], sp[2];
#pragma unroll
        for (int c2 = 0; c2 < 2; ++c2) { const int ch = c0 + 16 * c2 + 4 * fq; ba[c2] = *(const f32x4*)(b_a + ch); bx[c2] = *(const f32x4*)(b_x + ch); sp[c2] = *(const f32x4*)(sp8 + ch) * 1.44269504088896f; }
        const bf16* abase = XC + h * HD + 8 * fq; const bf16* xbase = XC + c0 + 4 * fq; const bf16* gbase = PROJ + D + c0 + 4 * fq; bf16* obase = YL + c0 + 4 * fq;
        const LAS unsigned char* bl = lds + fr * RG_PITCH + 16 * fq;
        LAS float* xch = (LAS float*)(lds + LRU_XOFF);
        bf16x8 af[2][8]; v2u xq[2][2], gq[2][2];
        { const size_t row0 = (size_t)bsel * SEQ + (size_t)wave * 32;
#pragma unroll
          for (int r2 = 0; r2 < 2; ++r2) { const size_t ro = (row0 + 16 * r2 + fr) * D, rg = (row0 + 16 * r2 + fr) * NIN;
#pragma unroll
              for (int kb = 0; kb < 8; ++kb) af[r2][kb] = *(const bf16x8*)(abase + ro + 32 * kb);
#pragma unroll
              for (int c2 = 0; c2 < 2; ++c2) { xq[r2][c2] = *(const v2u*)(xbase + ro + 16 * c2); gq[r2][c2] = *(const v2u*)(gbase + rg + 16 * c2); } } }
#pragma unroll 1
        for (int i = 0; i < SEQ / 256; ++i) {
            const size_t row0 = (size_t)bsel * SEQ + (size_t)i * 256 + (size_t)wave * 32;
            f32x4 acc[2][4];
#pragma unroll
            for (int r2 = 0; r2 < 2; ++r2)
#pragma unroll
                for (int cb = 0; cb < 4; ++cb) acc[r2][cb] = (f32x4){0.f, 0.f, 0.f, 0.f};
            {
                bf16x8 bq[2][4];
#pragma unroll
                for (int cb = 0; cb < 4; ++cb) bq[0][cb] = *(const LAS bf16x8*)(bl + cb * 16 * RG_PITCH);
#pragma unroll
                for (int kb = 0; kb < 8; ++kb) {
                    if (kb + 1 < 8) {
#pragma unroll
                        for (int cb = 0; cb < 4; ++cb) bq[(kb + 1) & 1][cb] = *(const LAS bf16x8*)(bl + cb * 16 * RG_PITCH + (kb + 1) * 64); }
                    __builtin_amdgcn_sched_barrier(0);
#pragma unroll
                    for (int cb = 0; cb < 4; ++cb)
#pragma unroll
                        for (int r2 = 0; r2 < 2; ++r2) acc[r2][cb] = __builtin_amdgcn_mfma_f32_16x16x32_bf16(bq[kb & 1][cb], af[r2][kb], acc[r2][cb], 0, 0, 0);
                    __builtin_amdgcn_sched_barrier(0);
                }
            }
            v2u xqn[2][2], gqn[2][2];
            { const size_t rown = (i + 1 < SEQ / 256) ? row0 + 256 : row0;
#pragma unroll
                for (int r2 = 0; r2 < 2; ++r2) { const size_t ro = (rown + 16 * r2 + fr) * D, rg = (rown + 16 * r2 + fr) * NIN;
#pragma unroll
                    for (int kb = 0; kb < 8; ++kb) af[r2][kb] = *(const bf16x8*)(abase + ro + 32 * kb);
#pragma unroll
                    for (int c2 = 0; c2 < 2; ++c2) { xqn[r2][c2] = *(const v2u*)(xbase + ro + 16 * c2); gqn[r2][c2] = *(const v2u*)(gbase + rg + 16 * c2); } } }
            float A[2][2][4], U[2][2][4];
#pragma unroll
            for (int r2 = 0; r2 < 2; ++r2)
#pragma unroll
                for (int c2 = 0; c2 < 2; ++c2) { const f32x4 rp = acc[r2][c2] + ba[c2], ip = acc[r2][c2 + 2] + bx[c2]; const v2u xw = xq[r2][c2];
                    const float xv[4] = {bf_lo(xw.x), bf_hi(xw.x), bf_lo(xw.y), bf_hi(xw.y)};
#pragma unroll
                    for (int j = 0; j < 4; ++j) { const float r = pg8::sigmoidf_(rp[j]), ig = pg8::sigmoidf_(ip[j]);
                        const float av = __builtin_amdgcn_exp2f(sp[c2][j] * r);
                        A[r2][c2][j] = av; U[r2][c2][j] = __builtin_amdgcn_sqrtf(fmaxf(__builtin_fmaf(-av, av, 1.0f), 0.0f)) * (ig * xv[j]); } }
#define LRU_STEP(d) \
                        "v_fmac_f32_dpp %4, %4, %0 row_shr:" #d " row_mask:0xf bank_mask:0xf\n\tv_mul_f32_dpp %0, %0, %0 row_shr:" #d " row_mask:0xf bank_mask:0xf\n\t" \
                        "v_fmac_f32_dpp %5, %5, %1 row_shr:" #d " row_mask:0xf bank_mask:0xf\n\tv_mul_f32_dpp %1, %1, %1 row_shr:" #d " row_mask:0xf bank_mask:0xf\n\t" \
                        "v_fmac_f32_dpp %6, %6, %2 row_shr:" #d " row_mask:0xf bank_mask:0xf\n\tv_mul_f32_dpp %2, %2, %2 row_shr:" #d " row_mask:0xf bank_mask:0xf\n\t" \
                        "v_fmac_f32_dpp %7, %7, %3 row_shr:" #d " row_mask:0xf bank_mask:0xf\n\tv_mul_f32_dpp %3, %3, %3 row_shr:" #d " row_mask:0xf bank_mask:0xf\n\t"
#pragma unroll
            for (int r2 = 0; r2 < 2; ++r2)
#pragma unroll
                for (int c2 = 0; c2 < 2; ++c2)
                    asm volatile("s_nop 1\n\t" LRU_STEP(1) LRU_STEP(2) LRU_STEP(4) LRU_STEP(8)
                                 : "+v"(A[r2][c2][0]), "+v"(A[r2][c2][1]), "+v"(A[r2][c2][2]), "+v"(A[r2][c2][3]), "+v"(U[r2][c2][0]), "+v"(U[r2][c2][1]), "+v"(U[r2][c2][2]), "+v"(U[r2][c2][3]));
#undef LRU_STEP
            const int l15 = (lane & 48) | 15;
#pragma unroll
            for (int c2 = 0; c2 < 2; ++c2)
#pragma unroll
                for (int j = 0; j < 4; ++j) { const float a15 = __shfl(A[0][c2][j], l15), u15 = __shfl(U[0][c2][j], l15);
                    U[1][c2][j] = A[1][c2][j] * u15 + U[1][c2][j]; A[1][c2][j] = A[1][c2][j] * a15; }
            LAS float* xp = xch + (i & 1) * 512;
            if (fr == 15) {
#pragma unroll
                for (int c2 = 0; c2 < 2; ++c2) { *(LAS f32x4*)(xp + wave * 32 + 16 * c2 + 4 * fq) = (f32x4){A[1][c2][0], A[1][c2][1], A[1][c2][2], A[1][c2][3]};
                    *(LAS f32x4*)(xp + 256 + wave * 32 + 16 * c2 + 4 * fq) = (f32x4){U[1][c2][0], U[1][c2][1], U[1][c2][2], U[1][c2][3]}; } }
            asm volatile("s_waitcnt lgkmcnt(0)" ::: "memory"); __builtin_amdgcn_s_barrier(); asm volatile("" ::: "memory");
            LAS float* cinp = xch + 1024 + (i & 1) * 32;
            f32x4 hin[2];
#pragma unroll
            for (int c2 = 0; c2 < 2; ++c2) hin[c2] = (i == 0) ? (f32x4){0.f, 0.f, 0.f, 0.f} : *(const LAS f32x4*)(cinp + 16 * c2 + 4 * fq);
#pragma unroll
            for (int w = 0; w < NWAVES - 1; ++w) if (w < wave) {
#pragma unroll
                for (int c2 = 0; c2 < 2; ++c2) { const f32x4 P = *(const LAS f32x4*)(xp + w * 32 + 16 * c2 + 4 * fq), Hh = *(const LAS f32x4*)(xp + 256 + w * 32 + 16 * c2 + 4 * fq);
                    hin[c2] = P * hin[c2] + Hh; } }
            if (wave == NWAVES - 1 && fr == 0) {
                LAS float* cout = xch + 1024 + ((i + 1) & 1) * 32;
#pragma unroll
                for (int c2 = 0; c2 < 2; ++c2) { const f32x4 P = *(const LAS f32x4*)(xp + (NWAVES - 1) * 32 + 16 * c2 + 4 * fq), Hh = *(const LAS f32x4*)(xp + 256 + (NWAVES - 1) * 32 + 16 * c2 + 4 * fq);
                    *(LAS f32x4*)(cout + 16 * c2 + 4 * fq) = P * hin[c2] + Hh; } }
#pragma unroll
            for (int r2 = 0; r2 < 2; ++r2) { const size_t ro = (row0 + 16 * r2 + fr) * D;
#pragma unroll
                for (int c2 = 0; c2 < 2; ++c2) { const v2u gw = gq[r2][c2]; const float gg[4] = {bf_lo(gw.x), bf_hi(gw.x), bf_lo(gw.y), bf_hi(gw.y)}; float y[4];
#pragma unroll
                    for (int j = 0; j < 4; ++j) { const float hh = U[r2][c2][j] + A[r2][c2][j] * hin[c2][j]; const float gx = gg[j], gz = gx * __builtin_fmaf(gx * gx, -0.10294324f, -2.30220819f);
                        y[j] = hh * gx * pg8::fast_rcp(1.0f + __builtin_amdgcn_exp2f(gz)); }
                    v2u o; o.x = cvt_pk_bf16(y[0], y[1]); o.y = cvt_pk_bf16(y[2], y[3]); *(v2u*)(obase + ro + 16 * c2) = o; } }
#pragma unroll
            for (int r2 = 0; r2 < 2; ++r2)
#pragma unroll
                for (int c2 = 0; c2 < 2; ++c2) { xq[r2][c2] = xqn[r2][c2]; gq[r2][c2] = gqn[r2][c2]; }
        }
    }
    __syncthreads();
}

__device__ __forceinline__ unsigned q8(float v, float inv) { const float q = fminf(fmaxf(__builtin_rintf(v * inv), -127.f), 127.f); return (unsigned)(int)q & 0xffu; }
__device__ __forceinline__ unsigned pack_q8(float a, float b, float c, float d, float inv) { return q8(a, inv) | (q8(b, inv) << 8) | (q8(c, inv) << 16) | (q8(d, inv) << 24); }
template <int CTRL, int BANK, bool BC> __device__ __forceinline__ float dpp_mov(float old, float src) {
    return __builtin_bit_cast(float, __builtin_amdgcn_update_dpp(__builtin_bit_cast(int, old), __builtin_bit_cast(int, src), CTRL, 0xF, BANK, BC)); }
__device__ __forceinline__ float xlane1(float t) { return dpp_mov<0xB1, 0xF, true>(0.f, t); }
__device__ __forceinline__ float xlane2(float t) { return dpp_mov<0x4E, 0xF, true>(0.f, t); }
__device__ __forceinline__ float xlane4(float t) { const float r = dpp_mov<0x104, 0x5, false>(t, t); return dpp_mov<0x114, 0xA, false>(r, t); }
__device__ __forceinline__ float xlane8(float t) { return dpp_mov<0x128, 0xF, true>(0.f, t); }
struct RotSigns { float s1, s2, s4, s8; };
__device__ __forceinline__ RotSigns rot_signs(int lane) { return RotSigns{(lane & 1) ? -1.f : 1.f, (lane & 2) ? -1.f : 1.f, (lane & 4) ? -1.f : 1.f, (lane & 8) ? -1.f : 1.f}; }
__device__ __forceinline__ f32x4 rot64(f32x4 t, const RotSigns sg) {
    { const float p0 = t.x + t.y, p1 = t.x - t.y, p2 = t.z + t.w, p3 = t.z - t.w; t = (f32x4){p0 + p2, p1 + p3, p0 - p2, p1 - p3}; }
    t = (f32x4){__builtin_fmaf(sg.s1, t.x, xlane1(t.x)), __builtin_fmaf(sg.s1, t.y, xlane1(t.y)), __builtin_fmaf(sg.s1, t.z, xlane1(t.z)), __builtin_fmaf(sg.s1, t.w, xlane1(t.w))};
    t = (f32x4){__builtin_fmaf(sg.s2, t.x, xlane2(t.x)), __builtin_fmaf(sg.s2, t.y, xlane2(t.y)), __builtin_fmaf(sg.s2, t.z, xlane2(t.z)), __builtin_fmaf(sg.s2, t.w, xlane2(t.w))};
    t = (f32x4){__builtin_fmaf(sg.s4, t.x, xlane4(t.x)), __builtin_fmaf(sg.s4, t.y, xlane4(t.y)), __builtin_fmaf(sg.s4, t.z, xlane4(t.z)), __builtin_fmaf(sg.s4, t.w, xlane4(t.w))};
    t = (f32x4){__builtin_fmaf(sg.s8, t.x, xlane8(t.x)), __builtin_fmaf(sg.s8, t.y, xlane8(t.y)), __builtin_fmaf(sg.s8, t.z, xlane8(t.z)), __builtin_fmaf(sg.s8, t.w, xlane8(t.w))};
    return t * 0.125f;
}
__device__ __forceinline__ unsigned pack_q8m(float a, float b, float c, float d, float inv) {
    const unsigned ua = __float_as_uint(__builtin_fmaf(a, inv, 12582912.0f)), ub = __float_as_uint(__builtin_fmaf(b, inv, 12582912.0f));
    const unsigned uc = __float_as_uint(__builtin_fmaf(c, inv, 12582912.0f)), ud = __float_as_uint(__builtin_fmaf(d, inv, 12582912.0f));
    return __builtin_amdgcn_perm(__builtin_amdgcn_perm(ud, uc, 0x0c0c0400u), __builtin_amdgcn_perm(ub, ua, 0x0c0c0400u), 0x05040100u);
}
__device__ __forceinline__ void rotq_row(f32x4 (&v)[16], unsigned* q8row, float* rsp, int lane) {
    float am = 0.f; const RotSigns sg = rot_signs(lane);
#pragma unroll
    for (int j = 0; j < 16; ++j) { v[j] = rot64(v[j], sg);
        am = fmaxf(fmaxf(am, fmaxf(fabsf(v[j].x), fabsf(v[j].y))), fmaxf(fabsf(v[j].z), fabsf(v[j].w))); }
#pragma unroll
    for (int o = 1; o < 64; o <<= 1) am = fmaxf(am, __shfl_xor(am, o));
    am = fmaxf(am, 1e-30f); const float qi = 127.0f / am;
#pragma unroll
    for (int j = 0; j < 16; ++j) q8row[lane + 64 * j] = pack_q8m(v[j].x, v[j].y, v[j].z, v[j].w, qi);
    if (lane == 0) *rsp = am * (1.0f / 127.0f);
}
__device__ __forceinline__ void transpose_item_rot(const float* W, int ld, bf16* WT, int ldk, int k0, int n0, int drow0, LAS float* scr, int lane, unsigned* cmax, int cidx0) {
#pragma unroll 8
    for (int i = 0; i < 32; ++i) { const int kk = 2 * i + (lane >> 5); scr[kk * 33 + (lane & 31)] = W[(size_t)(k0 + kk) * ld + n0 + (lane & 31)]; }
    LDS_WAIT(); asm volatile("" ::: "memory");
    const int nn = lane & 31, hf = lane >> 5;
#pragma unroll
    for (int b = 0; b < 6; ++b) {
#pragma unroll
        for (int i = 0; i < 16; ++i) { const int p = hf * 16 + i, lo = ((p >> b) << (b + 1)) | (p & ((1 << b) - 1)), hi = lo | (1 << b);
            const float xl = scr[lo * 33 + nn], xh = scr[hi * 33 + nn]; scr[lo * 33 + nn] = xl + xh; scr[hi * 33 + nn] = xl - xh; }
        LDS_WAIT(); asm volatile("" ::: "memory");
    }
    float am = 0.f;
#pragma unroll
    for (int i = 0; i < 32; ++i) am = fmaxf(am, fabsf(scr[(hf * 32 + i) * 33 + nn]));
    atomicMax(cmax + cidx0 + nn, __float_as_uint(am * 0.125f));
    const int c = lane & 7;
#pragma unroll
    for (int j = 0; j < 4; ++j) { const int n = (lane >> 3) + 8 * j; const LAS float* sp = scr + (8 * c) * 33 + n;
        v4u o; o.x = cvt_pk_bf16(sp[0 * 33] * 0.125f, sp[1 * 33] * 0.125f); o.y = cvt_pk_bf16(sp[2 * 33] * 0.125f, sp[3 * 33] * 0.125f);
        o.z = cvt_pk_bf16(sp[4 * 33] * 0.125f, sp[5 * 33] * 0.125f); o.w = cvt_pk_bf16(sp[6 * 33] * 0.125f, sp[7 * 33] * 0.125f);
        *(v4u*)(WT + (size_t)(drow0 + n) * ldk + k0 + 8 * c) = o; }
    LDS_WAIT(); asm volatile("" ::: "memory");
}

struct RotItem { int k0, n0, drow0; };
__device__ __forceinline__ void rot_load(float (&v)[32], const float* W, int ld, const RotItem r, int lane) {
    const float* wp = W + (size_t)(r.k0 + 32 * (lane >> 5)) * ld + r.n0 + (lane & 31);
#pragma unroll
    for (int i = 0; i < 32; ++i) v[i] = wp[(size_t)i * ld];
}
__device__ __forceinline__ void rot_finish(float (&v)[32], bf16* WT, int ldk, const RotItem r, LAS float* scr, int lane, unsigned* cmax) {
    const int nn = lane & 31, hf = lane >> 5;
#pragma unroll
    for (int b = 0; b < 5; ++b)
#pragma unroll
        for (int i = 0; i < 32; ++i) if (!(i & (1 << b))) { const float lo = v[i], hi = v[i | (1 << b)]; v[i] = lo + hi; v[i | (1 << b)] = lo - hi; }
    const float sg = hf ? -0.125f : 0.125f; float am = 0.f;
#pragma unroll
    for (int i = 0; i < 32; ++i) { const float pr = __shfl_xor(v[i], 32); v[i] = __builtin_fmaf(v[i], sg, pr * 0.125f); am = fmaxf(am, fabsf(v[i])); }
    am = fmaxf(am, __shfl_xor(am, 32));
    if (hf == 0) atomicMax(cmax + r.drow0 + nn, __float_as_uint(am));
#pragma unroll
    for (int i = 0; i < 32; ++i) scr[(32 * hf + i) * 33 + nn] = v[i];
    LDS_WAIT(); asm volatile("" ::: "memory");
    const int c = lane & 7;
#pragma unroll
    for (int j = 0; j < 4; ++j) { const int n = (lane >> 3) + 8 * j; const LAS float* sp = scr + (8 * c) * 33 + n;
        v4u o; o.x = cvt_pk_bf16(sp[0 * 33], sp[1 * 33]); o.y = cvt_pk_bf16(sp[2 * 33], sp[3 * 33]);
        o.z = cvt_pk_bf16(sp[4 * 33], sp[5 * 33]); o.w = cvt_pk_bf16(sp[6 * 33], sp[7 * 33]);
        *(v4u*)(WT + (size_t)(r.drow0 + n) * ldk + r.k0 + 8 * c) = o; }
    LDS_WAIT(); asm volatile("" ::: "memory");
}
template <class MapF>
__device__ __forceinline__ void rot_stream(const float* W, int ld, bf16* WT, int ldk, LAS float* scr, int lane, unsigned* cmax, int it, int nitems, int stride, const MapF map) {
    if (it >= nitems) return;
    float va[32], vb[32]; RotItem ra = map(it), rb = ra;
    rot_load(va, W, ld, ra, lane);
#pragma unroll 1
    while (true) {
        const int itb = it + stride; const bool hb = itb < nitems;
        if (hb) { rb = map(itb); rot_load(vb, W, ld, rb, lane); }
        rot_finish(va, WT, ldk, ra, scr, lane, cmax);
        if (!hb) break;
        it = itb + stride; const bool ha = it < nitems;
        if (ha) { ra = map(it); rot_load(va, W, ld, ra, lane); }
        rot_finish(vb, WT, ldk, rb, scr, lane, cmax);
        if (!ha) break;
    }
}
constexpr int QC0 = 2 * D, NQ = NIN - QC0;
struct MapGate { __device__ __forceinline__ RotItem operator()(int it) const { const int nblk = NQ / 32, kb = it / nblk, nb = it % nblk; return RotItem{64 * kb, 32 * nb, QC0 + 32 * nb}; } };
struct MapGU { __device__ __forceinline__ RotItem operator()(int it) const { const int nblk = NGU / 32, kb = it / nblk, nb = it % nblk, n0 = 32 * nb, isup = n0 >= DFF ? 1 : 0, j = n0 - isup * DFF;
    return RotItem{64 * kb, n0, (j >> 7) * 256 + isup * 128 + (j & 127)}; } };
constexpr int WGU_SHORT0 = (NGU / 16) % 256, WDN_P9_ITEMS = (256 - WGU_SHORT0) * 8 * 8;
struct MapDn { __device__ __forceinline__ RotItem operator()(int it) const { const int nblk = D / 32, kb = it / nblk, nb = it % nblk; return RotItem{64 * kb, 32 * nb, 32 * nb}; } };

template <class MapF>
__device__ __forceinline__ void strip_quant(const float* W, int ldw, unsigned char* W8o, float* cso, int nstrips, int s0, int sstride, LAS unsigned char* lds, int lane, int wave, const MapF map) {
    LAS unsigned char* sbuf = lds; LAS float* red = (LAS float*)(lds + RING_BYTES + 8192);
    const int nn = lane & 15, kh = lane >> 4;
    const float s16 = (kh & 1) ? -1.f : 1.f, s32 = (kh & 2) ? -0.125f : 0.125f;
    float va[16], vb[16];
    if (s0 >= nstrips) return;
    int n0, drow0; map(s0, n0, drow0);
    const float* wp = W + (size_t)(512 * wave + 16 * kh) * ldw + n0 + nn;
#pragma unroll
    for (int i = 0; i < 16; ++i) { va[i] = wp[(size_t)i * ldw]; vb[i] = wp[(size_t)(64 + i) * ldw]; }
    for (int strip = s0; strip < nstrips; strip += sstride) {
        float cm = 0.f;
#define SQ_LOAD(v, blk) do { _Pragma("unroll") for (int i = 0; i < 16; ++i) v[i] = wp[(size_t)(64 * (blk) + i) * ldw]; } while (0)
#define SQ_FIN(v, blk) do { \
        _Pragma("unroll") for (int b = 0; b < 4; ++b) _Pragma("unroll") for (int i = 0; i < 16; ++i) if (!(i & (1 << b))) { const float lo_ = v[i], hi_ = v[i | (1 << b)]; v[i] = lo_ + hi_; v[i | (1 << b)] = lo_ - hi_; } \
        _Pragma("unroll") for (int i = 0; i < 16; ++i) { const float pr_ = __shfl_xor(v[i], 16); v[i] = __builtin_fmaf(v[i], s16, pr_); } \
        _Pragma("unroll") for (int i = 0; i < 16; ++i) { const float pr_ = __shfl_xor(v[i], 32); v[i] = __builtin_fmaf(v[i], s32, pr_ * 0.125f); cm = fmaxf(cm, fabsf(v[i])); } \
        v4u p0_, p1_; p0_.x = cvt_pk_bf16(v[0], v[1]); p0_.y = cvt_pk_bf16(v[2], v[3]); p0_.z = cvt_pk_bf16(v[4], v[5]); p0_.w = cvt_pk_bf16(v[6], v[7]); \
        p1_.x = cvt_pk_bf16(v[8], v[9]); p1_.y = cvt_pk_bf16(v[10], v[11]); p1_.z = cvt_pk_bf16(v[12], v[13]); p1_.w = cvt_pk_bf16(v[14], v[15]); \
        LAS v4u* d_ = (LAS v4u*)(sbuf + (size_t)(((32 * wave + 4 * (blk) + kh) * 16 + nn) * 32)); d_[0] = p0_; d_[1] = p1_; } while (0)
#pragma unroll 1
        for (int blk = 0; blk < 8; blk += 2) {
            if (blk != 0) SQ_LOAD(vb, blk + 1);
            SQ_FIN(va, blk);
            if (blk + 2 < 8) SQ_LOAD(va, blk + 2);
            SQ_FIN(vb, blk + 1);
        }
        cm = fmaxf(cm, __shfl_xor(cm, 16)); cm = fmaxf(cm, __shfl_xor(cm, 32));
        if (kh == 0) red[wave * 16 + nn] = cm;
        const int drow_cur = drow0;
        if (strip + sstride < nstrips) { map(strip + sstride, n0, drow0); wp = W + (size_t)(512 * wave + 16 * kh) * ldw + n0 + nn;
#pragma unroll
            for (int i = 0; i < 16; ++i) { va[i] = wp[(size_t)i * ldw]; vb[i] = wp[(size_t)(64 + i) * ldw]; } }
        __syncthreads();
        { const int c = lane & 15, kk = lane >> 4;
          float m = 0.f;
#pragma unroll
          for (int w = 0; w < 8; ++w) m = fmaxf(m, red[w * 16 + c]);
          m = fmaxf(m, 1e-30f); const float inv = 127.0f / m;
          unsigned char* orow = W8o + (size_t)(drow_cur + c) * D;
#pragma unroll
          for (int q = 0; q < 8; ++q) { const int k16 = 32 * wave + 4 * q + kk; const LAS v4u* sp = (const LAS v4u*)(sbuf + (size_t)((k16 * 16 + c) * 32)); const v4u a = sp[0], b = sp[1];
              v4u o; o.x = pack_q8m(bf_lo(a.x), bf_hi(a.x), bf_lo(a.y), bf_hi(a.y), inv); o.y = pack_q8m(bf_lo(a.z), bf_hi(a.z), bf_lo(a.w), bf_hi(a.w), inv);
              o.z = pack_q8m(bf_lo(b.x), bf_hi(b.x), bf_lo(b.y), bf_hi(b.y), inv); o.w = pack_q8m(bf_lo(b.z), bf_hi(b.z), bf_lo(b.w), bf_hi(b.w), inv);
              *(v4u*)(orow + 16 * k16) = o; }
          if (wave == 0 && kk == 0) cso[drow_cur + c] = m * (1.0f / 127.0f); }
        __syncthreads();
    }
#undef SQ_LOAD
#undef SQ_FIN
}
struct SMapGU { __device__ __forceinline__ void operator()(int strip, int& n0, int& drow0) const { n0 = 16 * strip; const int isup = n0 >= DFF ? 1 : 0, j0 = n0 - isup * DFF; drow0 = (j0 >> 7) * 256 + isup * 128 + (j0 & 127); } };
struct SMapIn { __device__ __forceinline__ void operator()(int strip, int& n0, int& drow0) const { drow0 = 16 * strip; n0 = drow0 < NQ ? QC0 + drow0 : drow0 - NQ; } };

struct Args { const float* in[23]; float* out; unsigned char* ws; int ph_lo, ph_hi, li, pad; };

__global__ void __launch_bounds__(NWAVES * 64, 2) fwd_kernel(Args args) {
    extern __shared__ __attribute__((aligned(16))) unsigned char lds_raw[];
    LAS unsigned char* lds = (LAS unsigned char*)lds_raw;
    volatile LAS unsigned* MISC = (volatile LAS unsigned*)(lds + MISC_OFF);
    const int tid = threadIdx.x, lane = tid & 63, wave = __builtin_amdgcn_readfirstlane(tid >> 6);
    const int G = gridDim.x; const int bx = blockIdx.x; const int vcu = (G % 8 == 0) ? (bx % 8) * (G / 8) + bx / 8 : bx;
    unsigned char* ws = args.ws;
    gu32* ctl = (gu32*)(ws + WS_CTL);
    const float* x = args.in[0]; const float* cvec = args.in[1]; const float* w_ada = args.in[2]; const float* b_ada = args.in[3];
    const float* g_mix_pre = args.in[4]; const float* g_mix_post = args.in[5]; const float* w_in = args.in[6]; const float* conv_w = args.in[7]; const float* conv_b = args.in[8];
    const float* w_rg_a = args.in[9]; const float* b_rg_a = args.in[10]; const float* w_rg_x = args.in[11]; const float* b_rg_x = args.in[12]; const float* lam = args.in[13];
    const float* pool_w = args.in[14]; const float* pool_scale = args.in[15]; const float* w_bl = args.in[16]; const float* w_bp = args.in[17]; const float* w_o = args.in[18];
    const float* g_ffn_pre = args.in[19]; const float* g_ffn_post = args.in[20]; const float* w_gu = args.in[21]; const float* w_dn = args.in[22];
    float* out = args.out;
    float* mod = (float*)(ws + WS_MOD); float* sp8 = (float*)(ws + WS_SP8);
    bf16* Wrg_t = (bf16*)(ws + WS_WRG); bf16* Wpool_t = (bf16*)(ws + WS_WPOOL); bf16* Wbl_t = (bf16*)(ws + WS_WBL); bf16* Wbp_t = (bf16*)(ws + WS_WBP); bf16* Wo_t = (bf16*)(ws + WS_WO);
    bf16* Win_t = (bf16*)(ws + WS_WIN); bf16* Wgu_t = (bf16*)(ws + WS_WGU); bf16* Wdn_t = (bf16*)(ws + WS_WDN);
    bf16* U = (bf16*)(ws + WS_U); bf16* PROJ = (bf16*)(ws + WS_PROJ); bf16* XC = (bf16*)(ws + WS_XC); bf16* POOLED = (bf16*)(ws + WS_POOLED);
    unsigned* AU = (unsigned*)(ws + WS_AU); float* SCP = (float*)(ws + WS_SCANC); float* SCH = SCP + BATCH * SCAN_NC * D;
    bf16* YL = (bf16*)(ws + WS_YL); bf16* YP = (bf16*)(ws + WS_YP); bf16* MERGED = (bf16*)(ws + WS_MERGED); bf16* Y = (bf16*)(ws + WS_Y); bf16* Y2 = (bf16*)(ws + WS_Y2); bf16* H = (bf16*)(ws + WS_H); bf16* X1B = (bf16*)(ws + WS_X1B);

    for (int u = tid; u < (LDS_BYTES - LDSCTL_OFF) / 4; u += NWAVES * 64) ((LAS unsigned*)(lds + LDSCTL_OFF))[u] = 0u;
    __syncthreads();
    XcdBarrier bar; bar.bar = (unsigned*)(ctl + CW_BAR) + args.li * XCD_BAR_WORDS; bar.x = 0; bar.st = nullptr;
    if (N_LAUNCHES != NPH) bar = xcd_barrier_post((unsigned*)(ctl + CW_BAR) + args.li * XCD_BAR_WORDS, MISC + 8);
#define GRID_BAR() do { if (N_LAUNCHES != NPH) xcd_barrier(bar); } while (0)
    const int lo = args.ph_lo, hi = args.ph_hi;
#ifndef PH_MASK
#define PH_MASK 0x1fff
#endif
#define IN(k) (((PH_MASK >> (k)) & 1) && lo <= (k) && (k) < hi)
#ifndef DUP_MASK
#define DUP_MASK 0


#endif
#define DUP(k) ((DUP_MASK >> (k)) & 1)
#define REP(k) _Pragma("unroll 1") for (int rep_ = 0; rep_ < DUP(k) + 1; ++rep_)
#define BOTH(k) (IN(k) && (k) + 1 < hi)
    const int gw = vcu * NWAVES + wave, NGW = G * NWAVES;
    unsigned char* PQ8 = ws + WS_AU; unsigned char* W8c = ws + WS_AU + 64 * MiB; float* pscale = (float*)(ws + WS_AU + 96 * MiB); float* wcscale = pscale + M;
    bf16* Wcomb_t = (bf16*)(ws + WS_YP);
    bf16* Wgu_rot = (bf16*)(ws + WS_WGU); unsigned char* W8gu = ws + WS_YP; unsigned* cmaxf = (unsigned*)(ws + 640 * 1024);
    unsigned char* HQ8 = ws + WS_WGU; unsigned char* W8dn = ws + WS_AU; float* rhscale = (float*)(ws + WS_AU + 64 * MiB); float* cscaled = rhscale + M; unsigned* cmaxd = (unsigned*)(ws + 768 * 1024);
    unsigned char* U2Q8 = ws + WS_Y2; float* r2scale = (float*)(ws + WS_Y2 + 64 * MiB); float* cscalef = r2scale + M;
    unsigned char* UQ8 = ws + WS_AU; unsigned char* W8 = ws + WS_AU + 64 * MiB; float* rscale = (float*)(ws + WS_AU + 130 * MiB); float* cscale = rscale + M; unsigned* cmaxg = (unsigned*)(ws + 512 * 1024);

    if (IN(0)) REP(0) {
        {
            LAS float* cact = (LAS float*)lds; LAS float* red = (LAS float*)(lds + 32768);
            for (int i = tid; i < BATCH * D; i += NWAVES * 64) { const float v = cvec[i]; cact[i] = pg8::siluf_(v); }
            __syncthreads();
            const int cg = tid % 24, kg = tid / 24;
            for (int g = vcu; g < NMOD / 96; g += G) {
                if (kg < 21) {
                    f32x4 a0 = {0.f, 0.f, 0.f, 0.f}, a1 = {0.f, 0.f, 0.f, 0.f};
                    const float* wp = w_ada + (size_t)g * 96 + cg * 4;
#pragma unroll 8
                    for (int k = kg; k < D; k += 21) { const f32x4 w = *(const f32x4*)(wp + (size_t)k * NMOD); const float c0 = cact[k], c1 = cact[D + k]; a0 += w * c0; a1 += w * c1; }
                    LAS float* rp = red + (kg * 24 + cg) * 8;
                    rp[0] = a0.x; rp[1] = a0.y; rp[2] = a0.z; rp[3] = a0.w; rp[4] = a1.x; rp[5] = a1.y; rp[6] = a1.z; rp[7] = a1.w;
                }
                __syncthreads();
                if (tid < 192) { const int cgo = tid >> 3, r = tid & 7, b = r >> 2, j = r & 3; float s = 0.f;
#pragma unroll
                    for (int q = 0; q < 21; ++q) s += red[(q * 24 + cgo) * 8 + r];
                    const int n = g * 96 + cgo * 4 + j; mod[b * NMOD + n] = s + b_ada[n]; }
                __syncthreads();
            }
        }
        for (int i = bx * NWAVES * 64 + tid; i < D; i += G * NWAVES * 64) { const float l = lam[i]; sp8[i] = -8.0f * log1pf(expf(-l)); }
        {
            LAS float* scr = (LAS float*)(lds + wave * 16384);
            int itbase = 0;
            transpose_matrix<0>(w_in + D, D, NIN, Win_t, D, D, scr, lane, gw, NGW, itbase, D);
            for (int h = 0; h < HEADS; ++h) {
                const int nblk = HD / 32, nitems = (HD / 64) * nblk * 2;
                int it = gw - (itbase % NGW); if (it < 0) it += NGW;
                for (; it < nitems; it += NGW) { const int which = it / ((HD / 64) * nblk), r = it % ((HD / 64) * nblk), kb = r / nblk, nb = r % nblk, n0 = 32 * nb;
                    const float* W = (which ? w_rg_x : w_rg_a) + (size_t)h * HD * HD;
                    transpose_item(W, HD, Wrg_t, HD, 64 * kb, n0, h * 512 + (n0 >> 7) * 256 + which * 128 + (n0 & 127), scr, lane); }
                itbase += nitems;
            }
            for (int e = (bx * NWAVES * 64 + tid) * 4; e < PGRP * PGD * PGD; e += G * NWAVES * 64 * 4) {
                const int j = e % PGD, gi = e / (PGD * PGD); const f32x4 w = *(const f32x4*)(pool_w + e), sc = *(const f32x4*)(pool_scale + gi * PGD + j);
                v2u o; o.x = cvt_pk_bf16(w.x * sc.x, w.y * sc.y); o.y = cvt_pk_bf16(w.z * sc.z, w.w * sc.w); *(v2u*)(Wpool_t + e) = o; }
            transpose_matrix<0>(w_bl, D, D, Wbl_t, D, 0, scr, lane, gw, NGW, itbase);
            transpose_matrix<0>(w_bp, D, D, Wbp_t, D, 0, scr, lane, gw, NGW, itbase);
            transpose_matrix<0>(w_o, D, D, Wo_t, D, 0, scr, lane, gw, NGW, itbase);
            __syncthreads();
            strip_quant(w_in, NIN, W8, cscale, (NQ + D) / 16, vcu, G, lds, lane, wave, SMapIn{});
        }
        if (BOTH(0)) GRID_BAR();
    }

    if (IN(1)) REP(1) {
        { LAS float* scr = (LAS float*)(lds + wave * 16384);
          (void)scr;
          }
        __syncthreads();
        LAS float* cA = (LAS float*)lds; LAS float* cB = cA + D;
        int cur_b = -1;
        for (int slot = vcu; slot < M / 8; slot += G) {
            const int b = slot / (SEQ / 8);
            if (b != cur_b) { __syncthreads();
                for (int i = tid; i < D; i += NWAVES * 64) { cA[i] = g_mix_pre[i] * (1.0f + mod[b * NMOD + 1 * D + i]); cB[i] = mod[b * NMOD + 0 * D + i]; }
                __syncthreads(); cur_b = b; }
            { const size_t row = (size_t)slot * 8 + wave;
                const f32x4* xr = (const f32x4*)(x + row * D) + lane;
                f32x4 v[16]; float s = 0.f;
#pragma unroll
                for (int j = 0; j < 16; ++j) { v[j] = xr[64 * j]; s += dot4(v[j]); }
                const float rstd = 1.0f / sqrtf(wave_sum(s) * (1.0f / D) + RMS_EPS);
                v2u* o8 = (v2u*)(U + row * D) + lane;
#pragma unroll
                for (int j = 0; j < 16; ++j) { const f32x4 a = ((const LAS f32x4*)cA)[lane + 64 * j], bb = ((const LAS f32x4*)cB)[lane + 64 * j]; v[j] = v[j] * rstd * a + bb;
                    v2u w; w.x = cvt_pk_bf16(v[j].x, v[j].y); w.y = cvt_pk_bf16(v[j].z, v[j].w); o8[64 * j] = w; }
                rotq_row(v, (unsigned*)(UQ8 + row * D), rscale + row, lane);
            }
        }
        if (BOTH(1)) GRID_BAR();
    }

    if (IN(2)) {
#define P2_BODY do { { pg8::Gemm g{U, Win_t + (size_t)D * D, M, D, D, D, D, 30}; pg8::StaticOrder S; S.init(M, D, G, bx); \
        pg8::EpiPlain E{PROJ + D, NIN}; \
        pg8::gemm_phase<pg8::EpiPlain, pg8::StaticOrder, true, true>(lds + RING_OFF, g, S, E); } \
        { pg8::Gemm g{(const bf16*)UQ8, (const bf16*)W8, M, NQ, D / 2, D / 2, D / 2, 30}; pg8::StaticOrder S; S.init(M, NQ, G, bx);     \
        pg8::EpiI8 E{PROJ + QC0, NIN, rscale, cscale}; \
        pg8::gemm_phase<pg8::EpiI8, pg8::StaticOrder, true, true>(lds + RING_OFF, g, S, E); } \
        { pg8::Gemm g{(const bf16*)UQ8, (const bf16*)(W8 + (size_t)NQ * D), M, D, D / 2, D / 2, D / 2, 30}; pg8::StaticOrder S; S.init(M, D, G, bx);     \
        pg8::EpiI8 E{PROJ, NIN, rscale, cscale + NQ}; \
        pg8::gemm_phase<pg8::EpiI8, pg8::StaticOrder, true, true>(lds + RING_OFF, g, S, E); } } while (0)
        P2_BODY; if (DUP(2)) { P2_BODY; }
        if (BOTH(2)) GRID_BAR();
    }

    if (IN(3)) REP(3) {
        for (int id = gw; id < (M / 64) * 16; id += NGW) { const int chunk = id >> 4, cgp = id & 15, ch0 = cgp * 256 + lane * 4;
            switch (cgp >> 2) {
                case 0: conv_pool_chunk<2>(PROJ, XC, POOLED, conv_w, conv_b, chunk, ch0); break;
                case 1: conv_pool_chunk<4>(PROJ, XC, POOLED, conv_w, conv_b, chunk, ch0); break;
                case 2: conv_pool_chunk<8>(PROJ, XC, POOLED, conv_w, conv_b, chunk, ch0); break;
                default: conv_pool_chunk<16>(PROJ, XC, POOLED, conv_w, conv_b, chunk, ch0); break;
            }
        }
    }
    if (IN(3)) {
        { pg8::Gemm g{Wbp_t, Wpool_t, D, D, PGD, D, PGD, 2}; pg8::StaticOrder S; S.init(D, D, G, bx);
          pg8::EpiPlain E{Wcomb_t, D};
          pg8::gemm_phase<pg8::EpiPlain, pg8::StaticOrder, true, true>(lds + RING_OFF, g, S, E); }
        if (BOTH(3)) GRID_BAR();
    }

    if (IN(4)) {
#define P4_BODY do { \
        lru_fused(XC, Wrg_t, PROJ, YL, b_rg_a, b_rg_x, sp8, lds, tid, lane, wave, vcu, G); } while (0)
        P4_BODY; if (DUP(4)) { P4_BODY; }
        for (int slot = vcu; slot < (M + D) / 8; slot += G) { const int row = slot * 8 + wave; const bool isw = row >= M;
            const bf16* src = isw ? Wcomb_t + (size_t)(row - M) * D : POOLED + (size_t)row * D; const v2u* sp = (const v2u*)src + lane;
            f32x4 v[16];
#pragma unroll
            for (int j = 0; j < 16; ++j) { const v2u q = sp[64 * j]; v[j] = (f32x4){bf_lo(q.x), bf_hi(q.x), bf_lo(q.y), bf_hi(q.y)}; }
            rotq_row(v, (unsigned*)(isw ? W8c + (size_t)(row - M) * D : PQ8 + (size_t)row * D), isw ? wcscale + (row - M) : pscale + row, lane); }
        if (BOTH(4)) GRID_BAR();
    }

    if (IN(7)) {
#define P7_BODY do { \
        { pg8::Gemm g{(const bf16*)PQ8, (const bf16*)W8c, M, D, D / 2, D / 2, D / 2, 30}; pg8::StaticOrder S; S.init(M, D, G, bx);     \
          pg8::EpiGateI8 E{MERGED, D, PROJ + 4 * D, NIN, pscale, wcscale}; \
          pg8::gemm_phase<pg8::EpiGateI8, pg8::StaticOrder, true, true>(lds + RING_OFF, g, S, E); } \
        { pg8::Gemm g{YL, Wbl_t, M, D, D, D, D, 30}; pg8::StaticOrder S; S.init(M, D, G, bx); \
          pg8::EpiGate<true> E{MERGED, D, PROJ + 3 * D, NIN}; \
          pg8::gemm_phase<pg8::EpiGate<true>, pg8::StaticOrder, true, true>(lds + RING_OFF, g, S, E); } } while (0)
        P7_BODY; if (DUP(7)) { P7_BODY; }
        if (BOTH(7)) GRID_BAR();
    }

    if (IN(8)) {
#define P8_BODY do { pg8::Gemm g{MERGED, Wo_t, M, D, D, D, D, 30}; pg8::StaticOrder S; S.init(M, D, G, bx); \
        pg8::EpiPlain E{Y, D}; \
        pg8::gemm_phase<pg8::EpiPlain, pg8::StaticOrder, true, true>(lds + RING_OFF, g, S, E); } while (0)
        P8_BODY; if (DUP(8)) { P8_BODY; }
        if (BOTH(8)) GRID_BAR();
    }

    if (IN(9)) REP(9) {
        {
            LAS float* scr = (LAS float*)(lds + wave * 16384);
            int itbase = 0;
            (void)itbase;
            strip_quant(w_gu, NGU, W8gu, cscalef, NGU / 16, vcu, G, lds, lane, wave, SMapGU{});
            __syncthreads();
            if (((M / 256) * (NGU / 256)) % G == 0) { const int nblk = D / 32, nitems = (DFF / 64) * nblk;
                rot_stream(w_dn, D, Wdn_t, DFF, scr, lane, cmaxd, gw, nitems, NGW, MapDn{}); }
            else if (G == 256 && vcu >= WGU_SHORT0)
                rot_stream(w_dn, D, Wdn_t, DFF, scr, lane, cmaxd, (vcu - WGU_SHORT0) * NWAVES + wave, WDN_P9_ITEMS, (256 - WGU_SHORT0) * NWAVES, MapDn{});
        }
        __syncthreads();
        {
            LAS float* cG = (LAS float*)lds; LAS float* cA = cG + D; LAS float* cB = cA + D;
            int cur_b = -1;
            for (int slot = vcu; slot < M / 8; slot += G) {
                const int b = slot / (SEQ / 8);
                if (b != cur_b) { __syncthreads();
                    for (int i = tid; i < D; i += NWAVES * 64) { cG[i] = mod[b * NMOD + 2 * D + i] * g_mix_post[i]; cA[i] = g_ffn_pre[i] * (1.0f + mod[b * NMOD + 4 * D + i]); cB[i] = mod[b * NMOD + 3 * D + i]; }
                    __syncthreads(); cur_b = b; }
                { const size_t row = (size_t)slot * 8 + wave;
                    const f32x4* xr = (const f32x4*)(x + row * D) + lane; const v2u* yr = (const v2u*)(Y + row * D) + lane;
                    f32x4 v[16]; v2u yv[16]; float sy = 0.f;
#pragma unroll
                    for (int j = 0; j < 16; ++j) { v[j] = xr[64 * j]; yv[j] = yr[64 * j]; }
#pragma unroll
                    for (int j = 0; j < 16; ++j) { const f32x4 y = {bf_lo(yv[j].x), bf_hi(yv[j].x), bf_lo(yv[j].y), bf_hi(yv[j].y)}; sy += dot4(y); }
                    const float rstdy = 1.0f / sqrtf(wave_sum(sy) * (1.0f / D) + RMS_EPS);
                    float s1 = 0.f; v2u* orow = (v2u*)(X1B + row * D) + lane;
#pragma unroll
                    for (int j = 0; j < 16; ++j) { const f32x4 y = {bf_lo(yv[j].x), bf_hi(yv[j].x), bf_lo(yv[j].y), bf_hi(yv[j].y)}; const f32x4 gq = ((const LAS f32x4*)cG)[lane + 64 * j];
                        v[j] = v[j] + gq * (y * rstdy); s1 += dot4(v[j]); v2u w; w.x = cvt_pk_bf16(v[j].x, v[j].y); w.y = cvt_pk_bf16(v[j].z, v[j].w); orow[64 * j] = w; }
                    const float rstd1 = 1.0f / sqrtf(wave_sum(s1) * (1.0f / D) + RMS_EPS);
#pragma unroll
                    for (int j = 0; j < 16; ++j) { const f32x4 a = ((const LAS f32x4*)cA)[lane + 64 * j], bb = ((const LAS f32x4*)cB)[lane + 64 * j]; v[j] = v[j] * rstd1 * a + bb; }
                    rotq_row(v, (unsigned*)(U2Q8 + row * D), r2scale + row, lane);
                }
            }
        }
        if (BOTH(9)) GRID_BAR();
    }

    if (IN(10)) {
        { pg8::Gemm g{(const bf16*)U2Q8, (const bf16*)W8gu, M, NGU, D / 2, D / 2, D / 2, 30}; pg8::StaticOrder S; S.init(M, NGU, G, bx);
          pg8::EpiI8Swiglu E{H, DFF, r2scale, cscalef};
          pg8::gemm_phase<pg8::EpiI8Swiglu, pg8::StaticOrder, true, true>(lds + RING_OFF, g, S, E); }
        { const int rem10 = ((M / 256) * (NGU / 256)) % G;
          if (rem10 != 0 && bx >= rem10) { LAS float* scr = (LAS float*)(lds + wave * 16384); const int nblk = D / 32, nitems = (DFF / 64) * nblk;
              rot_stream(w_dn, D, Wdn_t, DFF, scr, lane, cmaxd, (G == 256 ? WDN_P9_ITEMS : 0) + (bx - rem10) * NWAVES + wave, nitems, (G - rem10) * NWAVES, MapDn{}); } }
        if (BOTH(10)) GRID_BAR();
    }

    if (IN(11)) {
        { const unsigned T = (unsigned)D * (DFF / 8), S = (unsigned)G * NWAVES * 64;
          for (unsigned it = (unsigned)bx * NWAVES * 64 + tid; it < T; it += 4 * S) {
              v4u w[4]; unsigned cm[4];
#pragma unroll
              for (int j = 0; j < 4; ++j) { const unsigned i2 = it + j * S; if (i2 < T) { w[j] = *(const v4u*)(Wdn_t + (size_t)i2 * 8); cm[j] = cmaxd[i2 / (DFF / 8)]; } }
#pragma unroll
              for (int j = 0; j < 4; ++j) { const unsigned i2 = it + j * S; if (i2 < T) { const float inv = 127.0f / fmaxf(__uint_as_float(cm[j]), 1e-30f);
                  v2u o; o.x = pack_q8(bf_lo(w[j].x), bf_hi(w[j].x), bf_lo(w[j].y), bf_hi(w[j].y), inv); o.y = pack_q8(bf_lo(w[j].z), bf_hi(w[j].z), bf_lo(w[j].w), bf_hi(w[j].w), inv);
                  *(v2u*)(W8dn + (size_t)i2 * 8) = o; } } } }
        for (int i = bx * NWAVES * 64 + tid; i < D; i += G * NWAVES * 64) cscaled[i] = fmaxf(__uint_as_float(cmaxd[i]), 1e-30f) * (1.0f / 127.0f);
        for (int slot = vcu; slot < M / 8; slot += G) { const size_t row = (size_t)slot * 8 + wave;
            const v2u* hp = (const v2u*)(H + row * DFF) + lane; v2u pk[DFF / 256]; float am = 0.f; const RotSigns sg = rot_signs(lane);
#pragma unroll
            for (int c = 0; c < DFF / 256; ++c) pk[c] = hp[64 * c];
#pragma unroll
            for (int c = 0; c < DFF / 256; ++c) { const f32x4 t = rot64((f32x4){bf_lo(pk[c].x), bf_hi(pk[c].x), bf_lo(pk[c].y), bf_hi(pk[c].y)}, sg);
                pk[c].x = cvt_pk_bf16(t.x, t.y); pk[c].y = cvt_pk_bf16(t.z, t.w);
                am = fmaxf(fmaxf(am, fmaxf(fabsf(bf_lo(pk[c].x)), fabsf(bf_hi(pk[c].x)))), fmaxf(fabsf(bf_lo(pk[c].y)), fabsf(bf_hi(pk[c].y)))); }
#pragma unroll
            for (int o = 1; o < 64; o <<= 1) am = fmaxf(am, __shfl_xor(am, o));
            am = fmaxf(am, 1e-30f); const float qi = 127.0f / am; unsigned* qrow = (unsigned*)(HQ8 + row * DFF) + lane;
#pragma unroll
            for (int c = 0; c < DFF / 256; ++c) qrow[64 * c] = pack_q8m(bf_lo(pk[c].x), bf_hi(pk[c].x), bf_lo(pk[c].y), bf_hi(pk[c].y), qi);
            if (lane == 0) rhscale[row] = am * (1.0f / 127.0f); }
        GRID_BAR();
#define P11_BODY do { pg8::Gemm g{(const bf16*)HQ8, (const bf16*)W8dn, M, D, DFF / 2, DFF / 2, DFF / 2, 30}; pg8::EpiI8 E{Y2, D, rhscale, cscaled}; \
        if (G == 256) { pg8::Grid16Order S; S.init(M, D, G, bx); pg8::gemm_phase<pg8::EpiI8, pg8::Grid16Order, true, true>(lds + RING_OFF, g, S, E); } \
        else { pg8::StaticOrder S; S.init(M, D, G, bx); pg8::gemm_phase<pg8::EpiI8, pg8::StaticOrder, true, true>(lds + RING_OFF, g, S, E); } } while (0)
        P11_BODY; if (DUP(11)) { P11_BODY; }
        if (BOTH(11)) GRID_BAR();
    }

    if (IN(12)) {
        LAS float* cG = (LAS float*)lds;
        int cur_b = -1;
        for (int slot = vcu; slot < M / 8; slot += G) {
            const int b = slot / (SEQ / 8);
            if (b != cur_b) { __syncthreads();
                for (int i = tid; i < D; i += NWAVES * 64) cG[i] = mod[b * NMOD + 5 * D + i] * g_ffn_post[i];
                __syncthreads(); cur_b = b; }
            { const size_t row = (size_t)slot * 8 + wave;
                f32x4* xr = (f32x4*)(out + row * D) + lane; const v2u* yr = (const v2u*)(Y2 + row * D) + lane; const v2u* x1r = (const v2u*)(X1B + row * D) + lane;
                f32x4 v[16]; v2u yv[16]; float sy = 0.f;
#pragma unroll
                for (int j = 0; j < 16; ++j) { const v2u q = x1r[64 * j]; v[j] = (f32x4){bf_lo(q.x), bf_hi(q.x), bf_lo(q.y), bf_hi(q.y)}; yv[j] = yr[64 * j]; }
#pragma unroll
                for (int j = 0; j < 16; ++j) { const f32x4 y = {bf_lo(yv[j].x), bf_hi(yv[j].x), bf_lo(yv[j].y), bf_hi(yv[j].y)}; sy += dot4(y); }
                const float rstdy = 1.0f / sqrtf(wave_sum(sy) * (1.0f / D) + RMS_EPS);
#pragma unroll
                for (int j = 0; j < 16; ++j) { const f32x4 y = {bf_lo(yv[j].x), bf_hi(yv[j].x), bf_lo(yv[j].y), bf_hi(yv[j].y)}; const f32x4 gq = ((const LAS f32x4*)cG)[lane + 64 * j];
                    xr[64 * j] = v[j] + gq * (y * rstdy); }
            }
        }
    }
#undef IN
#undef BOTH
#undef GRID_BAR
}

extern "C" void kernel_launch(void* const* d_in, const int* in_sizes, int n_in, void* d_out, int out_size, void* d_ws, size_t ws_size, hipStream_t stream) {
    static int grid = 0;
    if (grid == 0) {
        if (n_in != 23 || in_sizes[0] != M * D || out_size != M * D || ws_size < WS_END) {
            fprintf(stderr, "kernel_launch: built for 23 inputs, x/out of %d floats, >= %zu bytes of workspace; got n_in %d, in0 %d, out %d, ws %zu; nothing launched\n", M * D, (size_t)WS_END, n_in, n_in > 0 ? in_sizes[0] : -1, out_size, ws_size);
            grid = -1; return; }
        int dev = 0, cus = 0, per_cu = 0;
        if (hipGetDevice(&dev) != hipSuccess || hipDeviceGetAttribute(&cus, hipDeviceAttributeMultiprocessorCount, dev) != hipSuccess) { fprintf(stderr, "kernel_launch: device query failed\n"); grid = -1; return; }
        if (hipFuncSetAttribute((const void*)fwd_kernel, hipFuncAttributeMaxDynamicSharedMemorySize, LDS_BYTES) != hipSuccess) { fprintf(stderr, "kernel_launch: hipFuncSetAttribute failed\n"); grid = -1; return; }
        if (hipOccupancyMaxActiveBlocksPerMultiprocessor(&per_cu, (const void*)fwd_kernel, NWAVES * 64, LDS_BYTES) != hipSuccess || per_cu < 1)
            fprintf(stderr, "kernel_launch: note: occupancy query reports %d workgroups per CU\n", per_cu);
        (void)hipGetLastError();
        grid = cus;
    }
    if (grid < 0) return;
    if (hipMemsetAsync((char*)d_ws + WS_CTL, 0, CTL_ZERO_BYTES, stream) != hipSuccess) { fprintf(stderr, "kernel_launch: memset failed\n"); return; }
    Args a{};
    for (int i = 0; i < 23; ++i) a.in[i] = (const float*)d_in[i];
    a.out = (float*)d_out; a.ws = (unsigned char*)d_ws; a.pad = 0;
    for (int li = 0; li < N_LAUNCHES; ++li) {
        a.ph_lo = (N_LAUNCHES == NPH) ? li : (li * NPH) / N_LAUNCHES; a.ph_hi = (N_LAUNCHES == NPH) ? li + 1 : ((li + 1) * NPH) / N_LAUNCHES; a.li = li;
        hipLaunchKernelGGL(fwd_kernel, dim3(grid), dim3(NWAVES * 64), LDS_BYTES, stream, a);
        const hipError_t le = hipPeekAtLastError();
        if (le != hipSuccess) { fprintf(stderr, "kernel_launch: launch %d failed: %s\n", li, hipGetErrorName(le)); break; }
    }
}
```
